# Optimizing an MI355X kernel written in HIP

```python
import math
import jax, jax.numpy as jnp
from jax import lax
import numpy as np

D_MODEL = 1024
BATCH = 8
SEQ = 4096
DEPTH = 1

MIX_WIDTH = D_MODEL
HEAD_DIM = 64
N_HEADS = (MIX_WIDTH // 2) // HEAD_DIM
ATTN_WIDTH = N_HEADS * HEAD_DIM
SSM_GROUP_CH = 16
SSM_STATE = 64
SSM_WIDTH = MIX_WIDTH - ATTN_WIDTH
SSM_GROUPS = SSM_WIDTH // SSM_GROUP_CH
DILATED_BRANCHES = ((128, 1), (512, 4), (2048, 16))
PLE_DIM = 256
N_EXPERTS = 64
TOP_K = 8
N_EXPERT_GROUPS = 8
TOPK_GROUPS = 4
EXPERT_HIDDEN = 256
SHARED_HIDDEN = 256
ROUTED_SCALE = 2.5
BLOCK_ROWS = 128
LN_EPS = 1e-5

kernel_name = 'hybrid_dilated_attn_s5_moe_deepnorm'


def layer_norm(x, g, b):
    xf = x.astype(jnp.float32)
    mu = xf.mean(-1, keepdims=True)
    var = jnp.square(xf - mu).mean(-1, keepdims=True)
    y = (xf - mu) * lax.rsqrt(var + LN_EPS) * g.astype(jnp.float32) + b.astype(jnp.float32)
    return y.astype(x.dtype)


def alibi_slopes(n_heads):
    return jnp.exp2(-8.0 * jnp.arange(1, n_heads + 1, dtype=jnp.float32) / n_heads)


def dilated_branch(q, k, v, dil, n_keys, slopes):
    b, s, h, e = q.shape
    span = dil * n_keys
    sp = -(-s // span) * span
    L = sp // dil
    nb = L // n_keys
    pad = ((0, 0), (0, sp - s), (0, 0), (0, 0))

    def split(t):
        t = jnp.pad(t, pad).reshape(b, L, dil, h, e).transpose(0, 2, 1, 3, 4)
        return t.reshape(b, dil, nb, n_keys, h, e)

    def with_prev(t):
        prev = jnp.pad(t, ((0, 0), (0, 0), (1, 0), (0, 0), (0, 0), (0, 0)))[:, :, :-1]
        return jnp.concatenate([prev, t], axis=3)

    qb = split(q)
    kw = with_prev(split(k))
    vw = with_prev(split(v))
    scores = jnp.einsum('brnqhe,brnkhe->brnhqk', qb, kw,
                        preferred_element_type=jnp.float32) * (HEAD_DIM ** -0.5)
    qi = jnp.arange(n_keys)[:, None]
    kj = jnp.arange(2 * n_keys)[None, :]
    steps = qi + n_keys - kj
    in_band = (steps >= 0) & (steps <= n_keys)
    first_blk = (jnp.arange(nb) == 0)[:, None, None]
    valid = in_band[None] & ~(first_blk & (kj < n_keys)[None])
    bias = -slopes[:, None, None] * (steps * dil).astype(jnp.float32)[None]
    scores = jnp.where(valid[None, None, :, None], scores + bias, -jnp.inf)
    m = scores.max(-1, keepdims=True)
    pexp = jnp.exp(scores - m)
    l = pexp.sum(-1)
    o = jnp.einsum('brnhqk,brnkhe->brnqhe', pexp, vw.astype(jnp.float32))
    o = o / jnp.swapaxes(l, 3, 4)[..., None]
    lse = jnp.swapaxes(m[..., 0] + jnp.log(l), 3, 4)
    o = o.reshape(b, dil, L, h, e).transpose(0, 2, 1, 3, 4).reshape(b, sp, h, e)[:, :s]
    lse = lse.reshape(b, dil, L, h).transpose(0, 2, 1, 3).reshape(b, sp, h)[:, :s]
    return o, lse


def dilated_attention(q, k, v):
    slopes = alibi_slopes(q.shape[2])
    outs, lses = [], []
    for window, dil in DILATED_BRANCHES:
        o, lse = dilated_branch(q, k, v, dil, window // dil, slopes)
        outs.append(o)
        lses.append(lse)
    w = jax.nn.softmax(jnp.stack(lses, 0), axis=0)
    return jnp.sum(w[..., None] * jnp.stack(outs, 0), axis=0)


def s5_mixer(u, lam_re, lam_im, log_dt, b_re, b_im, c_re, c_im, d_skip, w_glu, b_glu):
    b, s, w = u.shape
    f32 = jnp.float32
    uf = u.astype(f32).reshape(b, s, SSM_GROUPS, SSM_GROUP_CH)
    lam = lax.complex(lam_re.astype(f32), lam_im.astype(f32))
    dt = jnp.exp(log_dt.astype(f32))[:, None]
    lam_bar = jnp.exp(lam * dt)
    gain = (lam_bar - 1.0) / lam
    b_bar = gain[..., None] * lax.complex(b_re.astype(f32), b_im.astype(f32))
    bu = jnp.einsum('bsgc,gnc->bsgn', uf.astype(jnp.complex64), b_bar)
    a = jnp.broadcast_to(lam_bar, bu.shape)

    def combine(left, right):
        a1, x1 = left
        a2, x2 = right
        return a1 * a2, a2 * x1 + x2

    _, states = lax.associative_scan(combine, (a, bu), axis=1)
    y = (jnp.einsum('gcn,bsgn->bsgc', c_re.astype(f32), states.real)
         - jnp.einsum('gcn,bsgn->bsgc', c_im.astype(f32), states.imag))
    y = (y + d_skip.astype(f32) * uf).reshape(b, s, w)
    y = jax.nn.gelu(y)
    y = y * jax.nn.sigmoid(y @ w_glu.astype(f32) + b_glu.astype(f32))
    return y.astype(u.dtype)


def routed_moe(h, w_router, router_bias, w_gate, w_up, w_down):
    t, d = h.shape
    scores = jax.nn.sigmoid((h @ w_router).astype(jnp.float32))
    sel = scores + router_bias.astype(jnp.float32)
    per_group = N_EXPERTS // N_EXPERT_GROUPS
    grp_score = lax.top_k(sel.reshape(t, N_EXPERT_GROUPS, per_group), 2)[0].sum(-1)
    _, top_g = lax.top_k(grp_score, TOPK_GROUPS)
    gmask = jax.nn.one_hot(top_g, N_EXPERT_GROUPS).sum(1) > 0
    emask = jnp.repeat(gmask, per_group, axis=1)
    _, idx = lax.top_k(jnp.where(emask, sel, -jnp.inf), TOP_K)
    wts = jnp.take_along_axis(scores, idx, axis=1)
    wts = wts / wts.sum(-1, keepdims=True) * ROUTED_SCALE

    n_assign = t * TOP_K
    flat_e = idx.reshape(n_assign)
    flat_w = wts.reshape(n_assign)
    flat_tok = jnp.arange(n_assign, dtype=jnp.int32) // TOP_K
    order = jnp.argsort(flat_e)
    se = flat_e[order]
    counts = jnp.bincount(flat_e, length=N_EXPERTS)
    start = jnp.cumsum(counts) - counts
    pcounts = (counts + BLOCK_ROWS - 1) // BLOCK_ROWS * BLOCK_ROWS
    pend = jnp.cumsum(pcounts)
    pstart = pend - pcounts
    dest = pstart[se] + (jnp.arange(n_assign) - start[se])
    n_blocks = -(-n_assign // BLOCK_ROWS) + N_EXPERTS
    n_rows = n_blocks * BLOCK_ROWS
    buf_tok = jnp.full((n_rows,), t, jnp.int32).at[dest].set(flat_tok[order])
    buf_w = jnp.zeros((n_rows,), jnp.float32).at[dest].set(flat_w[order])
    block_e = jnp.minimum(jnp.searchsorted(pend, jnp.arange(n_blocks) * BLOCK_ROWS, side='right'),
                          N_EXPERTS - 1)
    h_pad = jnp.concatenate([h, jnp.zeros((1, d), h.dtype)], axis=0)

    def run_block(args):
        tok, e, wb = args
        xb = h_pad[tok]
        hid = jax.nn.silu(xb @ w_gate[e]) * (xb @ w_up[e])
        return (hid @ w_down[e]) * wb[:, None].astype(h.dtype)

    yb = lax.map(run_block, (buf_tok.reshape(n_blocks, BLOCK_ROWS), block_e,
                             buf_w.reshape(n_blocks, BLOCK_ROWS)))
    y = jnp.zeros((t + 1, d), h.dtype).at[buf_tok].add(yb.reshape(n_rows, d))
    return y[:t]


def setup_inputs(seed: int = 0) -> dict:
    key = jax.random.key(seed)
    ks = jax.random.split(key, 32)
    f32 = jnp.float32
    beta = (8.0 * DEPTH) ** -0.25
    L, D, G, N, C = DEPTH, D_MODEL, SSM_GROUPS, SSM_STATE, SSM_GROUP_CH
    E, H, HS = N_EXPERTS, EXPERT_HIDDEN, SHARED_HIDDEN
    nrm = lambda k, shp, sc: jax.random.normal(k, shp, f32) * sc
    in_cols = 3 * ATTN_WIDTH + SSM_WIDTH
    lam_im0 = jnp.pi * jnp.arange(N, dtype=f32)
    return {
        'x': nrm(ks[0], (BATCH, SEQ, D), 1.0),
        'p': nrm(ks[1], (DEPTH, BATCH, SEQ, PLE_DIM), 1.0),
        'w_in': nrm(ks[2], (L, D, in_cols), D ** -0.5),
        'lam_re': -0.5 + nrm(ks[3], (L, G, N), 0.01),
        'lam_im': lam_im0 + nrm(ks[4], (L, G, N), 0.01),
        'log_dt': jax.random.uniform(ks[5], (L, G), f32, math.log(1e-3), math.log(1e-1)),
        'b_re': nrm(ks[6], (L, G, N, C), (2.0 * C) ** -0.5),
        'b_im': nrm(ks[7], (L, G, N, C), (2.0 * C) ** -0.5),
        'c_re': nrm(ks[8], (L, G, C, N), (2.0 * N) ** -0.5),
        'c_im': nrm(ks[9], (L, G, C, N), (2.0 * N) ** -0.5),
        'd_skip': nrm(ks[10], (L, G, C), 1.0),
        'w_glu': nrm(ks[11], (L, SSM_WIDTH, SSM_WIDTH), SSM_WIDTH ** -0.5),
        'b_glu': nrm(ks[12], (L, SSM_WIDTH), 0.01),
        'w_out': nrm(ks[13], (L, MIX_WIDTH, D), beta * MIX_WIDTH ** -0.5),
        'ln1_g': 1.0 + nrm(ks[14], (L, D), 0.02),
        'ln1_b': nrm(ks[15], (L, D), 0.02),
        'w_router': nrm(ks[16], (L, D, E), D ** -0.5),
        'router_bias': nrm(ks[17], (L, E), 0.01),
        'w_gate': nrm(ks[18], (L, E, D, H), D ** -0.5),
        'w_up': nrm(ks[19], (L, E, D, H), D ** -0.5),
        'w_down': nrm(ks[20], (L, E, H, D), beta * H ** -0.5),
        'ws_gate': nrm(ks[21], (L, D, HS), D ** -0.5),
        'ws_up': nrm(ks[22], (L, D, HS), D ** -0.5),
        'ws_down': nrm(ks[23], (L, HS, D), beta * HS ** -0.5),
        'w_ple': nrm(ks[24], (L, PLE_DIM, D), beta * PLE_DIM ** -0.5),
        'w_ple_gate': nrm(ks[25], (L, D, D), D ** -0.5),
        'ln2_g': 1.0 + nrm(ks[26], (L, D), 0.02),
        'ln2_b': nrm(ks[27], (L, D), 0.02),
    }


def reference(x, p, w_in, lam_re, lam_im, log_dt, b_re, b_im, c_re, c_im, d_skip,
              w_glu, b_glu, w_out, ln1_g, ln1_b, w_router, router_bias, w_gate, w_up,
              w_down, ws_gate, ws_up, ws_down, w_ple, w_ple_gate, ln2_g, ln2_b):
    alpha = (2.0 * DEPTH) ** 0.25
    b, s, d = x.shape
    h = x
    for i in range(DEPTH):
        z = h @ w_in[i]
        q = z[..., :ATTN_WIDTH].reshape(b, s, N_HEADS, HEAD_DIM)
        k = z[..., ATTN_WIDTH:2 * ATTN_WIDTH].reshape(b, s, N_HEADS, HEAD_DIM)
        v = z[..., 2 * ATTN_WIDTH:3 * ATTN_WIDTH].reshape(b, s, N_HEADS, HEAD_DIM)
        u = z[..., 3 * ATTN_WIDTH:]
        attn = dilated_attention(q, k, v).reshape(b, s, ATTN_WIDTH).astype(h.dtype)
        ssm = s5_mixer(u, lam_re[i], lam_im[i], log_dt[i], b_re[i], b_im[i], c_re[i],
                       c_im[i], d_skip[i], w_glu[i], b_glu[i])
        mix = jnp.concatenate([attn, ssm], axis=-1) @ w_out[i]
        h = layer_norm(alpha * h + mix, ln1_g[i], ln1_b[i])
        hf = h.reshape(b * s, d)
        routed = routed_moe(hf, w_router[i], router_bias[i], w_gate[i], w_up[i], w_down[i])
        shared = (jax.nn.silu(hf @ ws_gate[i]) * (hf @ ws_up[i])) @ ws_down[i]
        ffn = (routed + shared).reshape(b, s, d)
        ple = (p[i] @ w_ple[i]) * jax.nn.sigmoid(h @ w_ple_gate[i])
        h = layer_norm(alpha * h + ffn + ple, ln2_g[i], ln2_b[i])
    return h
```

```cpp
#include <hip/hip_runtime.h>
#include <cstdint>
#include <cstdio>
#include <cmath>

#define LAS __attribute__((address_space(3)))
#define GAS __attribute__((address_space(1)))
typedef unsigned short bf16_t;
typedef short bf16x8 __attribute__((ext_vector_type(8)));
typedef float f32x4 __attribute__((ext_vector_type(4)));
typedef float f32x2 __attribute__((ext_vector_type(2)));
typedef unsigned u32x4 __attribute__((ext_vector_type(4)));
typedef unsigned u32x2 __attribute__((ext_vector_type(2)));

constexpr int BATCH = 8, SEQ = 4096, DM = 1024, M = BATCH * SEQ;
constexpr int NH = 8, HD = 64, AW = 512, SW = 512, NG = 32, GC = 16, NS = 64;
constexpr int NE = 64, TOPK = 8, EH = 256, PLE = 256, ZC = 2048;
constexpr float ALPHA = 1.189207115002721f;
constexpr float LN_EPS = 1e-5f;
constexpr float ROUTED_SCALE = 2.5f;
constexpr float LOG2E = 1.4426950408889634f;
constexpr float QSCALE = 0.125f * LOG2E;

__device__ __forceinline__ unsigned f2bf(float f) { unsigned u = __builtin_bit_cast(unsigned, f); return (u + 0x7fffu + ((u >> 16) & 1u)) >> 16; }
__device__ __forceinline__ unsigned pk2(float lo, float hi) { return f2bf(lo) | (f2bf(hi) << 16); }
__device__ __forceinline__ float bf2f(unsigned short b) { return __builtin_bit_cast(float, (unsigned)b << 16); }
__device__ __forceinline__ float bflo(unsigned w) { return __builtin_bit_cast(float, w << 16); }
__device__ __forceinline__ float bfhi(unsigned w) { return __builtin_bit_cast(float, w & 0xffff0000u); }
__device__ __forceinline__ float wave_sum(float v) {
#pragma unroll
    for (int o = 1; o < 64; o <<= 1) v += __shfl_xor(v, o);
    return v;
}
__device__ __forceinline__ float sigmoidf_(float x) { return 1.f / (1.f + __expf(-x)); }
#define HYBRID 0
#define ONE_LAUNCH 1

namespace pg8 {
constexpr int BM = 256, BK = 64, HALF = 128, HTB = HALF * BK * 2  , STAGE_BYTES = 8 * HTB, NXCD = 8, WGM = 8;

__host__ __device__ __forceinline__ int lds_byte(int r, int c) { const int st = (r >> 4) * 2 + (c >> 5), rr = r & 15, cc = c & 31, ob = rr * 64 + cc * 2; return st * 1024 + (ob ^ (((ob >> 9) & 1) << 5)); }
__host__ __device__ __forceinline__ void stage_rc(int b, int& R, int& C) { const int st = b / 1024, sb = b % 1024, swz = sb ^ (((sb >> 9) & 1) << 5); R = (st >> 1) * 16 + swz / 64; C = (st & 1) * 32 + (swz % 64) / 2; }
__host__ __device__ __forceinline__ int perm32(int rho) { const int n = rho >> 4, i = rho & 15; return 8 * (i >> 2) + 4 * n + (i & 3); }

struct Unit { int arow, brow, crow, ccol, e, aux; };

typedef int i32x8 __attribute__((ext_vector_type(8)));
typedef int i32x4 __attribute__((ext_vector_type(4)));
__device__ __forceinline__ i32x8 cat8(bf16x8 a, bf16x8 b) { return __builtin_shufflevector(__builtin_bit_cast(i32x4, a), __builtin_bit_cast(i32x4, b), 0, 1, 2, 3, 4, 5, 6, 7); }
template <class Epi, class Sched, bool ALIGN_EPI, bool F8 = false>
__device__ __forceinline__ void gemm_phase(LAS unsigned char* lds, const int K, const Sched& S, const Epi& E) {
    int tid_l = threadIdx.x; asm volatile("" : "+v"(tid_l));
    const int tid = tid_l, wid = __builtin_amdgcn_readfirstlane(tid >> 6), lane = tid & 63, wr = wid >> 2, wc = wid & 3, fr = lane & 15, fq = lane >> 4;
    const int nt = K / BK;
    unsigned voffB[2];
#pragma unroll
    for (int i = 0; i < 2; ++i) { int R, C; stage_rc(tid * 16 + i * 8192, R, C); const int Rb = (R & ~31) + perm32(R & 31); voffB[i] = (unsigned)(Rb * K + C) * 2u; }
#define PG8_AVOFF(u_, v_) do { int Ra[2], Ca[2]; int t_ = tid; asm volatile("" : "+v"(t_)); _Pragma("unroll") for (int i = 0; i < 2; ++i) stage_rc(t_ * 16 + i * 8192, Ra[i], Ca[i]); S.avoff(u_, Ra, Ca, v_); } while (0)
    const size_t kstep = (size_t)(BK * 2);
    const size_t hstep = (size_t)HALF * K * 2;
    const unsigned ldsw = (unsigned)wid * 1024u;
    const int aoff = lds_byte(wr * 64 + fr, fq * 8), boff = lds_byte(wc * 32 + fr, fq * 8);
#define PG8_SA(b, h) (((b) * 2 + (h)) * HTB)
#define PG8_SB(b, h) ((4 + (b) * 2 + (h)) * HTB)
#define PG8_STAGE(bufoff, gbase, v0, v1) do { \
        __builtin_amdgcn_global_load_lds((const unsigned*)((const char*)(gbase) + (v0)), (LAS unsigned*)(lds + (bufoff) + ldsw), 16, 0, 0); \
        __builtin_amdgcn_global_load_lds((const unsigned*)((const char*)(gbase) + (v1)), (LAS unsigned*)(lds + (bufoff) + ldsw + 8192), 16, 0, 0); } while (0)
#define PG8_LDA(dst, b, h) do { if constexpr (F8) { _Pragma("unroll") for (int m = 0; m < 4; ++m) dst##8[m] = cat8(*(const LAS bf16x8*)(lds + PG8_SA(b, h) + aoff + m * 2048), *(const LAS bf16x8*)(lds + PG8_SA(b, h) + aoff + m * 2048 + 1024)); } \
        else { _Pragma("unroll") for (int m = 0; m < 4; ++m) _Pragma("unroll") for (int k = 0; k < 2; ++k) dst[m][k] = *(const LAS bf16x8*)(lds + PG8_SA(b, h) + aoff + m * 2048 + k * 1024); } } while (0)
#define PG8_LDB(dst, b, h) do { if constexpr (F8) { _Pragma("unroll") for (int n = 0; n < 2; ++n) dst##8[n] = cat8(*(const LAS bf16x8*)(lds + PG8_SB(b, h) + boff + n * 2048), *(const LAS bf16x8*)(lds + PG8_SB(b, h) + boff + n * 2048 + 1024)); } \
        else { _Pragma("unroll") for (int n = 0; n < 2; ++n) _Pragma("unroll") for (int k = 0; k < 2; ++k) dst[n][k] = *(const LAS bf16x8*)(lds + PG8_SB(b, h) + boff + n * 2048 + k * 1024); } } while (0)
#define PG8_MMA(ai, bj, At, Bt) do { __builtin_amdgcn_s_setprio(1); if constexpr (F8) { _Pragma("unroll") for (int m = 0; m < 4; ++m) _Pragma("unroll") for (int n = 0; n < 2; ++n) \
            acc[ai][bj][m][n] = __builtin_amdgcn_mfma_scale_f32_16x16x128_f8f6f4(Bt##8[n], At##8[m], acc[ai][bj][m][n], 0, 0, 0, 0x7f7f7f7f, 0, 0x7f7f7f7f); } \
        else { _Pragma("unroll") for (int m = 0; m < 4; ++m) _Pragma("unroll") for (int n = 0; n < 2; ++n) _Pragma("unroll") for (int k = 0; k < 2; ++k) \
            acc[ai][bj][m][n] = __builtin_amdgcn_mfma_f32_16x16x32_bf16(Bt[n][k], At[m][k], acc[ai][bj][m][n], 0, 0, 0); } __builtin_amdgcn_s_setprio(0); } while (0)
#define PG8_WAIT_V(n) asm volatile("s_waitcnt vmcnt(" #n ")" ::: "memory")
#define PG8_WAIT_L(n) asm volatile("s_waitcnt lgkmcnt(" #n ")" ::: "memory")
#define PG8_BAR __builtin_amdgcn_s_barrier()
#define PG8_SCHED __builtin_amdgcn_sched_barrier(0)
    Unit cur, nxt; int ui = 0;
    if (!S.next(0, cur)) return;
    f32x4 acc[2][2][4][2];
#pragma unroll
    for (int a = 0; a < 2; ++a)
#pragma unroll
        for (int b = 0; b < 2; ++b)
#pragma unroll
            for (int m = 0; m < 4; ++m)
#pragma unroll
                for (int n = 0; n < 2; ++n) acc[a][b][m][n] = (f32x4){0.f, 0.f, 0.f, 0.f};
    bf16x8 At[4][2], B0[2][2], B1[2][2]; i32x8 At8[4], B08[2], B18[2];
    unsigned cv[2][2];
    PG8_AVOFF(cur, cv);
    const char* cA = S.abase(cur); const char* cB = S.bbase(cur);
    PG8_STAGE(PG8_SB(0, 0), cB, voffB[0], voffB[1]); PG8_STAGE(PG8_SB(0, 1), cB + hstep, voffB[0], voffB[1]); PG8_STAGE(PG8_SA(0, 0), cA, cv[0][0], cv[0][1]); PG8_STAGE(PG8_SA(0, 1), cA, cv[1][0], cv[1][1]);
    if (wr == 1) PG8_BAR;
    PG8_WAIT_V(2); PG8_BAR;
    PG8_STAGE(PG8_SB(1, 0), cB + kstep, voffB[0], voffB[1]); PG8_STAGE(PG8_SA(1, 0), cA + kstep, cv[0][0], cv[0][1]); PG8_STAGE(PG8_SB(1, 1), cB + hstep + kstep, voffB[0], voffB[1]);
    PG8_WAIT_V(6); PG8_BAR;
    for (;;) {
        const bool has_next = S.next(ui + 1, nxt);
        const char* nA = cA; const char* nB = cB;
        if (has_next) { nA = S.abase(nxt); nB = S.bbase(nxt); }
#pragma unroll 1
        for (int t = 0; t < nt; t += 2) {
            const bool last = (t == nt - 2);
            const char* a1 = cA + (size_t)(t + 1) * kstep;
            const char* a2 = last ? nA : cA + (size_t)(t + 2) * kstep; const char* b2 = last ? nB : cB + (size_t)(t + 2) * kstep;
            const char* a3 = a2 + kstep; const char* b3 = b2 + kstep;
            PG8_LDB(B0, 0, 0); PG8_LDB(B1, 0, 1); PG8_SCHED; PG8_LDA(At, 0, 0); PG8_STAGE(PG8_SA(1, 1), a1, cv[1][0], cv[1][1]);
            if (last && has_next) PG8_AVOFF(nxt, cv);
            PG8_WAIT_V(8); PG8_WAIT_L(0); PG8_BAR; PG8_MMA(0, 0, At, B0); PG8_MMA(0, 1, At, B1); PG8_BAR; PG8_SCHED;
            PG8_LDA(At, 0, 1); PG8_STAGE(PG8_SB(0, 0), b2, voffB[0], voffB[1]); PG8_STAGE(PG8_SB(0, 1), b2 + hstep, voffB[0], voffB[1]); PG8_STAGE(PG8_SA(0, 0), a2, cv[0][0], cv[0][1]);
            PG8_WAIT_V(8); PG8_WAIT_L(0); PG8_BAR; PG8_MMA(1, 0, At, B0); PG8_MMA(1, 1, At, B1); PG8_BAR; PG8_SCHED;
            PG8_LDB(B0, 1, 0); PG8_LDB(B1, 1, 1); PG8_SCHED; PG8_LDA(At, 1, 0); PG8_STAGE(PG8_SA(0, 1), a2, cv[1][0], cv[1][1]);
            PG8_WAIT_V(8); PG8_WAIT_L(0); PG8_BAR; PG8_MMA(0, 0, At, B0); PG8_MMA(0, 1, At, B1); PG8_BAR; PG8_SCHED;
            PG8_LDA(At, 1, 1); PG8_STAGE(PG8_SB(1, 0), b3, voffB[0], voffB[1]); PG8_STAGE(PG8_SB(1, 1), b3 + hstep, voffB[0], voffB[1]); PG8_STAGE(PG8_SA(1, 0), a3, cv[0][0], cv[0][1]);
            PG8_WAIT_V(8); PG8_WAIT_L(0); PG8_BAR; PG8_MMA(1, 0, At, B0); PG8_MMA(1, 1, At, B1); PG8_BAR; PG8_SCHED;
        }
        if constexpr (ALIGN_EPI) { if (wr == 0) PG8_BAR; }
        E(acc, cur, wr, wc, fr, fq);
        if (!has_next) break;
#pragma unroll
        for (int a = 0; a < 2; ++a)
#pragma unroll
            for (int b = 0; b < 2; ++b)
#pragma unroll
                for (int m = 0; m < 4; ++m)
#pragma unroll
                    for (int n = 0; n < 2; ++n) acc[a][b][m][n] = (f32x4){0.f, 0.f, 0.f, 0.f};
        cur = nxt; cA = nA; cB = nB; ++ui;
        if constexpr (ALIGN_EPI) { if (wr == 1) PG8_BAR; }
    }
    PG8_WAIT_V(0);
    if constexpr (!ALIGN_EPI) { if (wr == 0) PG8_BAR; }
    PG8_BAR;
#undef PG8_AVOFF
#undef PG8_SA
#undef PG8_SB
#undef PG8_STAGE
#undef PG8_LDA
#undef PG8_LDB
#undef PG8_MMA
#undef PG8_WAIT_V
#undef PG8_WAIT_L
#undef PG8_BAR
#undef PG8_SCHED
}

struct PlainSched {
    const bf16_t* A; const bf16_t* Bt; int K; int nM, nN, nwg, G, c;
    __device__ void init(const bf16_t* A_, const bf16_t* Bt_, int Mr, int N, int K_, int G_, int c_) { A = A_; Bt = Bt_; K = K_; nM = Mr / BM; nN = N / BM; nwg = nM * nN; G = G_; c = c_; }
    __device__ __forceinline__ bool next(int i, Unit& u) const {
        const long L = (long)i * G + c; if (L >= nwg) return false;
        int wgid = (int)L; { const int q = nwg / NXCD, r = nwg % NXCD, xcd = wgid % NXCD, off = wgid / NXCD; wgid = (xcd < r ? xcd * (q + 1) : r * (q + 1) + (xcd - r) * q) + off; }
        const int nig = WGM * nN, gid = wgid / nig, fm = gid * WGM, gsz = (nM - fm) < WGM ? (nM - fm) : WGM;
        const int pm = fm + ((wgid % nig) % gsz), pn = (wgid % nig) / gsz;
        u.arow = pm * BM; u.brow = pn * BM; u.crow = pm * BM; u.ccol = pn * BM; u.e = 0; u.aux = 0; return true;
    }
    __device__ __forceinline__ const char* abase(const Unit& u) const { return (const char*)A + (size_t)u.arow * K * 2; }
    __device__ __forceinline__ const char* bbase(const Unit& u) const { return (const char*)Bt + (size_t)u.brow * K * 2; }
    __device__ __forceinline__ void avoff(const Unit&, const int (&R)[2], const int (&C)[2], unsigned (&v)[2][2]) const {
#pragma unroll
        for (int h = 0; h < 2; ++h)
#pragma unroll
            for (int i = 0; i < 2; ++i) v[h][i] = (unsigned)((h * HALF + R[i]) * K + C[i]) * 2u;
    }
};
}

constexpr size_t MiB = 1u << 20;
constexpr size_t WS_CTL = 0, CTL_ZERO_BYTES = 64 * 1024;
constexpr size_t WS_LDEST = 1 * MiB;
constexpr size_t WS_LIST = 9 * MiB;
constexpr size_t WS_LISTW = 17 * MiB;
constexpr size_t WS_STATS = 25 * MiB;
constexpr size_t WS_WR = 29 * MiB;
constexpr size_t WS_WIN = 30 * MiB;
constexpr size_t WS_WGLU = 34 * MiB;
constexpr size_t WS_WOUT = 35 * MiB;
constexpr size_t WS_WPG = 37 * MiB;
constexpr size_t WS_WGU = 39 * MiB;
constexpr size_t WS_WD = 104 * MiB;
constexpr size_t WS_WPLE = 136 * MiB + 512 * 1024;
constexpr size_t WS_B = 137 * MiB;
constexpr size_t WS_C = 201 * MiB;
constexpr size_t WS_D = 297 * MiB;
constexpr size_t WS_E = 361 * MiB;
constexpr size_t WS_BASE = WS_B;
constexpr size_t WS_HID = 201 * MiB;
constexpr size_t WS_SLAB0 = 30 * MiB, WS_SLABX = 289 * MiB;
constexpr size_t WS_SLAB1 = WS_SLABX;
constexpr size_t OUT_GS = 16 * MiB;
constexpr size_t WS_H8 = 449 * MiB;
constexpr size_t WS_END = 512 * MiB;
constexpr int TQ_TOK = 8192, LCAP = 8192;
static_assert(WS_WD + (size_t)65 * 1024 * 256 * 2 <= WS_WPLE && WS_HID + (size_t)360448 * 256 <= WS_SLABX && WS_SLABX + (size_t)3 * TQ_TOK * 9 * 1024 <= WS_END && WS_SLAB0 + (size_t)TQ_TOK * 9 * 1024 <= WS_WD, "ws map");
constexpr int CW_CNT = 64;
constexpr int CW_BAR = 1024;

constexpr int RING_OFF = 0, RING_BYTES = 131072;
constexpr int LDSCTL_OFF = RING_BYTES;
constexpr int MISC_OFF = LDSCTL_OFF;
constexpr int TAB_OFF = LDSCTL_OFF + 128;
constexpr int TST_OFF = LDSCTL_OFF + 512;
constexpr int IDX_OFF = LDSCTL_OFF + 2048;
constexpr int LDS_BYTES = 163840;
static_assert(IDX_OFF + 12 * 2048 <= LDS_BYTES, "LDS map");

constexpr int NWAVES = 8;
#define RLX_AGENT __ATOMIC_RELAXED, __HIP_MEMORY_SCOPE_AGENT
#define LDS_WAIT() asm volatile("s_waitcnt lgkmcnt(0)" ::: "memory")
#define VM_WAIT() asm volatile("s_waitcnt vmcnt(0)" ::: "memory")

#define XB_TMO      128
#define XB_XCNT(j)  (256  + 64 * (j))
#define XB_XSUB(j)  (1280 + 64 * (j))
#define XB_XGEN(j)  (2304 + 64 * (j))
#define XB_TOP      3328
#define XB_TOPGEN   3392
#define XCD_BAR_WORDS 3456
#define XB_SPIN_CAP (1u << 18)
__device__ __forceinline__ unsigned xb_ld(unsigned* p)              { return __hip_atomic_load(p, __ATOMIC_RELAXED, __HIP_MEMORY_SCOPE_AGENT); }
__device__ __forceinline__ unsigned xb_add(unsigned* p, unsigned v) { return __hip_atomic_fetch_add(p, v, __ATOMIC_RELAXED, __HIP_MEMORY_SCOPE_AGENT); }
__device__ __forceinline__ unsigned xb_xcc_id() { return (unsigned)__builtin_amdgcn_s_getreg((3 << 11) | 20) & 0xFu; }
#define XB_SPIN(cond, bar) do { unsigned _sp = 0; while (cond) { __builtin_amdgcn_s_sleep(1); \
    if ((++_sp & 255u) == 0u) { if (xb_ld(&(bar)[XB_TMO])) break; if (_sp > XB_SPIN_CAP) { atomicAdd(&(bar)[XB_TMO], 1u); break; } } } } while (0)
struct XcdBarrier { unsigned* bar; unsigned x; volatile LAS unsigned* st; };
__device__ __forceinline__ XcdBarrier xcd_barrier_post(unsigned* bar, volatile LAS unsigned* st) {
    XcdBarrier b; b.bar = bar; b.x = xb_xcc_id(); b.st = st;
    if (threadIdx.x == 0) (void)xb_add(&bar[XB_XCNT(b.x)], 1u);
    return b;
}
__device__ __forceinline__ void xcd_barrier_complete(unsigned* bar, unsigned x, unsigned& nloc, unsigned& nx) {
    const unsigned G = gridDim.x * gridDim.y * gridDim.z;
    unsigned sum, cnt, mine, sp = 0u;
    for (;;) {
        sum = 0u; cnt = 0u; mine = 0u;
#pragma unroll
        for (unsigned j = 0; j < 16; ++j) { const unsigned c = xb_ld(&bar[XB_XCNT(j)]); sum += c; cnt += (c > 0u) ? 1u : 0u; mine = (j == x) ? c : mine; }
        if (sum == G) break;
        __builtin_amdgcn_s_sleep(1);
        if ((++sp & 255u) == 0u) { if (xb_ld(&bar[XB_TMO])) break; if (sp > XB_SPIN_CAP) { atomicAdd(&bar[XB_TMO], 1u); break; } }
    }
    nloc = mine > 0u ? mine : 1u; nx = cnt > 0u ? cnt : 1u;
}
__device__ __forceinline__ void xcd_barrier(const XcdBarrier& b) {
    asm volatile("s_waitcnt vmcnt(0)" ::: "memory");
    __syncthreads();
    if (threadIdx.x == 0) {
        unsigned* bar = b.bar;
        __builtin_amdgcn_s_waitcnt(0);
        unsigned nloc = b.st[0], nx = b.st[1];
        if (nloc == 0u) { xcd_barrier_complete(bar, b.x, nloc, nx); b.st[0] = nloc; b.st[1] = nx; }
        const unsigned old = xb_add(&bar[XB_XSUB(b.x)], 1u);
        const unsigned gen = old / nloc;
        if (old + 1u == (gen + 1u) * nloc) {
            __builtin_amdgcn_fence(__ATOMIC_RELEASE, "agent");
            asm volatile("s_waitcnt vmcnt(0)" ::: "memory");
            const unsigned og = xb_add(&bar[XB_TOP], 1u);
            const unsigned tg = og / nx;
            if (og + 1u == (tg + 1u) * nx) xb_add(&bar[XB_TOPGEN], 1u);
            else XB_SPIN(xb_ld(&bar[XB_TOPGEN]) == tg, bar);
            __builtin_amdgcn_fence(__ATOMIC_ACQUIRE, "agent");
            xb_add(&bar[XB_XGEN(b.x)], 1u);
            asm volatile("s_waitcnt vmcnt(0)" ::: "memory");
        } else {
            XB_SPIN(xb_ld(&bar[XB_XGEN(b.x)]) == gen, bar);
            __builtin_amdgcn_fence(__ATOMIC_ACQUIRE, "agent");
            asm volatile("s_waitcnt vmcnt(0)" ::: "memory");
        }
    }
    __syncthreads();
}

struct Frame {
    LAS unsigned char* lds;
    volatile LAS unsigned* MISC;
    unsigned* ctl;
    int tid, lane, wave, vcu, G;
    float* out; unsigned char* ws;
};
struct Args { const float* in[28]; float* out; unsigned char* ws; int ph_lo, ph_hi; };
typedef __bf16 bf16x2_t __attribute__((ext_vector_type(2)));
__device__ __forceinline__ unsigned cvtpk(float lo, float hi) { f32x2 v = {lo, hi}; bf16x2_t b = __builtin_convertvector(v, bf16x2_t); return __builtin_bit_cast(unsigned, b); }
__device__ __forceinline__ u32x4 pack8(const f32x4 a, const f32x4 b) { u32x4 w; w.x = cvtpk(a[0], a[1]); w.y = cvtpk(a[2], a[3]); w.z = cvtpk(b[0], b[1]); w.w = cvtpk(b[2], b[3]); return w; }
__device__ __forceinline__ void unpack8(const u32x4 w, f32x4& a, f32x4& b) { a = (f32x4){bflo(w.x), bfhi(w.x), bflo(w.y), bfhi(w.y)}; b = (f32x4){bflo(w.z), bfhi(w.z), bflo(w.w), bfhi(w.w)}; }

using pg8::Unit;
typedef const f32x4 (&AccRef)[2][2][4][2];
#define EPI_ROWS_BEGIN _Pragma("unroll") for (int ai = 0; ai < 2; ++ai) _Pragma("unroll") for (int m = 0; m < 4; ++m) { const int rr = ai * 128 + wr * 64 + m * 16 + fr;
#define EPI_ROWS_END }
struct EpiQKVU {
    bf16_t* O;
    __device__ __forceinline__ void operator()(AccRef acc, const Unit& u, int wr, int wc, int fr, int fq) const {
        const int t = u.ccol >> 9, colt = u.ccol & 511; bf16_t* base = O + (size_t)t * M * 512; const float sc = (t == 0) ? QSCALE : 1.f;
        const int col0 = colt + wc * 32 + 8 * fq;
        EPI_ROWS_BEGIN
            bf16_t* rowp = base + (size_t)(u.crow + rr) * 512 + col0;
#pragma unroll
            for (int bj = 0; bj < 2; ++bj) *(u32x4*)(rowp + bj * 128) = pack8(acc[ai][bj][m][0] * sc, acc[ai][bj][m][1] * sc);
        EPI_ROWS_END
    }
};
struct EpiGLU {
    const bf16_t* Y; const float* bias; bf16_t* MIX;
    __device__ __forceinline__ void operator()(AccRef acc, const Unit& u, int wr, int wc, int fr, int fq) const {
        const int col0 = u.ccol + wc * 32 + 8 * fq;
        f32x4 bv[2][2];
#pragma unroll
        for (int bj = 0; bj < 2; ++bj) { bv[bj][0] = *(const f32x4*)(bias + col0 + bj * 128); bv[bj][1] = *(const f32x4*)(bias + col0 + bj * 128 + 4); }
        EPI_ROWS_BEGIN
            const size_t row = (size_t)(u.crow + rr);
#pragma unroll
            for (int bj = 0; bj < 2; ++bj) {
                const u32x4 yw = *(const u32x4*)(Y + row * 512 + col0 + bj * 128); f32x4 y0, y1; unpack8(yw, y0, y1);
                f32x4 a0 = acc[ai][bj][m][0] + bv[bj][0], a1 = acc[ai][bj][m][1] + bv[bj][1];
#pragma unroll
                for (int j = 0; j < 4; ++j) { a0[j] = y0[j] * sigmoidf_(a0[j]); a1[j] = y1[j] * sigmoidf_(a1[j]); }
                *(u32x4*)(MIX + row * 1024 + 512 + col0 + bj * 128) = pack8(a0, a1);
            }
        EPI_ROWS_END
    }
};
struct EpiWout {
    const float* X; float* PRE; f32x2* STATS;
    __device__ __forceinline__ void operator()(AccRef acc, const Unit& u, int wr, int wc, int fr, int fq) const {
        const int col0 = u.ccol + wc * 32 + 8 * fq;
        EPI_ROWS_BEGIN
            const size_t row = (size_t)(u.crow + rr); float s = 0.f, q = 0.f;
#pragma unroll
            for (int bj = 0; bj < 2; ++bj) {
                const float* xp = X + row * 1024 + col0 + bj * 128;
                const f32x4 v0 = *(const f32x4*)xp * ALPHA + acc[ai][bj][m][0], v1 = *(const f32x4*)(xp + 4) * ALPHA + acc[ai][bj][m][1];
                float* pp = PRE + row * 1024 + col0 + bj * 128; *(f32x4*)pp = v0; *(f32x4*)(pp + 4) = v1;
                s += (v0[0] + v0[1]) + (v0[2] + v0[3]) + (v1[0] + v1[1]) + (v1[2] + v1[3]);
                q += (v0[0] * v0[0] + v0[1] * v0[1]) + (v0[2] * v0[2] + v0[3] * v0[3]) + (v1[0] * v1[0] + v1[1] * v1[1]) + (v1[2] * v1[2] + v1[3] * v1[3]);
            }
            s += __shfl_xor(s, 16); s += __shfl_xor(s, 32); q += __shfl_xor(q, 16); q += __shfl_xor(q, 32);
            if (fq == 0) STATS[row * 16 + (u.ccol >> 8) * 4 + wc] = (f32x2){s, q};
        EPI_ROWS_END
    }
};
constexpr float WSC = 1.f / 32.f;
struct EpiGU {
    unsigned char* HID;
    __device__ __forceinline__ void operator()(AccRef acc, const Unit& u, int wr, int wc, int fr, int fq) const {
        const int col0 = u.ccol + wc * 32 + 8 * fq;
        EPI_ROWS_BEGIN
            f32x4 h0, h1;
#pragma unroll
            for (int j = 0; j < 4; ++j) { const float g0 = acc[ai][0][m][0][j] * WSC, g1 = acc[ai][0][m][1][j] * WSC; h0[j] = g0 * sigmoidf_(g0) * (acc[ai][1][m][0][j] * WSC); h1[j] = g1 * sigmoidf_(g1) * (acc[ai][1][m][1][j] * WSC); }
            int p0 = __builtin_amdgcn_cvt_pk_fp8_f32(h0[0], h0[1], 0, false); p0 = __builtin_amdgcn_cvt_pk_fp8_f32(h0[2], h0[3], p0, true);
            int p1 = __builtin_amdgcn_cvt_pk_fp8_f32(h1[0], h1[1], 0, false); p1 = __builtin_amdgcn_cvt_pk_fp8_f32(h1[2], h1[3], p1, true);
            *(u32x2*)(HID + (size_t)(u.crow + rr) * 256 + col0) = (u32x2){(unsigned)p0, (unsigned)p1};
        EPI_ROWS_END
    }
};
struct EpiDown {
    unsigned char* ws; LAS const int* dw;
    __device__ __forceinline__ void operator()(AccRef acc, const Unit& u, int wr, int wc, int fr, int fq) const {
        const int col0 = u.ccol + wc * 32 + 8 * fq; const int q = u.e >> 8;
        unsigned char* SLAB = ws + (q == 0 ? WS_SLAB0 : WS_SLABX + (size_t)(q - 1) * TQ_TOK * 9 * 1024);
        EPI_ROWS_BEGIN
            const int dest = dw[(u.crow * 256 + rr) * 2]; const float w = __int_as_float(dw[(u.crow * 256 + rr) * 2 + 1]) * (16.f * WSC);
            if (dest >= 0) { unsigned char* rowp = SLAB + (size_t)dest * 1024 + col0;
#pragma unroll
                for (int bj = 0; bj < 2; ++bj) { const f32x4 a = acc[ai][bj][m][0] * w, c = acc[ai][bj][m][1] * w;
                    int p0 = __builtin_amdgcn_cvt_pk_fp8_f32(a[0], a[1], 0, false); p0 = __builtin_amdgcn_cvt_pk_fp8_f32(a[2], a[3], p0, true);
                    int p1 = __builtin_amdgcn_cvt_pk_fp8_f32(c[0], c[1], 0, false); p1 = __builtin_amdgcn_cvt_pk_fp8_f32(c[2], c[3], p1, true);
                    *(u32x2*)(rowp + bj * 128) = (u32x2){(unsigned)p0, (unsigned)p1}; } }
        EPI_ROWS_END
    }
};
struct EpiGS {
    bf16_t* GS;
    __device__ __forceinline__ void operator()(AccRef acc, const Unit& u, int wr, int wc, int fr, int fq) const {
        const int col0 = u.ccol + wc * 32 + 8 * fq;
        EPI_ROWS_BEGIN
#pragma unroll
            for (int bj = 0; bj < 2; ++bj) { f32x4 a0 = acc[ai][bj][m][0], a1 = acc[ai][bj][m][1];
#pragma unroll
                for (int j = 0; j < 4; ++j) { a0[j] = sigmoidf_(a0[j] * WSC); a1[j] = sigmoidf_(a1[j] * WSC); }
                *(u32x4*)(GS + (size_t)(u.crow + rr) * 1024 + col0 + bj * 128) = pack8(a0, a1); }
        EPI_ROWS_END
    }
};
struct EpiBase {
    const bf16_t* GSB; bf16_t* H;
    __device__ __forceinline__ void operator()(AccRef acc, const Unit& u, int wr, int wc, int fr, int fq) const {
        const int col0 = u.ccol + wc * 32 + 8 * fq;
        EPI_ROWS_BEGIN
#pragma unroll
            for (int bj = 0; bj < 2; ++bj) { const size_t off = (size_t)(u.crow + rr) * 1024 + col0 + bj * 128;
                f32x4 g0, g1, h0, h1; unpack8(*(const u32x4*)(GSB + off), g0, g1); unpack8(*(const u32x4*)(H + off), h0, h1);
                const f32x4 o0 = acc[ai][bj][m][0] * g0 + h0 * ALPHA, o1 = acc[ai][bj][m][1] * g1 + h1 * ALPHA;
                *(u32x4*)(H + off) = pack8(o0, o1); }
        EPI_ROWS_END
    }
};

__device__ __forceinline__ void moe_prefix(Frame& F) {
    LAS int* tst = (LAS int*)(F.lds + TST_OFF);
    __syncthreads();
    if (F.wave == 0) {
        int c[5], tot = 0;
#pragma unroll
        for (int j = 0; j < 5; ++j) { const int i = 5 * F.lane + j, q = i / 65, e = i % 65; c[j] = i < 260 ? (e < 64 ? ((int)__hip_atomic_load(F.ctl + CW_CNT + q * 64 + e, RLX_AGENT) + 255) >> 8 : 32) : 0; tot += c[j]; }
        int inc = tot;
#pragma unroll
        for (int o = 1; o < 64; o <<= 1) { const int v = __shfl_up(inc, o); if (F.lane >= o) inc += v; }
        int run = inc - tot;
#pragma unroll
        for (int j = 0; j < 5; ++j) { const int i = 5 * F.lane + j; if (i < 260) tst[i] = run; run += c[j]; }
        if (F.lane == 63) tst[260] = inc;
    }
    __syncthreads();
}
template <int MODE> __device__ __forceinline__ void moe_units(Frame& F, int s0) {
    LAS int* tst = (LAS int*)(F.lds + TST_OFF); LAS int* tab = (LAS int*)(F.lds + TAB_OFF); LAS int* idx = (LAS int*)(F.lds + IDX_OFF);
    const int* LIST = (const int*)(F.ws + WS_LIST); const int* LDEST = (const int*)(F.ws + WS_LDEST); const float* LISTW = (const float*)(F.ws + WS_LISTW);
    moe_prefix(F);
    const int tile0 = 0, ntile = tst[260], nunit = MODE == 0 ? 2 * ntile : 4 * ntile;
    constexpr int CAP = 12;
    int n = (nunit - F.vcu + F.G - 1) / F.G - s0; n = n < 0 ? 0 : (n > CAP ? CAP : n);
    if (F.tid < 260) { const int lo = tst[F.tid], hi = tst[F.tid + 1];
#pragma unroll
        for (int s = 0; s < CAP; ++s) { const int L = (s0 + s) * F.G + F.vcu, tile = tile0 + (MODE == 0 ? (L >> 1) : (L >> 2));
            if (s < n && lo <= tile && tile < hi) { LAS int* t = tab + 4 + 6 * s; t[0] = F.tid % 65; t[1] = tile - lo; t[2] = tile; t[3] = MODE == 0 ? (L & 1) : (L & 3); t[4] = F.tid / 65; } } }
    if (F.tid == 0) { tab[0] = n; tab[1] = nunit; }
    __syncthreads();
    for (int it = F.tid; it < n * 256; it += 512) { const int s = it >> 8, r = it & 255; const int e = tab[4 + 6 * s], ti = tab[5 + 6 * s], q = tab[8 + 6 * s]; const int p = ti * 256 + r;
        if (MODE == 0) { int v;
            if (e < 64) { const int cnt = (int)__hip_atomic_load(F.ctl + CW_CNT + q * 64 + e, RLX_AGENT); v = p < cnt ? LIST[(size_t)(q * 64 + e) * LCAP + p] : q * TQ_TOK; }
            else v = q * TQ_TOK + p;
            idx[it] = v;
        } else { int dest = p * 9 + 8; float w = 1.f;
            if (e < 64) { const int cnt = (int)__hip_atomic_load(F.ctl + CW_CNT + q * 64 + e, RLX_AGENT); const size_t li = (size_t)(q * 64 + e) * LCAP + (p < cnt ? p : 0); dest = p < cnt ? LDEST[li] : -1; w = LISTW[li]; }
            idx[it * 2] = dest; idx[it * 2 + 1] = __float_as_int(w); } }
    __syncthreads();
}
struct GUSched {
    const bf16_t* H; const bf16_t* W; LAS const int* tab; LAS const int* idx;
    __device__ __forceinline__ bool next(int i, Unit& u) const { if (i >= tab[0]) return false; u.e = tab[4 + 6 * i]; const int tile = tab[6 + 6 * i], pn = tab[7 + 6 * i];
        u.aux = i; u.arow = 0; u.crow = tile * 256; u.ccol = pn * 128; u.brow = u.e * 512 + pn * 256; return true; }
    __device__ __forceinline__ const char* abase(const Unit&) const { return (const char*)H; }
    __device__ __forceinline__ const char* bbase(const Unit& u) const { return (const char*)W + (size_t)u.brow * 512 * 2; }
    __device__ __forceinline__ void avoff(const Unit& u, const int (&R)[2], const int (&C)[2], unsigned (&v)[2][2]) const {
#pragma unroll
        for (int h = 0; h < 2; ++h)
#pragma unroll
            for (int i = 0; i < 2; ++i) v[h][i] = (unsigned)(idx[u.aux * 256 + h * 128 + R[i]] * 512 + C[i]) * 2u;
    }
};
struct DownSched {
    const unsigned char* HID; const unsigned char* W; LAS const int* tab;
    __device__ __forceinline__ bool next(int i, Unit& u) const { if (i >= tab[0]) return false; u.e = tab[4 + 6 * i]; u.aux = tab[5 + 6 * i]; const int tile = tab[6 + 6 * i], pn = tab[7 + 6 * i];
        u.arow = tile * 256; u.ccol = pn * 256; u.brow = u.e * 1024 + pn * 256; u.crow = i; u.e |= tab[8 + 6 * i] << 8; return true; }
    __device__ __forceinline__ const char* abase(const Unit& u) const { return (const char*)HID + (size_t)u.arow * 256; }
    __device__ __forceinline__ const char* bbase(const Unit& u) const { return (const char*)W + (size_t)u.brow * 256; }
    __device__ __forceinline__ void avoff(const Unit&, const int (&R)[2], const int (&C)[2], unsigned (&v)[2][2]) const {
#pragma unroll
        for (int h = 0; h < 2; ++h)
#pragma unroll
            for (int i = 0; i < 2; ++i) v[h][i] = (unsigned)((h * 128 + R[i]) * 128 + C[i]) * 2u;
    }
};

struct TrItem { const float* W; bf16_t* WT; int K, N, destrow0, k0, n0, f8; };
__device__ __forceinline__ void tr_load(const TrItem& it, f32x4 (&tv)[8], int lane) {
#pragma unroll
    for (int j = 0; j < 8; ++j) tv[j] = *(const f32x4*)(it.W + (size_t)(it.k0 + 8 * (lane >> 3) + j) * it.N + it.n0 + 4 * (lane & 7));
}
__device__ __forceinline__ void tr_store(const TrItem& it, const f32x4 (&tv)[8], int lane) {
    if (it.f8) {
#pragma unroll
        for (int c = 0; c < 4; ++c) { int p0 = __builtin_amdgcn_cvt_pk_fp8_f32(tv[0][c] * 32.f, tv[1][c] * 32.f, 0, false); p0 = __builtin_amdgcn_cvt_pk_fp8_f32(tv[2][c] * 32.f, tv[3][c] * 32.f, p0, true);
            int p1 = __builtin_amdgcn_cvt_pk_fp8_f32(tv[4][c] * 32.f, tv[5][c] * 32.f, 0, false); p1 = __builtin_amdgcn_cvt_pk_fp8_f32(tv[6][c] * 32.f, tv[7][c] * 32.f, p1, true);
            *(u32x2*)((unsigned char*)it.WT + (size_t)(it.destrow0 + 4 * (lane & 7) + c) * it.K + it.k0 + 8 * (lane >> 3)) = (u32x2){(unsigned)p0, (unsigned)p1}; }
        return; }
#pragma unroll
    for (int c = 0; c < 4; ++c) { u32x4 o; o.x = pk2(tv[0][c], tv[1][c]); o.y = pk2(tv[2][c], tv[3][c]); o.z = pk2(tv[4][c], tv[5][c]); o.w = pk2(tv[6][c], tv[7][c]);
        *(u32x4*)(it.WT + (size_t)(it.destrow0 + 4 * (lane & 7) + c) * it.K + it.k0 + 8 * (lane >> 3)) = o; }
}
constexpr int I_IN = 16 * 64, I_GLU = 8 * 16, I_OUT = 16 * 32, I_PG = 16 * 32, I_PLE = 4 * 32, I_SMALL = I_IN + I_GLU + I_OUT + I_PG + I_PLE, I_G = 65 * 128, I_U = 65 * 128, I_D = 65 * 128, I_EXP = I_G + I_U + I_D;
__device__ __forceinline__ TrItem tr_decode_small(Frame& F, const Args& A, int r) {
    if (r < I_IN) return TrItem{A.in[2], (bf16_t*)(F.ws + WS_WIN), 1024, 2048, (r % 64) * 32, (r / 64) * 64, (r % 64) * 32, 0}; r -= I_IN;
    if (r < I_GLU) return TrItem{A.in[11], (bf16_t*)(F.ws + WS_WGLU), 512, 512, (r % 16) * 32, (r / 16) * 64, (r % 16) * 32, 0}; r -= I_GLU;
    if (r < I_OUT) return TrItem{A.in[13], (bf16_t*)(F.ws + WS_WOUT), 1024, 1024, (r % 32) * 32, (r / 32) * 64, (r % 32) * 32, 0}; r -= I_OUT;
    if (r < I_PG) return TrItem{A.in[25], (bf16_t*)(F.ws + WS_WPG), 1024, 1024, (r % 32) * 32, (r / 32) * 64, (r % 32) * 32, 1}; r -= I_PG;
    return TrItem{A.in[24], (bf16_t*)(F.ws + WS_WPLE), 256, 1024, (r % 32) * 32, (r / 32) * 64, (r % 32) * 32, 0};
}
__device__ __forceinline__ TrItem tr_decode_exp(Frame& F, const Args& A, int r) {
    bf16_t* WGU = (bf16_t*)(F.ws + WS_WGU); bf16_t* WD = (bf16_t*)(F.ws + WS_WD);
    if (r < I_G + I_U) { const bool up = r >= I_G; if (up) r -= I_G; const int e = r / 128, rr = r % 128, n0 = (rr % 8) * 32, k0 = (rr / 8) * 64;
        const float* src = e < 64 ? (up ? A.in[19] : A.in[18]) + (size_t)e * 1024 * 256 : (up ? A.in[22] : A.in[21]);
        return TrItem{src, (bf16_t*)((unsigned char*)WGU + (size_t)e * 512 * 1024), 1024, 256, (n0 >> 7) * 256 + (n0 & 127) + (up ? 128 : 0), k0, n0, 1}; }
    r -= I_G + I_U;
    { const int e = r / 128, rr = r % 128, n0 = (rr % 32) * 32, k0 = (rr / 32) * 64; const float* src = e < 64 ? A.in[20] + (size_t)e * 256 * 1024 : A.in[23];
        return TrItem{src, (bf16_t*)((unsigned char*)WD + (size_t)e * 1024 * 256), 256, 1024, n0, k0, n0, 1}; }
}
__device__ __forceinline__ int cvt_expert_burst(Frame& F, const Args& A, int cur, int nmax) {
    const int NGW = F.G * NWAVES;
    for (int k = 0; k < nmax && cur < I_EXP; k += 2) {
        const bool two = (k + 1 < nmax) && (cur + NGW < I_EXP);
        const TrItem a = tr_decode_exp(F, A, cur); f32x4 ta[8], tb[8]; tr_load(a, ta, F.lane);
        TrItem bI = a; if (two) { bI = tr_decode_exp(F, A, cur + NGW); tr_load(bI, tb, F.lane); }
        tr_store(a, ta, F.lane); if (two) tr_store(bI, tb, F.lane);
        cur += two ? 2 * NGW : NGW;
    }
    return cur;
}
__device__ __forceinline__ void p0_prologue(Frame& F, const Args& A) {
    const int gw = F.vcu * NWAVES + F.wave, NGW = F.G * NWAVES;
    if (gw < I_SMALL) {
        TrItem cur = tr_decode_small(F, A, gw); f32x4 tv[8], tn[8]; tr_load(cur, tv, F.lane);
        for (int it = gw; it < I_SMALL; it += NGW) {
            const bool has = it + NGW < I_SMALL; TrItem nxt = cur;
            if (has) { nxt = tr_decode_small(F, A, it + NGW); tr_load(nxt, tn, F.lane); }
            tr_store(cur, tv, F.lane);
            cur = nxt;
#pragma unroll
            for (int i = 0; i < 8; ++i) tv[i] = tn[i];
        }
    }
    { const float* x = A.in[0]; bf16_t* XB = (bf16_t*)(F.ws + WS_B);
      for (int m = gw * 4; m < M; m += NGW * 4) { f32x4 v[4][4];
#pragma unroll
          for (int r = 0; r < 4; ++r)
#pragma unroll
              for (int j = 0; j < 4; ++j) v[r][j] = ((const f32x4*)(x + (size_t)(m + r) * DM))[F.lane + 64 * j];
#pragma unroll
          for (int r = 0; r < 4; ++r)
#pragma unroll
              for (int j = 0; j < 4; ++j) ((u32x2*)(XB + (size_t)(m + r) * DM))[F.lane + 64 * j] = (u32x2){pk2(v[r][j][0], v[r][j][1]), pk2(v[r][j][2], v[r][j][3])}; } }
    { const float* wr = A.in[16]; bf16_t* WR = (bf16_t*)(F.ws + WS_WR);
      for (int i = (F.vcu * NWAVES + F.wave) * 64 + F.lane; i < 64 * 1024; i += NGW * 64) { const int e = i >> 10, k = i & 1023; const float v = wr[(size_t)k * 64 + e];
          const unsigned hb = f2bf(v); const float hf = __builtin_bit_cast(float, hb << 16); WR[i] = (bf16_t)hb; WR[65536 + i] = (bf16_t)f2bf(v - hf); } }
}

__device__ __forceinline__ void p2_attn_naive(Frame& F) {
    const bf16_t* Q = (const bf16_t*)(F.ws + WS_C); const bf16_t* Kb = Q + (size_t)M * 512; const bf16_t* Vb = Kb + (size_t)M * 512; bf16_t* MIX = (bf16_t*)(F.ws + WS_B);
    const int gw = F.vcu * NWAVES + F.wave, NGW = F.G * NWAVES, lane = F.lane;
    for (int item = gw; item < M * NH; item += NGW) {
        const int h = item & 7, bt = item >> 3, t = bt & (SEQ - 1), b = bt >> 12;
        const float q = bf2f(Q[(size_t)bt * 512 + h * 64 + lane]);
        const float slope2 = exp2f(-(float)(h + 1)) * LOG2E;
        float m = -INFINITY, l = 0.f, o = 0.f;
        for (int br = 0; br < 3; ++br) { const int dil = (br == 0) ? 1 : (br == 1 ? 4 : 16);
            for (int j = 0; j <= 128; ++j) { const int pos = t - j * dil; if (pos < 0) break;
                const size_t ro = (size_t)(b * SEQ + pos) * 512 + h * 64 + lane;
                const float kk = bf2f(Kb[ro]), vv = bf2f(Vb[ro]);
                const float s = wave_sum(q * kk) - slope2 * (float)(j * dil);
                const float mn = fmaxf(m, s); const float corr = exp2f(m - mn); const float pe = exp2f(s - mn);
                l = l * corr + pe; o = o * corr + pe * vv; m = mn; } }
        MIX[(size_t)bt * 1024 + h * 64 + lane] = (bf16_t)f2bf(o / l);
    }
}
__device__ __forceinline__ float gelu_tanh(float v) { return 0.5f * v * (1.f + tanhf(0.7978845608028654f * (v + 0.044715f * v * v * v))); }
__device__ __forceinline__ void p2_ssm_naive(Frame& F, const Args& A) {
    if (F.wave != 0) return;
    const bf16_t* U = (const bf16_t*)(F.ws + WS_D); bf16_t* Y = (bf16_t*)(F.ws + WS_D) + (size_t)M * 512;
    const float* lam_re = A.in[3]; const float* lam_im = A.in[4]; const float* log_dt = A.in[5]; const float* b_re = A.in[6]; const float* b_im = A.in[7];
    const float* c_re = A.in[8]; const float* c_im = A.in[9]; const float* d_skip = A.in[10];
    const int n = F.lane;
    for (int item = F.vcu; item < BATCH * NG; item += F.G) {
        const int b = item / NG, g = item % NG;
        const float lr = lam_re[g * NS + n], li = lam_im[g * NS + n], dt = expf(log_dt[g]);
        const float er = expf(lr * dt); const float ar = er * cosf(li * dt), ai = er * sinf(li * dt);
        const float den = lr * lr + li * li;
        const float gr = ((ar - 1.f) * lr + ai * li) / den, gi = (ai * lr - (ar - 1.f) * li) / den;
        float bbr[16], bbi[16], cr[16], ci[16];
#pragma unroll
        for (int c = 0; c < 16; ++c) { const float br = b_re[(g * NS + n) * GC + c], bi = b_im[(g * NS + n) * GC + c];
            bbr[c] = gr * br - gi * bi; bbi[c] = gr * bi + gi * br; cr[c] = c_re[(g * GC + c) * NS + n]; ci[c] = c_im[(g * GC + c) * NS + n]; }
        const float dsk = (n < 16) ? d_skip[g * GC + n] : 0.f;
        float sr = 0.f, si = 0.f;
        for (int t = 0; t < SEQ; ++t) {
            const u32x4* up = (const u32x4*)(U + (size_t)(b * SEQ + t) * 512 + g * GC);
            float u[16]; { f32x4 a0, a1, a2, a3; unpack8(up[0], a0, a1); unpack8(up[1], a2, a3);
#pragma unroll
                for (int c = 0; c < 4; ++c) { u[c] = a0[c]; u[4 + c] = a1[c]; u[8 + c] = a2[c]; u[12 + c] = a3[c]; } }
            float bur = 0.f, bui = 0.f;
#pragma unroll
            for (int c = 0; c < 16; ++c) { bur += bbr[c] * u[c]; bui += bbi[c] * u[c]; }
            const float nr = ar * sr - ai * si + bur, ni = ar * si + ai * sr + bui; sr = nr; si = ni;
            float my = 0.f, uc = 0.f;
#pragma unroll
            for (int c = 0; c < 16; ++c) { const float v = wave_sum(cr[c] * sr - ci[c] * si); if (n == c) { my = v; uc = u[c]; } }
            if (n < 16) Y[(size_t)(b * SEQ + t) * 512 + g * GC + n] = (bf16_t)f2bf(gelu_tanh(my + dsk * uc));
        }
    }
}

constexpr int P5_WB = 0, P5_BUF = 34816, P5_PART = 17408, P5_PITCH = 272, P5_SCR = 69632, P5_HIST = 104448, P5_BASEL = P5_HIST + 256, P5_RB = P5_HIST + 512, P5_GB = P5_HIST + 1024;
__device__ __forceinline__ void p5_ln_router(Frame& F, const Args& A, int fake) {
    const float* PRE = F.out; const f32x4* STATS = (const f32x4*)(F.ws + WS_STATS); const float* gam = A.in[14]; const float* bet = A.in[15]; const float* rbias = A.in[17];
    bf16_t* H = (bf16_t*)(F.ws + WS_B); unsigned char* H8 = F.ws + WS_H8; const bf16_t* WR = (const bf16_t*)(F.ws + WS_WR);
    int* LIST = (int*)(F.ws + WS_LIST); float* LISTW = (float*)(F.ws + WS_LISTW); int* LDEST = (int*)(F.ws + WS_LDEST); int* CNT = (int*)(F.ctl + CW_CNT);
    LAS unsigned char* lds = F.lds; LAS float* scr = (LAS float*)(lds + P5_SCR) + F.wave * (16 * 68); LAS int* hist = (LAS int*)(lds + P5_HIST); LAS int* basel = (LAS int*)(lds + P5_BASEL); LAS float* rb = (LAS float*)(lds + P5_RB);
    const int tid = F.tid, lane = F.lane, fr = lane & 15, g = lane >> 4;
    for (int rg = F.vcu; rg < M / 128; rg += F.G) {
        const int row = rg * 128 + F.wave * 16 + fr;
        if (tid < 64) { hist[tid] = 0; rb[tid] = rbias[tid]; }
        { LAS float* gbl = (LAS float*)(lds + P5_GB); for (int i = tid; i < 256; i += 512) { *(LAS f32x4*)(gbl + 4 * i) = *(const f32x4*)(gam + 4 * i); *(LAS f32x4*)(gbl + 1024 + 4 * i) = *(const f32x4*)(bet + 4 * i); } }
        float mean, rstd;
        { const f32x4 p0 = STATS[(size_t)row * 8 + 2 * g], p1 = STATS[(size_t)row * 8 + 2 * g + 1]; float s = (p0[0] + p0[2]) + (p1[0] + p1[2]), q = (p0[1] + p0[3]) + (p1[1] + p1[3]);
          s += __shfl_xor(s, 16); s += __shfl_xor(s, 32); q += __shfl_xor(q, 16); q += __shfl_xor(q, 32);
          mean = s * (1.f / DM); const float var = fmaxf(q * (1.f / DM) - mean * mean, 0.f); rstd = rsqrtf(var + LN_EPS); }
        u32x4 st[4];
#pragma unroll
        for (int i = 0; i < 4; ++i) { const int q = tid + 512 * i, part = q >> 10, rem = q & 1023, e = rem >> 4, pc = rem & 15; st[i] = *(const u32x4*)(WR + (size_t)part * 65536 + e * 1024 + pc * 8); }
        const float* prow = PRE + (size_t)row * DM + 8 * g;
        f32x4 pv[8], pn[8];
#pragma unroll
        for (int ks = 0; ks < 4; ++ks) { pv[2 * ks] = *(const f32x4*)(prow + ks * 32); pv[2 * ks + 1] = *(const f32x4*)(prow + ks * 32 + 4); }
#pragma unroll
        for (int i = 0; i < 4; ++i) { const int q = tid + 512 * i, part = q >> 10, rem = q & 1023, e = rem >> 4, pc = rem & 15; *(LAS u32x4*)(lds + P5_WB + part * P5_PART + e * P5_PITCH + pc * 16) = st[i]; }
        __syncthreads();
        f32x4 acc[4];
#pragma unroll
        for (int nt = 0; nt < 4; ++nt) acc[nt] = (f32x4){0.f, 0.f, 0.f, 0.f};
        const LAS float* gbl = (const LAS float*)(lds + P5_GB) + 8 * g;
#pragma unroll 1
        for (int kc = 0; kc < 8; ++kc) {
            if (kc < 7) {
#pragma unroll
                for (int i = 0; i < 4; ++i) { const int q = tid + 512 * i, part = q >> 10, rem = q & 1023, e = rem >> 4, pc = rem & 15; st[i] = *(const u32x4*)(WR + (size_t)part * 65536 + e * 1024 + (kc + 1) * 128 + pc * 8); }
#pragma unroll
                for (int ks = 0; ks < 4; ++ks) { pn[2 * ks] = *(const f32x4*)(prow + (kc + 1) * 128 + ks * 32); pn[2 * ks + 1] = *(const f32x4*)(prow + (kc + 1) * 128 + ks * 32 + 4); }
            }
            LAS unsigned char* wb = lds + P5_WB + (kc & 1) * P5_BUF;
#pragma unroll
            for (int ks = 0; ks < 4; ++ks) {
                const int kk = kc * 128 + ks * 32 + 8 * g;
                f32x4 v0 = pv[2 * ks], v1 = pv[2 * ks + 1];
                const f32x4 g0 = *(const LAS f32x4*)(gbl + kc * 128 + ks * 32), g1 = *(const LAS f32x4*)(gbl + kc * 128 + ks * 32 + 4), b0 = *(const LAS f32x4*)(gbl + 1024 + kc * 128 + ks * 32), b1 = *(const LAS f32x4*)(gbl + 1024 + kc * 128 + ks * 32 + 4);
                v0 = (v0 - mean) * rstd * g0 + b0; v1 = (v1 - mean) * rstd * g1 + b1;
                const u32x4 hw = pack8(v0, v1);
                *(u32x4*)(H + (size_t)row * DM + kk) = hw;
                { int p0 = __builtin_amdgcn_cvt_pk_fp8_f32(v0[0], v0[1], 0, false); p0 = __builtin_amdgcn_cvt_pk_fp8_f32(v0[2], v0[3], p0, true); int p1 = __builtin_amdgcn_cvt_pk_fp8_f32(v1[0], v1[1], 0, false); p1 = __builtin_amdgcn_cvt_pk_fp8_f32(v1[2], v1[3], p1, true);
                  *(u32x2*)(H8 + (size_t)row * DM + kk) = (u32x2){(unsigned)p0, (unsigned)p1}; }
                f32x4 h0, h1; unpack8(hw, h0, h1);
                const u32x4 lw = pack8(v0 - h0, v1 - h1);
                const bf16x8 ahi = __builtin_bit_cast(bf16x8, hw), alo = __builtin_bit_cast(bf16x8, lw);
#pragma unroll
                for (int nt = 0; nt < 4; ++nt) {
                    const bf16x8 bhi = *(const LAS bf16x8*)(wb + (16 * nt + fr) * P5_PITCH + (ks * 32 + 8 * g) * 2);
                    const bf16x8 blo = *(const LAS bf16x8*)(wb + P5_PART + (16 * nt + fr) * P5_PITCH + (ks * 32 + 8 * g) * 2);
                    acc[nt] = __builtin_amdgcn_mfma_f32_16x16x32_bf16(ahi, bhi, acc[nt], 0, 0, 0);
                    acc[nt] = __builtin_amdgcn_mfma_f32_16x16x32_bf16(alo, bhi, acc[nt], 0, 0, 0);
                    acc[nt] = __builtin_amdgcn_mfma_f32_16x16x32_bf16(ahi, blo, acc[nt], 0, 0, 0);
                }
            }
            if (kc < 7) {
                LAS unsigned char* wn = lds + P5_WB + ((kc + 1) & 1) * P5_BUF;
#pragma unroll
                for (int i = 0; i < 4; ++i) { const int q = tid + 512 * i, part = q >> 10, rem = q & 1023, e = rem >> 4, pc = rem & 15; *(LAS u32x4*)(wn + part * P5_PART + e * P5_PITCH + pc * 16) = st[i]; }
#pragma unroll
                for (int i = 0; i < 8; ++i) pv[i] = pn[i];
            }
            __syncthreads();
        }
        if (fake) continue;
#pragma unroll
        for (int nt = 0; nt < 4; ++nt)
#pragma unroll
            for (int r = 0; r < 4; ++r) scr[(4 * g + r) * 68 + 16 * nt + fr] = sigmoidf_(acc[nt][r]);
        __syncthreads();
        const int trow = lane >> 2, q4 = lane & 3;
        float sc[16], cand[16];
        { const LAS f32x4* sp = (const LAS f32x4*)(scr + trow * 68 + 16 * q4); const LAS f32x4* bp = (const LAS f32x4*)(rb + 16 * q4);
#pragma unroll
          for (int j = 0; j < 4; ++j) { const f32x4 s4 = sp[j], b4 = bp[j];
#pragma unroll
              for (int e = 0; e < 4; ++e) { sc[4 * j + e] = s4[e]; cand[4 * j + e] = s4[e] + b4[e]; } } }
        float gsc[2];
#pragma unroll
        for (int h = 0; h < 2; ++h) { float m1 = -INFINITY, m2 = -INFINITY;
#pragma unroll
            for (int j = 0; j < 8; ++j) { const float v = cand[8 * h + j]; const float lo_ = fminf(m1, v); m1 = fmaxf(m1, v); m2 = fmaxf(m2, lo_); }
            gsc[h] = m1 + m2; }
        float gs[8];
#pragma unroll
        for (int k = 0; k < 4; ++k) { gs[2 * k] = __shfl(gsc[0], (lane & ~3) + k); gs[2 * k + 1] = __shfl(gsc[1], (lane & ~3) + k); }
        unsigned gm = 0;
#pragma unroll
        for (int it = 0; it < 4; ++it) { float best = -INFINITY; int bi = 0;
#pragma unroll
            for (int gg = 0; gg < 8; ++gg) { const bool ok = !((gm >> gg) & 1u) && gs[gg] > best; best = ok ? gs[gg] : best; bi = ok ? gg : bi; }
            gm |= 1u << bi; }
#pragma unroll
        for (int j = 0; j < 16; ++j) if (!((gm >> (2 * q4 + (j >> 3))) & 1u)) cand[j] = -INFINITY;
        int idx[8]; float wv[8]; float wsum = 0.f;
#pragma unroll
        for (int it = 0; it < 8; ++it) {
            float bv = -INFINITY; int be = 0;
#pragma unroll
            for (int j = 0; j < 16; ++j) { const bool ok = cand[j] > bv; bv = ok ? cand[j] : bv; be = ok ? j : be; }
            be += 16 * q4;
#pragma unroll
            for (int o = 1; o < 4; o <<= 1) { const float ov = __shfl_xor(bv, o); const int oe = __shfl_xor(be, o); const bool take = (ov > bv) || (ov == bv && oe < be); bv = take ? ov : bv; be = take ? oe : be; }
            float mysc = 0.f;
#pragma unroll
            for (int j = 0; j < 16; ++j) { const bool hit = (be == 16 * q4 + j); cand[j] = hit ? -INFINITY : cand[j]; mysc = hit ? sc[j] : mysc; }
            const float w = __shfl(mysc, (lane & ~3) + (be >> 4));
            idx[it] = be; wv[it] = w; wsum += w;
        }
        int myrk[2];
#pragma unroll
        for (int h = 0; h < 2; ++h) { int e = 0;
#pragma unroll
            for (int it = 0; it < 8; ++it) if (it == 2 * q4 + h) e = idx[it];
            myrk[h] = __hip_atomic_fetch_add(hist + e, 1, __ATOMIC_RELAXED, __HIP_MEMORY_SCOPE_WORKGROUP); }
        __syncthreads();
        const int tq = rg >> 6;
        if (tid < 64) { const int c = hist[tid]; basel[tid] = c ? atomicAdd(CNT + tq * 64 + tid, c) : 0; }
        __syncthreads();
        { const int tok = rg * 128 + F.wave * 16 + trow; const float inv = ROUTED_SCALE / wsum;
#pragma unroll
          for (int h = 0; h < 2; ++h) { int e = 0; float w = 0.f;
#pragma unroll
              for (int it = 0; it < 8; ++it) if (it == 2 * q4 + h) { e = idx[it]; w = wv[it]; }
              const int pos = basel[e] + myrk[h]; const size_t li = (size_t)(tq * 64 + e) * LCAP + pos;
              LIST[li] = tok; LISTW[li] = w * inv; LDEST[li] = (tok - tq * TQ_TOK) * 9 + 2 * q4 + h; } }
        __syncthreads();
    }
}

__device__ __forceinline__ void p_combine_ln2(Frame& F, const Args& A, int tq, const unsigned char* SLAB, int b0, int nb) {
    const bf16_t* BASE = (const bf16_t*)(F.ws + WS_BASE); const float* gam = A.in[26]; const float* bet = A.in[27];
    if (F.vcu < b0 || F.vcu >= b0 + nb) return;
    const int gw = (F.vcu - b0) * NWAVES + F.wave, NGW = nb * NWAVES, lane = F.lane;
    for (int tl = gw; tl < TQ_TOK; tl += NGW) {
        const int t = tq * TQ_TOK + tl;
        u32x4 w[9]; u32x4 bw[2];
#pragma unroll
        for (int h = 0; h < 2; ++h) bw[h] = *(const u32x4*)(BASE + (size_t)t * 1024 + lane * 16 + h * 8);
#pragma unroll
        for (int k = 0; k < 9; ++k) w[k] = *(const u32x4*)(SLAB + ((size_t)tl * 9 + k) * 1024 + lane * 16);
        f32x4 s4[4];
#pragma unroll
        for (int j = 0; j < 4; ++j) s4[j] = (f32x4){0.f, 0.f, 0.f, 0.f};
#pragma unroll
        for (int k = 0; k < 9; ++k)
#pragma unroll
            for (int j = 0; j < 4; ++j) { const f32x2 d0 = __builtin_amdgcn_cvt_pk_f32_fp8((int)w[k][j], false), d1 = __builtin_amdgcn_cvt_pk_f32_fp8((int)w[k][j], true); s4[j] += (f32x4){d0[0], d0[1], d1[0], d1[1]}; }
        f32x4 v[4]; unpack8(bw[0], v[0], v[1]); unpack8(bw[1], v[2], v[3]);
#pragma unroll
        for (int j = 0; j < 4; ++j) v[j] += s4[j] * 0.0625f;
        float s = 0.f;
#pragma unroll
        for (int j = 0; j < 4; ++j) s += (v[j][0] + v[j][1]) + (v[j][2] + v[j][3]);
        const float mean = wave_sum(s) * (1.f / DM); float s2 = 0.f;
#pragma unroll
        for (int j = 0; j < 4; ++j) { v[j] = v[j] - mean; s2 += (v[j][0] * v[j][0] + v[j][1] * v[j][1]) + (v[j][2] * v[j][2] + v[j][3] * v[j][3]); }
        const float rstd = rsqrtf(wave_sum(s2) * (1.f / DM) + LN_EPS);
        float* op = F.out + (size_t)t * DM + lane * 16;
#pragma unroll
        for (int j = 0; j < 4; ++j) { const f32x4 gg = *(const f32x4*)(gam + lane * 16 + 4 * j), bb = *(const f32x4*)(bet + lane * 16 + 4 * j); *(f32x4*)(op + 4 * j) = v[j] * rstd * gg + bb; }
    }
}
__device__ __forceinline__ void p_convert_p(Frame& F, const Args& A) {
    const float* P = A.in[1]; bf16_t* PB = (bf16_t*)F.out;
    const int gw = F.vcu * NWAVES + F.wave, NGW = F.G * NWAVES;
    for (int m = gw * 8; m < M; m += NGW * 8) { f32x4 v[8];
#pragma unroll
        for (int r = 0; r < 8; ++r) v[r] = ((const f32x4*)(P + (size_t)(m + r) * PLE))[F.lane];
#pragma unroll
        for (int r = 0; r < 8; ++r) ((u32x2*)(PB + (size_t)(m + r) * PLE))[F.lane] = (u32x2){pk2(v[r][0], v[r][1]), pk2(v[r][2], v[r][3])}; }
}

constexpr size_t WS_KT = WS_E, WS_EM = WS_E + 2 * MiB, WS_MY = WS_E + 12 * MiB, WS_A64 = WS_E + 22 * MiB;
constexpr int KT_ELEMS = 65 * 256;
__device__ __forceinline__ void p0_ssm_tables(Frame& F, const Args& A, int gi, int sl) {
    const float* lam_re = A.in[3]; const float* lam_im = A.in[4]; const float* log_dt = A.in[5]; const float* b_re = A.in[6]; const float* b_im = A.in[7];
    const float* c_re = A.in[8]; const float* c_im = A.in[9];
    LAS f32x2* POW = (LAS f32x2*)(F.lds);
    LAS f32x2* BB = (LAS f32x2*)(F.lds + 33280);
    LAS f32x2* CC = (LAS f32x2*)(F.lds + 33280 + 8192);
    const int tid = F.tid; const float dt = expf(log_dt[gi]);
    __syncthreads();
    for (int idx = tid; idx < 65 * 64; idx += 512) { const int d = idx >> 6, n = idx & 63; const float lr = lam_re[gi * NS + n], li = lam_im[gi * NS + n];
        const float mag = expf(lr * dt * (float)d); float sn, cs; sincosf(li * dt * (float)d, &sn, &cs); POW[idx] = (f32x2){mag * cs, mag * sn}; }
    for (int idx = tid; idx < 64 * 16; idx += 512) { const int n = idx >> 4, c = idx & 15; const float lr = lam_re[gi * NS + n], li = lam_im[gi * NS + n];
        const float er = expf(lr * dt); float sn, cs; sincosf(li * dt, &sn, &cs); const float ar = er * cs, ai = er * sn, den = lr * lr + li * li;
        const float gr = ((ar - 1.f) * lr + ai * li) / den, gim = (ai * lr - (ar - 1.f) * li) / den;
        const float br = b_re[(gi * NS + n) * GC + c], bi = b_im[(gi * NS + n) * GC + c];
        BB[idx] = (f32x2){gr * br - gim * bi, gr * bi + gim * br}; }
    for (int idx = tid; idx < 16 * 64; idx += 512) CC[idx] = (f32x2){c_re[gi * 1024 + idx], c_im[gi * 1024 + idx]};
    __syncthreads();
    bf16_t* KT = (bf16_t*)(F.ws + WS_KT) + (size_t)gi * KT_ELEMS; bf16_t* EM = (bf16_t*)(F.ws + WS_EM) + (size_t)gi * 128 * 1024; bf16_t* MY = (bf16_t*)(F.ws + WS_MY) + (size_t)gi * 1024 * 128;
    for (int idx = sl * (KT_ELEMS / 8) + tid; idx < (sl + 1) * (KT_ELEMS / 8); idx += 512) { const int dd = idx >> 8, c = (idx >> 4) & 15, cp = idx & 15; float acc = 0.f;
        if (dd > 0) { const int d = dd - 1;
            for (int n = 0; n < 64; ++n) { const f32x2 p = POW[d * 64 + n], bb = BB[n * 16 + cp], cc = CC[c * 64 + n];
                const float wr = p[0] * bb[0] - p[1] * bb[1], wi = p[0] * bb[1] + p[1] * bb[0]; acc += cc[0] * wr - cc[1] * wi; } }
        KT[idx] = (bf16_t)f2bf(acc); }
    for (int idx = sl * 16384 + tid; idx < (sl + 1) * 16384; idx += 512) { const int ri = idx >> 10, k = idx & 1023, n = ri & 63, part = ri >> 6, j = k >> 4, cp = k & 15;
        const f32x2 p = POW[(63 - j) * 64 + n], bb = BB[n * 16 + cp]; const float v = part == 0 ? p[0] * bb[0] - p[1] * bb[1] : p[0] * bb[1] + p[1] * bb[0];
        EM[idx] = (bf16_t)f2bf(v); }
    for (int idx = sl * 16384 + tid; idx < (sl + 1) * 16384; idx += 512) { const int row = idx >> 7, ki = idx & 127, t = row >> 4, c = row & 15, n = ki & 63, part = ki >> 6;
        const f32x2 p = POW[(t + 1) * 64 + n], cc = CC[c * 64 + n]; const float v = part == 0 ? cc[0] * p[0] - cc[1] * p[1] : -(cc[0] * p[1] + cc[1] * p[0]);
        MY[idx] = (bf16_t)f2bf(v); }
    if (sl == 0 && tid < 64) ((f32x2*)(F.ws + WS_A64))[gi * 64 + tid] = POW[64 * 64 + tid];
    __syncthreads();
}

__device__ __forceinline__ float gelu_tanh_f(float v) { const float u = 0.7978845608028654f * (v + 0.044715f * v * v * v); const float e = __expf(2.f * u); return v * (1.f - 1.f / (e + 1.f)); }
constexpr int SS_KT = 0, SS_ES = 33280, SS_SP = 66560, SS_SPP = 136;
__device__ __forceinline__ void ssm_unit(Frame& F, const Args& A, int b, int gi, int fake) {
    const bf16_t* U = (const bf16_t*)(F.ws + WS_D); bf16_t* Y = (bf16_t*)(F.ws + WS_D) + (size_t)M * 512; const float* d_skip = A.in[10];
    const bf16_t* KTg = (const bf16_t*)(F.ws + WS_KT) + (size_t)gi * KT_ELEMS; const bf16_t* EM = (const bf16_t*)(F.ws + WS_EM) + (size_t)gi * 128 * 1024; const bf16_t* MY = (const bf16_t*)(F.ws + WS_MY) + (size_t)gi * 1024 * 128;
    LAS unsigned char* lds = F.lds; LAS bf16_t* KT = (LAS bf16_t*)(lds + SS_KT); LAS float* ES = (LAS float*)(lds + SS_ES); LAS bf16_t* SP = (LAS bf16_t*)(lds + SS_SP);
    const int tid = F.tid, lane = F.lane, fr = lane & 15, g = lane >> 4, w = F.wave, nt = w & 3, wh = w >> 2;
    __syncthreads();
    for (int i = tid; i < KT_ELEMS / 8; i += 512) ((LAS u32x4*)KT)[i] = ((const u32x4*)KTg)[i];
    const size_t tokb = (size_t)b * SEQ + (size_t)(16 * nt + fr) * 64;
    const bf16_t* ub = U + tokb * 512 + gi * 16 + 8 * (g & 1) + (size_t)(g >> 1) * 512;
    if (!(fake & 2)) { f32x4 acc[4];
#pragma unroll
      for (int i = 0; i < 4; ++i) acc[i] = (f32x4){0.f, 0.f, 0.f, 0.f};
      const bf16_t* ea = EM + (size_t)(wh * 64 + fr) * 1024 + 8 * g;
      bf16x8 cb[4], ca[4][4], nb[4], na[4][4];
#define SS_LDG(B_, A_, k0) do { _Pragma("unroll") for (int q = 0; q < 4; ++q) { B_[q] = *(const bf16x8*)(ub + (size_t)(fake ? 0 : (k0) + q) * 1024); \
          _Pragma("unroll") for (int i = 0; i < 4; ++i) A_[q][i] = *(const bf16x8*)(ea + (size_t)i * 16 * 1024 + (fake ? 0 : (k0) + q) * 32); } } while (0)
      SS_LDG(cb, ca, 0);
#pragma unroll 1
      for (int kg = 0; kg < 8; ++kg) {
          if (kg < 7) SS_LDG(nb, na, 4 * (kg + 1));
          __builtin_amdgcn_sched_barrier(0);
#pragma unroll
          for (int q = 0; q < 4; ++q)
#pragma unroll
              for (int i = 0; i < 4; ++i) acc[i] = __builtin_amdgcn_mfma_f32_16x16x32_bf16(ca[q][i], cb[q], acc[i], 0, 0, 0);
#pragma unroll
          for (int q = 0; q < 4; ++q) { cb[q] = nb[q];
#pragma unroll
              for (int i = 0; i < 4; ++i) ca[q][i] = na[q][i]; }
      }
#undef SS_LDG
#pragma unroll
      for (int i = 0; i < 4; ++i)
#pragma unroll
          for (int r = 0; r < 4; ++r) ES[(wh * 64 + i * 16 + 4 * g + r) * 65 + 16 * nt + fr] = acc[i][r]; }
    __syncthreads();
    if (tid < 64 && !(fake & 4)) { const f32x2 a = ((const f32x2*)(F.ws + WS_A64))[gi * 64 + tid]; float sr = 0.f, si = 0.f;
        for (int c = 0; c < 64; ++c) { SP[c * SS_SPP + tid] = (bf16_t)f2bf(sr); SP[c * SS_SPP + 64 + tid] = (bf16_t)f2bf(si);
            const float er = ES[tid * 65 + c], ei = ES[(64 + tid) * 65 + c]; const float nr = a[0] * sr - a[1] * si + er, ni = a[0] * si + a[1] * sr + ei; sr = nr; si = ni; } }
    __syncthreads();
    { const f32x4 dsk = *(const f32x4*)(d_skip + gi * 16 + 4 * g);
      const LAS bf16_t* ka = KT + fr * 16 + 8 * (g & 1) + (1 - (g >> 1) + wh) * 256;
#pragma unroll 1
      for (int B = 0; B < ((fake & 8) ? 0 : 4); ++B) {
          f32x4 acc[8];
#pragma unroll
          for (int i = 0; i < 8; ++i) acc[i] = (f32x4){0.f, 0.f, 0.f, 0.f};
          const bf16_t* ma = MY + (size_t)((16 * B) * 16 + wh * 16 + fr) * 128 + 8 * g;
#pragma unroll
          for (int ks = 0; ks < 4; ++ks) { const bf16x8 bf = *(const LAS bf16x8*)(SP + (16 * nt + fr) * SS_SPP + ks * 32 + 8 * g);
              bf16x8 af[8];
#pragma unroll
              for (int i = 0; i < 8; ++i) af[i] = *(const bf16x8*)(ma + (fake ? (size_t)0 : (size_t)i * 32 * 128 + ks * 32));
              __builtin_amdgcn_sched_barrier(0);
#pragma unroll
              for (int i = 0; i < 8; ++i) acc[i] = __builtin_amdgcn_mfma_f32_16x16x32_bf16(af[i], bf, acc[i], 0, 0, 0);
              __builtin_amdgcn_sched_barrier(0); }
          bf16x8 bn = *(const bf16x8*)ub;
#pragma unroll 1
          for (int ks = 0; ks <= 8 * B; ++ks) {
              const bf16x8 bf = bn; bn = *(const bf16x8*)(ub + (size_t)(fake ? 0 : ks + 1) * 1024);
              const LAS bf16_t* kk = ka + (8 * B - ks) * 512;
              bf16x8 af[8];
#pragma unroll
              for (int i = 0; i < 8; ++i) af[i] = *(const LAS bf16x8*)(kk + i * 512);
              __builtin_amdgcn_sched_barrier(0);
#pragma unroll
              for (int i = 0; i < 8; ++i) acc[i] = __builtin_amdgcn_mfma_f32_16x16x32_bf16(af[i], bf, acc[i], 0, 0, 0);
              __builtin_amdgcn_sched_barrier(0); }
#pragma unroll
          for (int d = 1; d < 8; ++d) {
              const bf16x8 bf = bn; if (d < 7) bn = *(const bf16x8*)(ub + (size_t)(fake ? 0 : 8 * B + d + 1) * 1024);
#pragma unroll
              for (int i = d; i < 8; ++i) { const bf16x8 af = *(const LAS bf16x8*)(ka + (i - d) * 512); acc[i] = __builtin_amdgcn_mfma_f32_16x16x32_bf16(af, bf, acc[i], 0, 0, 0); } }
#pragma unroll
          for (int i = 0; i < 8; ++i) { const int t = 2 * (8 * B + i) + wh; const size_t off = (tokb + t) * 512 + gi * 16 + 4 * g;
              const u32x2 uw = *(const u32x2*)(U + off); const f32x4 uv = (f32x4){bflo(uw.x), bfhi(uw.x), bflo(uw.y), bfhi(uw.y)};
              f32x4 y = acc[i] + dsk * uv;
#pragma unroll
              for (int r = 0; r < 4; ++r) y[r] = gelu_tanh_f(y[r]);
              if (!fake) *(u32x2*)(Y + off) = (u32x2){cvtpk(y[0], y[1]), cvtpk(y[2], y[3])}; }
      } }
}

constexpr int AT_QU = 512  , AT_OST = 0, AT_OP = 72  , AT_M = 73728, AT_L = 75776, AT_V = 77824, AT_VW = 4608, AT_VP = 144;
typedef short s16x4 __attribute__((ext_vector_type(4)));
__device__ __forceinline__ s16x4 vtr(const LAS unsigned char* p) { return __builtin_bit_cast(s16x4, __builtin_amdgcn_ds_read_tr16_b64_v4i16((LAS s16x4*)p)); }
__device__ __forceinline__ float xmax16(float x) { auto r = __builtin_amdgcn_permlane16_swap(__float_as_uint(x), __float_as_uint(x), false, false); return fmaxf(__uint_as_float(r[0]), __uint_as_float(r[1])); }
__device__ __forceinline__ float xmax32(float x) { auto r = __builtin_amdgcn_permlane32_swap(__float_as_uint(x), __float_as_uint(x), false, false); return fmaxf(__uint_as_float(r[0]), __uint_as_float(r[1])); }
template <bool SHARED>
__device__ __forceinline__ void attn_branch(Frame& F, int b, int h, int t0, int br, int r, int pp, int fake) {
    const bf16_t* Qg = (const bf16_t*)(F.ws + WS_C); bf16_t* MIXo = (bf16_t*)(F.ws + WS_B);
    LAS unsigned char* lds = F.lds; LAS bf16_t* Ost = (LAS bf16_t*)(lds + AT_OST); LAS float* Mst = (LAS float*)(lds + AT_M); LAS float* Lst = (LAS float*)(lds + AT_L);
    const int lane = F.lane, fr = lane & 15, g = lane >> 4;
    const float slope2 = exp2f(-(float)(h + 1)) * LOG2E, sr = slope2 * (float)r;
    const size_t rowb = (size_t)b * SEQ;
    const int vrow = lane >> 3, vch = lane & 7;
    constexpr int NS_ = SHARED ? 1 : 2;
    int qpos[2], lo[2], hi[2], k0s[NS_]; bf16x8 qf0[2], qf1[2]; float m[2], l[2]; f32x4 o[2][4]; bf16x8 kf[NS_][2][2]; u32x4 vr[NS_][4]; f32x4 biasC[2][2];
    LAS unsigned char* vb[NS_]; const LAS unsigned char* trp[NS_];
#pragma unroll
    for (int X = 0; X < 2; ++X) {
        int base;
        if (SHARED) { const int p = F.wave + 8 * pp, cls = p % r, pi = p / r; base = t0 + cls + (2 * pi + X) * 16 * r; }
        else { const int s = F.wave + 8 * X; base = t0 + s; }
        qpos[X] = base + r * fr;
        const int k0 = (SHARED ? base - 16 * r * X : base) - 128 * r;
        if (X < NS_) k0s[X < NS_ ? X : 0] = k0;
        const int nmin = k0 < 0 ? (-k0 + r - 1) / r : 0, sh = SHARED ? 16 * X : 0;
        lo[X] = (fr + sh) > nmin ? (fr + sh) : nmin; hi[X] = fr + sh + 128;
        const bf16_t* qp = Qg + (rowb + qpos[X]) * 512 + h * 64 + 8 * g; qf0[X] = *(const bf16x8*)qp; qf1[X] = *(const bf16x8*)(qp + 32);
        m[X] = -1e30f; l[X] = 0.f;
#pragma unroll
        for (int dt = 0; dt < 4; ++dt) o[X][dt] = (f32x4){0.f, 0.f, 0.f, 0.f};
#pragma unroll
        for (int T = 0; T < 2; ++T)
#pragma unroll
            for (int rr = 0; rr < 4; ++rr) biasC[X][T][rr] = sr * (float)(16 * T + 4 * g + rr - sh - 128 - fr);
    }
    const __amdgpu_buffer_rsrc_t rs = __builtin_amdgcn_make_buffer_rsrc((void*)F.ws, 0, 0x7fffffff, 0x00020000);
    int koff[NS_][2], voff[NS_][4], nminu[NS_];
#pragma unroll
    for (int Y = 0; Y < NS_; ++Y) {
        vb[Y] = lds + AT_V + F.wave * AT_VW; trp[Y] = vb[Y] + (4 * g + (fr >> 2)) * AT_VP + (fr & 3) * 8;
        nminu[Y] = k0s[Y] < 0 ? (-k0s[Y] + r - 1) / r : 0;
#pragma unroll
        for (int T = 0; T < 2; ++T) koff[Y][T] = (int)(WS_C + (size_t)M * 1024) + (int)((((long)rowb + k0s[Y] + r * (16 * T + fr)) * 512 + h * 64 + 8 * g) * 2);
#pragma unroll
        for (int i = 0; i < 4; ++i) voff[Y][i] = (int)(WS_C + (size_t)M * 2048) + (int)((((long)rowb + k0s[Y] + r * (vrow + 8 * i)) * 512 + h * 64 + vch * 8) * 2);
    }
    const int kstepb = fake ? 0 : 32768 * r;
#define AT_LOAD(Y, n0) do { const int so_ = ((n0) >> 5) * kstepb; _Pragma("unroll") for (int T = 0; T < 2; ++T) { \
            kf[Y][T][0] = __builtin_bit_cast(bf16x8, __builtin_amdgcn_raw_buffer_load_b128(rs, koff[Y][T], so_, 0)); kf[Y][T][1] = __builtin_bit_cast(bf16x8, __builtin_amdgcn_raw_buffer_load_b128(rs, koff[Y][T] + 64, so_, 0)); } \
        _Pragma("unroll") for (int i = 0; i < 4; ++i) vr[Y][i] = __builtin_amdgcn_raw_buffer_load_b128(rs, voff[Y][i], so_, 0); } while (0)
#pragma unroll
    for (int Y = 0; Y < NS_; ++Y) AT_LOAD(Y, 0);
#pragma unroll 1
    for (int st = 0; st < 5; ++st) {
        const int n0 = st * 32; f32x4 sT[2][2]; bf16x8 pb[2];
#pragma unroll
        for (int Y = 0; Y < NS_; ++Y)
#pragma unroll
            for (int i = 0; i < 4; ++i) *(LAS u32x4*)(vb[Y] + (vrow + 8 * i) * AT_VP + vch * 16) = vr[Y][i];
#pragma unroll
        for (int X = 0; X < 2; ++X)
#pragma unroll
            for (int T = 0; T < 2; ++T) { constexpr int dummy = 0; (void)dummy; const int Y = SHARED ? 0 : X;
                sT[X][T] = __builtin_amdgcn_mfma_f32_16x16x32_bf16(kf[Y][T][0], qf0[X], biasC[X][T], 0, 0, 0); sT[X][T] = __builtin_amdgcn_mfma_f32_16x16x32_bf16(kf[Y][T][1], qf1[X], sT[X][T], 0, 0, 0); }
        if (st < 4) {
#pragma unroll
            for (int Y = 0; Y < NS_; ++Y) AT_LOAD(Y, n0 + 32); }
        const float off = sr * (float)n0;
#pragma unroll
        for (int X = 0; X < 2; ++X) {
            const int Y = SHARED ? 0 : X;
            const bool full = (st >= 1) && (st <= 3) && (n0 >= nminu[Y]);
            if (!full) { const unsigned span = (unsigned)(hi[X] - lo[X]);
#pragma unroll
                for (int T = 0; T < 2; ++T)
#pragma unroll
                    for (int rr = 0; rr < 4; ++rr) { const int n = n0 + 16 * T + 4 * g + rr; if ((unsigned)(n - lo[X]) > span) sT[X][T][rr] = -1e30f; } }
            float pmax = fmaxf(fmaxf(fmaxf(sT[X][0][0], sT[X][0][1]), fmaxf(sT[X][0][2], sT[X][0][3])), fmaxf(fmaxf(sT[X][1][0], sT[X][1][1]), fmaxf(sT[X][1][2], sT[X][1][3])));
            pmax = xmax32(xmax16(pmax)) + off;
            const float mn = fmaxf(m[X], pmax);
            if (__any(mn > m[X])) { const float f = __builtin_amdgcn_exp2f(m[X] - mn); l[X] *= f;
#pragma unroll
                for (int dt = 0; dt < 4; ++dt) o[X][dt] = o[X][dt] * f; }
            m[X] = mn; const float ml = mn - off; float ps = 0.f;
#pragma unroll
            for (int T = 0; T < 2; ++T)
#pragma unroll
                for (int rr = 0; rr < 4; ++rr) { const float p = __builtin_amdgcn_exp2f(sT[X][T][rr] - ml); sT[X][T][rr] = p; ps += p; }
            l[X] += ps;
            const u32x4 pw = (u32x4){cvtpk(sT[X][0][0], sT[X][0][1]), cvtpk(sT[X][0][2], sT[X][0][3]), cvtpk(sT[X][1][0], sT[X][1][1]), cvtpk(sT[X][1][2], sT[X][1][3])};
            pb[X] = __builtin_bit_cast(bf16x8, pw);
        }
#pragma unroll
        for (int dt = 0; dt < 4; ++dt) {
            bf16x8 vf[NS_];
#pragma unroll
            for (int Y = 0; Y < NS_; ++Y) { const s16x4 lo4 = vtr(trp[Y] + dt * 32), hi4 = vtr(trp[Y] + 16 * AT_VP + dt * 32); vf[Y] = (bf16x8){lo4[0], lo4[1], lo4[2], lo4[3], hi4[0], hi4[1], hi4[2], hi4[3]}; }
#pragma unroll
            for (int X = 0; X < 2; ++X) o[X][dt] = __builtin_amdgcn_mfma_f32_16x16x32_bf16(vf[SHARED ? 0 : X], pb[X], o[X][dt], 0, 0, 0);
        }
    }
#undef AT_LOAD
#pragma unroll
    for (int X = 0; X < 2; ++X) {
        float lx = l[X]; lx += __shfl_xor(lx, 16); lx += __shfl_xor(lx, 32); float mx = m[X];
        const int qi = qpos[X] - t0;
        if (br > 0) { const float ms = Mst[qi], ls = Lst[qi]; const float mn = fmaxf(mx, ms), f1 = __builtin_amdgcn_exp2f(mx - mn), f2 = __builtin_amdgcn_exp2f(ms - mn);
#pragma unroll
            for (int dt = 0; dt < 4; ++dt) { const u32x2 ow = *(const LAS u32x2*)(Ost + qi * AT_OP + 16 * dt + 4 * g); const f32x4 os = (f32x4){bflo(ow.x), bfhi(ow.x), bflo(ow.y), bfhi(ow.y)}; o[X][dt] = o[X][dt] * f1 + os * f2; }
            lx = lx * f1 + ls * f2; mx = mn; }
        if (br < 2) {
#pragma unroll
            for (int dt = 0; dt < 4; ++dt) *(LAS u32x2*)(Ost + qi * AT_OP + 16 * dt + 4 * g) = (u32x2){cvtpk(o[X][dt][0], o[X][dt][1]), cvtpk(o[X][dt][2], o[X][dt][3])};
            if (g == 0) { Mst[qi] = mx; Lst[qi] = lx; }
        } else if (!fake) { const float inv = 1.f / lx; bf16_t* op = MIXo + (rowb + qpos[X]) * 1024 + h * 64 + 4 * g;
#pragma unroll
            for (int dt = 0; dt < 4; ++dt) { const f32x4 v = o[X][dt] * inv; *(u32x2*)(op + 16 * dt) = (u32x2){cvtpk(v[0], v[1]), cvtpk(v[2], v[3])}; } }
    }
}
struct CvtPend { int cur; bool has; TrItem it; f32x4 tv[8]; };
__device__ __forceinline__ void cvt_step(Frame& F, const Args& A, CvtPend& P) {
    if (P.has) tr_store(P.it, P.tv, F.lane);
    P.has = P.cur < I_EXP;
    if (P.has) { P.it = tr_decode_exp(F, A, P.cur); tr_load(P.it, P.tv, F.lane); P.cur += F.G * NWAVES; }
}
__device__ __forceinline__ void attn_unit(Frame& F, const Args& A, int b, int h, int t0, int fake, CvtPend& P) {
#pragma unroll 1
    for (int br = 0; br < 3; ++br) { const int r = br == 0 ? 16 : (br == 1 ? 4 : 1);
#pragma unroll 1
        for (int pp = 0; pp < 2; ++pp) { attn_branch<true>(F, b, h, t0, br, r, pp, fake); if (!fake) cvt_step(F, A, P); }
        __syncthreads(); }
}
__device__ __forceinline__ void p2_mixers(Frame& F, const Args& A) {
    CvtPend P; P.cur = F.vcu * NWAVES + F.wave; P.has = false;
#ifndef REP_SSM
#define REP_SSM 1
#endif
#ifndef REP_ATT
#define REP_ATT 1
#endif
#ifndef SSM_FAKE
#define SSM_FAKE 0
#endif
#ifndef ATT_FAKE
#define ATT_FAKE 0
#endif
    for (int rp = 0; rp < REP_SSM; ++rp)
    for (int u = F.vcu; u < BATCH * NG; u += F.G) ssm_unit(F, A, u / NG, u % NG, rp > 0 ? SSM_FAKE : 0);
    __syncthreads();
    for (int rp = 0; rp < REP_ATT; ++rp)
    for (int u = F.vcu; u < BATCH * NH * (SEQ / AT_QU); u += F.G) { const int qb = u & 7, bh = u >> 3; attn_unit(F, A, bh >> 3, bh & 7, qb * AT_QU, rp > 0 ? ATT_FAKE : 0, P); }
    if (P.has) tr_store(P.it, P.tv, F.lane);
    (void)cvt_expert_burst(F, A, P.cur, 1 << 20);
}

constexpr int N_PHASES = 9;
__global__ void __launch_bounds__(NWAVES * 64, 2) mk_fwd(Args args) {
    extern __shared__ __attribute__((aligned(16))) unsigned char lds_raw[];
    Frame F;
    F.lds = (LAS unsigned char*)lds_raw;
    F.MISC = (volatile LAS unsigned*)(F.lds + MISC_OFF);
    F.tid = threadIdx.x; F.lane = F.tid & 63; F.wave = __builtin_amdgcn_readfirstlane(F.tid >> 6);
    F.G = gridDim.x; { const int bx = blockIdx.x; F.vcu = (F.G % 8 == 0) ? (bx % 8) * (F.G / 8) + bx / 8 : bx; }
    F.ws = args.ws; F.out = args.out; F.ctl = (unsigned*)(args.ws + WS_CTL);
    for (int u = F.tid; u < (LDS_BYTES - LDSCTL_OFF) / 4; u += NWAVES * 64) ((LAS unsigned*)(F.lds + LDSCTL_OFF))[u] = 0u;
    __syncthreads();
    const int lo = args.ph_lo, hi = args.ph_hi;
    XcdBarrier bar; bar.bar = F.ctl + CW_BAR; bar.x = 0; bar.st = nullptr;
    if (hi - lo > 1) bar = xcd_barrier_post(F.ctl + CW_BAR, F.MISC + 8);
#ifndef PH_MASK
#define PH_MASK 0x1ff
#endif
#define IN(k) (((PH_MASK >> (k)) & 1) && lo <= (k) && (k) < hi)
#ifndef REPEAT_MASK
#define REPEAT_MASK 0
#endif
#ifndef P5_FAKE
#define P5_FAKE 0
#endif
#ifndef PROBE_EPI_MODE
#define PROBE_EPI_MODE 0
#endif
#define PH(k) if (IN(k)) for (int rep_ = 0; rep_ < 1 + ((REPEAT_MASK >> (k)) & 1); ++rep_)
#define RELAUNDER() do { int t_ = threadIdx.x; asm volatile("" : "+v"(t_)); F.tid = t_; F.lane = t_ & 63; F.wave = __builtin_amdgcn_readfirstlane(t_ >> 6); \
        GAS unsigned char* w_ = (GAS unsigned char*)args.ws; GAS float* o_ = (GAS float*)args.out; asm volatile("" : "+s"(w_), "+s"(o_)); F.ws = (unsigned char*)w_; F.out = (float*)o_; F.ctl = (unsigned*)(w_ + WS_CTL); } while (0)
#define XB ((bf16_t*)(F.ws + WS_B))
#define MIX XB
#define H XB
#define Qb ((bf16_t*)(F.ws + WS_C))
#define Ub ((bf16_t*)(F.ws + WS_D))
#define Yb (Ub + (size_t)M * 512)
#define SEAM(k) do { if (IN(k) && IN((k) + 1)) xcd_barrier(bar); } while (0)
    LAS unsigned char* ring = F.lds + RING_OFF;

    PH(0) { RELAUNDER(); for (int it = F.vcu; it < NG * 8; it += F.G) p0_ssm_tables(F, args, it >> 3, it & 7); p0_prologue(F, args); } SEAM(0);
    PH(1) { RELAUNDER();
        pg8::PlainSched S; S.init(XB, (const bf16_t*)(F.ws + WS_WIN), M, ZC, DM, F.G, (int)blockIdx.x);
        EpiQKVU E{Qb};
        pg8::gemm_phase<EpiQKVU, pg8::PlainSched, true>(ring, DM, S, E);
    } SEAM(1);
    PH(2) { RELAUNDER(); p2_mixers(F, args); } SEAM(2);
    PH(3) { RELAUNDER();
        pg8::PlainSched S; S.init(Yb, (const bf16_t*)(F.ws + WS_WGLU), M, SW, SW, F.G, (int)blockIdx.x);
        EpiGLU E{Yb, args.in[12], MIX};
        pg8::gemm_phase<EpiGLU, pg8::PlainSched, true>(ring, SW, S, E);
    } SEAM(3);
    PH(4) { RELAUNDER();
        pg8::PlainSched S; S.init(MIX, (const bf16_t*)(F.ws + WS_WOUT), M, DM, DM, F.G, (int)blockIdx.x);
        EpiWout E{args.in[0], F.out, (f32x2*)(F.ws + WS_STATS)};
        pg8::gemm_phase<EpiWout, pg8::PlainSched, true>(ring, DM, S, E);
    } SEAM(4);
    PH(5) { RELAUNDER();
#if (REPEAT_MASK >> 5) & 1
        if (rep_ == 1 && !P5_FAKE) { xcd_barrier(bar); if (blockIdx.x == 0 && F.tid < 256) __hip_atomic_store(F.ctl + CW_CNT + F.tid, 0u, RLX_AGENT); xcd_barrier(bar); }
#endif
        p5_ln_router(F, args, rep_ == 1 ? P5_FAKE : 0); } SEAM(5);
#define SLABQ(q) ((unsigned char*)(F.ws + ((q) == 0 ? WS_SLAB0 : WS_SLABX + (size_t)((q) - 1) * TQ_TOK * 9 * 1024)))
#define DOWN() do { DownSched S{(const unsigned char*)(F.ws + WS_HID), (const unsigned char*)(F.ws + WS_WD), (LAS const int*)(F.lds + TAB_OFF)}; \
        EpiDown E{F.ws, (LAS const int*)(F.lds + IDX_OFF)}; pg8::gemm_phase<EpiDown, DownSched, false, true>(ring, EH / 2, S, E); } while (0)
    PH(6) { RELAUNDER();
        p_convert_p(F, args);
        { pg8::PlainSched S; S.init((const bf16_t*)(F.ws + WS_H8), (const bf16_t*)(F.ws + WS_WPG), M, DM, DM / 2, F.G, (int)blockIdx.x);
          EpiGS E{(bf16_t*)((char*)F.out + OUT_GS)};
          pg8::gemm_phase<EpiGS, pg8::PlainSched, true, true>(ring, DM / 2, S, E); }
        moe_units<0>(F, 0);
        { GUSched S{(const bf16_t*)(F.ws + WS_H8), (const bf16_t*)(F.ws + WS_WGU), (LAS const int*)(F.lds + TAB_OFF), (LAS const int*)(F.lds + IDX_OFF)}; EpiGU E{(unsigned char*)(F.ws + WS_HID)};
          pg8::gemm_phase<EpiGU, GUSched, true, true>(ring, DM / 2, S, E); }
    } SEAM(6);
    PH(7) { RELAUNDER();
        { pg8::PlainSched S; S.init((const bf16_t*)F.out, (const bf16_t*)(F.ws + WS_WPLE), M, DM, PLE, F.G, (int)blockIdx.x);
          EpiBase E{(const bf16_t*)((const char*)F.out + OUT_GS), H};
          pg8::gemm_phase<EpiBase, pg8::PlainSched, true>(ring, PLE, S, E); }
        moe_units<1>(F, 0); DOWN(); RELAUNDER(); moe_units<1>(F, 12); DOWN();
    } SEAM(7);
    PH(8) { RELAUNDER();
#pragma unroll 1
        for (int q = 0; q < 4; ++q) p_combine_ln2(F, args, q, SLABQ(q), 0, F.G); }
#undef SLABQ
#undef DOWN
#undef IN
#undef SEAM
#undef XB
#undef MIX
#undef H
#undef Qb
#undef Ub
#undef Yb

}

#ifndef HYBRID
#define HYBRID 0
#endif
#ifndef ONE_LAUNCH
#define ONE_LAUNCH 0
#endif
extern "C" void kernel_launch(void* const* d_in, const int* in_sizes, int n_in, void* d_out, int out_size, void* d_ws, size_t ws_size, hipStream_t stream) {
    static int grid = 0;
    if (grid == 0) {
        if (n_in != 28 || out_size != M * DM || ws_size < WS_END) { fprintf(stderr, "kernel_launch: unexpected shapes (n_in %d out %d ws %zu)\n", n_in, out_size, ws_size); grid = -1; return; }
        int dev = 0, cus = 0;
        if (hipGetDevice(&dev) != hipSuccess || hipDeviceGetAttribute(&cus, hipDeviceAttributeMultiprocessorCount, dev) != hipSuccess) { grid = -1; return; }
        if (hipFuncSetAttribute((const void*)mk_fwd, hipFuncAttributeMaxDynamicSharedMemorySize, LDS_BYTES) != hipSuccess) { fprintf(stderr, "kernel_launch: hipFuncSetAttribute failed\n"); grid = -1; return; }
        grid = cus;
    }
    if (grid < 0) return;
    (void)hipMemsetAsync((char*)d_ws + WS_CTL, 0, CTL_ZERO_BYTES, stream);
    Args a{};
    for (int i = 0; i < 28; ++i) a.in[i] = (const float*)d_in[i];
    a.out = (float*)d_out; a.ws = (unsigned char*)d_ws;
    const int last_phase = (HYBRID == 2) ? 5 : N_PHASES;
    if (ONE_LAUNCH) { a.ph_lo = 0; a.ph_hi = last_phase; hipLaunchKernelGGL(mk_fwd, dim3(grid), dim3(NWAVES * 64), LDS_BYTES, stream, a); }
    else for (int p = 0; p < last_phase; ++p) { a.ph_lo = p; a.ph_hi = p + 1; hipLaunchKernelGGL(mk_fwd, dim3(grid), dim3(NWAVES * 64), LDS_BYTES, stream, a); }
#if HYBRID == 2
    {
        using nv::GP;
        const float* pin = (const float*)d_in[1];
        const float* ln1_g = (const float*)d_in[14]; const float* ln1_b = (const float*)d_in[15]; const float* w_router = (const float*)d_in[16]; const float* router_bias = (const float*)d_in[17];
        const float* w_gate = (const float*)d_in[18]; const float* w_up = (const float*)d_in[19]; const float* w_down = (const float*)d_in[20];
        const float* ws_gate = (const float*)d_in[21]; const float* ws_up = (const float*)d_in[22]; const float* ws_down = (const float*)d_in[23];
        const float* w_ple = (const float*)d_in[24]; const float* w_pg = (const float*)d_in[25]; const float* ln2_g = (const float*)d_in[26]; const float* ln2_b = (const float*)d_in[27];
        float* out = (float*)d_out; char* ws = (char*)d_ws;
        float* HID = (float*)(ws); float* H = (float*)(ws + 256 * MiB); float* HIDS = (float*)(ws + 384 * MiB); float* SC = (float*)(ws + 448 * MiB);
        int* LIST = (int*)(ws + 456 * MiB); float* LISTW = (float*)(ws + 464 * MiB); int* CNT = (int*)(ws + 472 * MiB); int* OFF = CNT + 64;
        GP g{};
        nv::k_ln<<<M / 4, 256, 0, stream>>>(out, H, ln1_g, ln1_b);
        g = GP{}; g.A = H; g.lda = DM; g.B = w_router; g.ldb = NE; g.K = DM; g.nrows = M; g.C = SC; g.ldc = NE;
        nv::k_gemm<3><<<dim3(1, M / 64), 256, 0, stream>>>(g);
        (void)hipMemsetAsync(CNT, 0, 128 * sizeof(int), stream);
        nv::k_topk<<<M / 256, 256, 0, stream>>>(SC, router_bias, CNT, LIST, LISTW);
        nv::k_prefix<<<1, 64, 0, stream>>>(CNT, OFF);
        (void)hipMemsetAsync(out, 0, (size_t)M * DM * sizeof(float), stream);
        g = GP{}; g.A = H; g.lda = DM; g.B = w_gate; g.B2 = w_up; g.ldb = EH; g.K = DM; g.C = HID; g.ldc = EH; g.cnt = CNT; g.off = OFF; g.list = LIST; g.listw = LISTW;
        nv::k_gemm<4><<<dim3(EH / 64, M / 64, NE), 256, 0, stream>>>(g);
        g = GP{}; g.A = HID; g.lda = EH; g.B = w_down; g.ldb = DM; g.K = EH; g.C = out; g.ldc = DM; g.cnt = CNT; g.off = OFF; g.list = LIST; g.listw = LISTW;
        nv::k_gemm<5><<<dim3(DM / 64, M / 64, NE), 256, 0, stream>>>(g);
        g = GP{}; g.A = H; g.lda = DM; g.B = ws_gate; g.B2 = ws_up; g.ldb = EH; g.K = DM; g.nrows = M; g.C = HIDS; g.ldc = EH;
        nv::k_gemm<6><<<dim3(EH / 64, M / 64), 256, 0, stream>>>(g);
        g = GP{}; g.A = HIDS; g.lda = EH; g.B = ws_down; g.ldb = DM; g.K = EH; g.nrows = M; g.C = out; g.ldc = DM;
        nv::k_gemm<7><<<dim3(DM / 64, M / 64), 256, 0, stream>>>(g);
        g = GP{}; g.A = pin; g.lda = PLE; g.B = w_ple; g.ldb = DM; g.K = PLE; g.nrows = M; g.C = out; g.ldc = DM; g.A2 = H; g.lda2 = DM; g.B2 = w_pg; g.ldb2 = DM; g.K2 = DM;
        nv::k_gemm<8><<<dim3(DM / 64, M / 64), 256, 0, stream>>>(g);
        nv::k_ln<<<M / 4, 256, 0, stream>>>(out, out, ln2_g, ln2_b);
    }
#endif
}
```

```cpp
#include <hip/hip_runtime.h>
#include <cstdint>
#include <cstdio>
#include <cmath>

#define LAS __attribute__((address_space(3)))
#define GAS __attribute__((address_space(1)))
typedef unsigned short bf16_t;
typedef short bf16x8 __attribute__((ext_vector_type(8)));
typedef float f32x4 __attribute__((ext_vector_type(4)));
typedef float f32x2 __attribute__((ext_vector_type(2)));
typedef unsigned u32x4 __attribute__((ext_vector_type(4)));
typedef unsigned u32x2 __attribute__((ext_vector_type(2)));

constexpr int BATCH = 8, SEQ = 4096, DM = 1024, M = BATCH * SEQ;
constexpr int NH = 8, HD = 64, AW = 512, SW = 512, NG = 32, GC = 16, NS = 64;
constexpr int NE = 64, TOPK = 8, EH = 256, PLE = 256, ZC = 2048;
constexpr float ALPHA = 1.189207115002721f;
constexpr float LN_EPS = 1e-5f;
constexpr float ROUTED_SCALE = 2.5f;
constexpr float LOG2E = 1.4426950408889634f;
constexpr float QSCALE = 0.125f * LOG2E;

__device__ __forceinline__ unsigned f2bf(float f) { unsigned u = __builtin_bit_cast(unsigned, f); return (u + 0x7fffu + ((u >> 16) & 1u)) >> 16; }
__device__ __forceinline__ unsigned pk2(float lo, float hi) { return f2bf(lo) | (f2bf(hi) << 16); }
__device__ __forceinline__ float bf2f(unsigned short b) { return __builtin_bit_cast(float, (unsigned)b << 16); }
__device__ __forceinline__ float bflo(unsigned w) { return __builtin_bit_cast(float, w << 16); }
__device__ __forceinline__ float bfhi(unsigned w) { return __builtin_bit_cast(float, w & 0xffff0000u); }
__device__ __forceinline__ float wave_sum(float v) {
#pragma unroll
    for (int o = 1; o < 64; o <<= 1) v += __shfl_xor(v, o);
    return v;
}
__device__ __forceinline__ float sigmoidf_(float x) { return 1.f / (1.f + __expf(-x)); }
#define HYBRID 0
#define ONE_LAUNCH 1

namespace pg8 {
constexpr int BM = 256, BK = 64, HALF = 128, HTB = HALF * BK * 2  , STAGE_BYTES = 8 * HTB, NXCD = 8, WGM = 8;

__host__ __device__ __forceinline__ int lds_byte(int r, int c) { const int st = (r >> 4) * 2 + (c >> 5), rr = r & 15, cc = c & 31, ob = rr * 64 + cc * 2; return st * 1024 + (ob ^ (((ob >> 9) & 1) << 5)); }
__host__ __device__ __forceinline__ void stage_rc(int b, int& R, int& C) { const int st = b / 1024, sb = b % 1024, swz = sb ^ (((sb >> 9) & 1) << 5); R = (st >> 1) * 16 + swz / 64; C = (st & 1) * 32 + (swz % 64) / 2; }
__host__ __device__ __forceinline__ int perm32(int rho) { const int n = rho >> 4, i = rho & 15; return 8 * (i >> 2) + 4 * n + (i & 3); }

struct Unit { int arow, brow, crow, ccol, e, aux; };

typedef int i32x8 __attribute__((ext_vector_type(8)));
typedef int i32x4 __attribute__((ext_vector_type(4)));
__device__ __forceinline__ i32x8 cat8(bf16x8 a, bf16x8 b) { return __builtin_shufflevector(__builtin_bit_cast(i32x4, a), __builtin_bit_cast(i32x4, b), 0, 1, 2, 3, 4, 5, 6, 7); }
template <class Epi, class Sched, bool ALIGN_EPI, bool F8 = false>
__device__ __forceinline__ void gemm_phase(LAS unsigned char* lds, const int K, const Sched& S, const Epi& E) {
    int tid_l = threadIdx.x; asm volatile("" : "+v"(tid_l));
    const int tid = tid_l, wid = __builtin_amdgcn_readfirstlane(tid >> 6), lane = tid & 63, wr = wid >> 2, wc = wid & 3, fr = lane & 15, fq = lane >> 4;
    const int nt = K / BK;
    unsigned voffB[2];
#pragma unroll
    for (int i = 0; i < 2; ++i) { int R, C; stage_rc(tid * 16 + i * 8192, R, C); const int Rb = (R & ~31) + perm32(R & 31); voffB[i] = (unsigned)(Rb * K + C) * 2u; }
#define PG8_AVOFF(u_, v_) do { int Ra[2], Ca[2]; int t_ = tid; asm volatile("" : "+v"(t_)); _Pragma("unroll") for (int i = 0; i < 2; ++i) stage_rc(t_ * 16 + i * 8192, Ra[i], Ca[i]); S.avoff(u_, Ra, Ca, v_); } while (0)
    const size_t kstep = (size_t)(BK * 2);
    const size_t hstep = (size_t)HALF * K * 2;
    const unsigned ldsw = (unsigned)wid * 1024u;
    const int aoff = lds_byte(wr * 64 + fr, fq * 8), boff = lds_byte(wc * 32 + fr, fq * 8);
#define PG8_SA(b, h) (((b) * 2 + (h)) * HTB)
#define PG8_SB(b, h) ((4 + (b) * 2 + (h)) * HTB)
#define PG8_STAGE(bufoff, gbase, v0, v1) do { \
        __builtin_amdgcn_global_load_lds((const unsigned*)((const char*)(gbase) + (v0)), (LAS unsigned*)(lds + (bufoff) + ldsw), 16, 0, 0); \
        __builtin_amdgcn_global_load_lds((const unsigned*)((const char*)(gbase) + (v1)), (LAS unsigned*)(lds + (bufoff) + ldsw + 8192), 16, 0, 0); } while (0)
#define PG8_LDA(dst, b, h) do { if constexpr (F8) { _Pragma("unroll") for (int m = 0; m < 4; ++m) dst##8[m] = cat8(*(const LAS bf16x8*)(lds + PG8_SA(b, h) + aoff + m * 2048), *(const LAS bf16x8*)(lds + PG8_SA(b, h) + aoff + m * 2048 + 1024)); } \
        else { _Pragma("unroll") for (int m = 0; m < 4; ++m) _Pragma("unroll") for (int k = 0; k < 2; ++k) dst[m][k] = *(const LAS bf16x8*)(lds + PG8_SA(b, h) + aoff + m * 2048 + k * 1024); } } while (0)
#define PG8_LDB(dst, b, h) do { if constexpr (F8) { _Pragma("unroll") for (int n = 0; n < 2; ++n) dst##8[n] = cat8(*(const LAS bf16x8*)(lds + PG8_SB(b, h) + boff + n * 2048), *(const LAS bf16x8*)(lds + PG8_SB(b, h) + boff + n * 2048 + 1024)); } \
        else { _Pragma("unroll") for (int n = 0; n < 2; ++n) _Pragma("unroll") for (int k = 0; k < 2; ++k) dst[n][k] = *(const LAS bf16x8*)(lds + PG8_SB(b, h) + boff + n * 2048 + k * 1024); } } while (0)
#define PG8_MMA(ai, bj, At, Bt) do { __builtin_amdgcn_s_setprio(1); if constexpr (F8) { _Pragma("unroll") for (int m = 0; m < 4; ++m) _Pragma("unroll") for (int n = 0; n < 2; ++n) \
            acc[ai][bj][m][n] = __builtin_amdgcn_mfma_scale_f32_16x16x128_f8f6f4(Bt##8[n], At##8[m], acc[ai][bj][m][n], 0, 0, 0, 0x7f7f7f7f, 0, 0x7f7f7f7f); } \
        else { _Pragma("unroll") for (int m = 0; m < 4; ++m) _Pragma("unroll") for (int n = 0; n < 2; ++n) _Pragma("unroll") for (int k = 0; k < 2; ++k) \
            acc[ai][bj][m][n] = __builtin_amdgcn_mfma_f32_16x16x32_bf16(Bt[n][k], At[m][k], acc[ai][bj][m][n], 0, 0, 0); } __builtin_amdgcn_s_setprio(0); } while (0)
#define PG8_WAIT_V(n) asm volatile("s_waitcnt vmcnt(" #n ")" ::: "memory")
#define PG8_WAIT_L(n) asm volatile("s_waitcnt lgkmcnt(" #n ")" ::: "memory")
#define PG8_BAR __builtin_amdgcn_s_barrier()
#define PG8_SCHED __builtin_amdgcn_sched_barrier(0)
    Unit cur, nxt; int ui = 0;
    if (!S.next(0, cur)) return;
    f32x4 acc[2][2][4][2];
#pragma unroll
    for (int a = 0; a < 2; ++a)
#pragma unroll
        for (int b = 0; b < 2; ++b)
#pragma unroll
            for (int m = 0; m < 4; ++m)
#pragma unroll
                for (int n = 0; n < 2; ++n) acc[a][b][m][n] = (f32x4){0.f, 0.f, 0.f, 0.f};
    bf16x8 At[4][2], B0[2][2], B1[2][2]; i32x8 At8[4], B08[2], B18[2];
    unsigned cv[2][2];
    PG8_AVOFF(cur, cv);
    const char* cA = S.abase(cur); const char* cB = S.bbase(cur);
    PG8_STAGE(PG8_SB(0, 0), cB, voffB[0], voffB[1]); PG8_STAGE(PG8_SB(0, 1), cB + hstep, voffB[0], voffB[1]); PG8_STAGE(PG8_SA(0, 0), cA, cv[0][0], cv[0][1]); PG8_STAGE(PG8_SA(0, 1), cA, cv[1][0], cv[1][1]);
    if (wr == 1) PG8_BAR;
    PG8_WAIT_V(2); PG8_BAR;
    PG8_STAGE(PG8_SB(1, 0), cB + kstep, voffB[0], voffB[1]); PG8_STAGE(PG8_SA(1, 0), cA + kstep, cv[0][0], cv[0][1]); PG8_STAGE(PG8_SB(1, 1), cB + hstep + kstep, voffB[0], voffB[1]);
    PG8_WAIT_V(6); PG8_BAR;
    for (;;) {
        const bool has_next = S.next(ui + 1, nxt);
        const char* nA = cA; const char* nB = cB;
        if (has_next) { nA = S.abase(nxt); nB = S.bbase(nxt); }
#pragma unroll 1
        for (int t = 0; t < nt; t += 2) {
            const bool last = (t == nt - 2);
            const char* a1 = cA + (size_t)(t + 1) * kstep;
            const char* a2 = last ? nA : cA + (size_t)(t + 2) * kstep; const char* b2 = last ? nB : cB + (size_t)(t + 2) * kstep;
            const char* a3 = a2 + kstep; const char* b3 = b2 + kstep;
            PG8_LDB(B0, 0, 0); PG8_LDB(B1, 0, 1); PG8_SCHED; PG8_LDA(At, 0, 0); PG8_STAGE(PG8_SA(1, 1), a1, cv[1][0], cv[1][1]);
            if (last && has_next) PG8_AVOFF(nxt, cv);
            PG8_WAIT_V(8); PG8_WAIT_L(0); PG8_BAR; PG8_MMA(0, 0, At, B0); PG8_MMA(0, 1, At, B1); PG8_BAR; PG8_SCHED;
            PG8_LDA(At, 0, 1); PG8_STAGE(PG8_SB(0, 0), b2, voffB[0], voffB[1]); PG8_STAGE(PG8_SB(0, 1), b2 + hstep, voffB[0], voffB[1]); PG8_STAGE(PG8_SA(0, 0), a2, cv[0][0], cv[0][1]);
            PG8_WAIT_V(8); PG8_WAIT_L(0); PG8_BAR; PG8_MMA(1, 0, At, B0); PG8_MMA(1, 1, At, B1); PG8_BAR; PG8_SCHED;
            PG8_LDB(B0, 1, 0); PG8_LDB(B1, 1, 1); PG8_SCHED; PG8_LDA(At, 1, 0); PG8_STAGE(PG8_SA(0, 1), a2, cv[1][0], cv[1][1]);
            PG8_WAIT_V(8); PG8_WAIT_L(0); PG8_BAR; PG8_MMA(0, 0, At, B0); PG8_MMA(0, 1, At, B1); PG8_BAR; PG8_SCHED;
            PG8_LDA(At, 1, 1); PG8_STAGE(PG8_SB(1, 0), b3, voffB[0], voffB[1]); PG8_STAGE(PG8_SB(1, 1), b3 + hstep, voffB[0], voffB[1]); PG8_STAGE(PG8_SA(1, 0), a3, cv[0][0], cv[0][1]);
            PG8_WAIT_V(8); PG8_WAIT_L(0); PG8_BAR; PG8_MMA(1, 0, At, B0); PG8_MMA(1, 1, At, B1); PG8_BAR; PG8_SCHED;
        }
        if constexpr (ALIGN_EPI) { if (wr == 0) PG8_BAR; }
        E(acc, cur, wr, wc, fr, fq);
        if (!has_next) break;
#pragma unroll
        for (int a = 0; a < 2; ++a)
#pragma unroll
            for (int b = 0; b < 2; ++b)
#pragma unroll
                for (int m = 0; m < 4; ++m)
#pragma unroll
                    for (int n = 0; n < 2; ++n) acc[a][b][m][n] = (f32x4){0.f, 0.f, 0.f, 0.f};
        cur = nxt; cA = nA; cB = nB; ++ui;
        if constexpr (ALIGN_EPI) { if (wr == 1) PG8_BAR; }
    }
    PG8_WAIT_V(0);
    if constexpr (!ALIGN_EPI) { if (wr == 0) PG8_BAR; }
    PG8_BAR;
#undef PG8_AVOFF
#undef PG8_SA
#undef PG8_SB
#undef PG8_STAGE
#undef PG8_LDA
#undef PG8_LDB
#undef PG8_MMA
#undef PG8_WAIT_V
#undef PG8_WAIT_L
#undef PG8_BAR
#undef PG8_SCHED
}

struct PlainSched {
    const bf16_t* A; const bf16_t* Bt; int K; int nM, nN, nwg, G, c;
    __device__ void init(const bf16_t* A_, const bf16_t* Bt_, int Mr, int N, int K_, int G_, int c_) { A = A_; Bt = Bt_; K = K_; nM = Mr / BM; nN = N / BM; nwg = nM * nN; G = G_; c = c_; }
    __device__ __forceinline__ bool next(int i, Unit& u) const {
        const long L = (long)i * G + c; if (L >= nwg) return false;
        int wgid = (int)L; { const int q = nwg / NXCD, r = nwg % NXCD, xcd = wgid % NXCD, off = wgid / NXCD; wgid = (xcd < r ? xcd * (q + 1) : r * (q + 1) + (xcd - r) * q) + off; }
        const int nig = WGM * nN, gid = wgid / nig, fm = gid * WGM, gsz = (nM - fm) < WGM ? (nM - fm) : WGM;
        const int pm = fm + ((wgid % nig) % gsz), pn = (wgid % nig) / gsz;
        u.arow = pm * BM; u.brow = pn * BM; u.crow = pm * BM; u.ccol = pn * BM; u.e = 0; u.aux = 0; return true;
    }
    __device__ __forceinline__ const char* abase(const Unit& u) const { return (const char*)A + (size_t)u.arow * K * 2; }
    __device__ __forceinline__ const char* bbase(const Unit& u) const { return (const char*)Bt + (size_t)u.brow * K * 2; }
    __device__ __forceinline__ void avoff(const Unit&, const int (&R)[2], const int (&C)[2], unsigned (&v)[2][2]) const {
#pragma unroll
        for (int h = 0; h < 2; ++h)
#pragma unroll
            for (int i = 0; i < 2; ++i) v[h][i] = (unsigned)((h * HALF + R[i]) * K + C[i]) * 2u;
    }
};
}

constexpr size_t MiB = 1u << 20;
constexpr size_t WS_CTL = 0, CTL_ZERO_BYTES = 64 * 1024;
constexpr size_t WS_LDEST = 1 * MiB;
constexpr size_t WS_LIST = 9 * MiB;
constexpr size_t WS_LISTW = 17 * MiB;
constexpr size_t WS_STATS = 25 * MiB;
constexpr size_t WS_WR = 29 * MiB;
constexpr size_t WS_WIN = 30 * MiB;
constexpr size_t WS_WGLU = 34 * MiB;
constexpr size_t WS_WOUT = 35 * MiB;
constexpr size_t WS_WPG = 37 * MiB;
constexpr size_t WS_WGU = 39 * MiB;
constexpr size_t WS_WD = 104 * MiB;
constexpr size_t WS_WPLE = 136 * MiB + 512 * 1024;
constexpr size_t WS_B = 137 * MiB;
constexpr size_t WS_C = 201 * MiB;
constexpr size_t WS_D = 297 * MiB;
constexpr size_t WS_E = 361 * MiB;
constexpr size_t WS_BASE = WS_B;
constexpr size_t WS_HID = 201 * MiB;
constexpr size_t WS_SLAB0 = 30 * MiB, WS_SLAB1 = 377 * MiB;
constexpr size_t OUT_GS = 16 * MiB;
constexpr size_t WS_H8 = 449 * MiB;
constexpr size_t WS_END = 512 * MiB;
constexpr int TQ_TOK = 8192, LCAP = 8192;
static_assert(WS_WD + (size_t)65 * 1024 * 256 * 2 <= WS_WPLE && WS_HID + (size_t)360448 * 512 <= WS_SLAB1 && WS_SLAB1 + (size_t)TQ_TOK * 9 * 1024 <= WS_END && WS_SLAB0 + (size_t)TQ_TOK * 9 * 1024 <= WS_WD, "ws map");
constexpr int CW_CNT = 64;
constexpr int CW_BAR = 1024;

constexpr int RING_OFF = 0, RING_BYTES = 131072;
constexpr int LDSCTL_OFF = RING_BYTES;
constexpr int MISC_OFF = LDSCTL_OFF;
constexpr int TAB_OFF = LDSCTL_OFF + 128;
constexpr int TST_OFF = LDSCTL_OFF + 512;
constexpr int IDX_OFF = LDSCTL_OFF + 2048;
constexpr int LDS_BYTES = 147456;
static_assert(IDX_OFF + 12 * 1024 <= LDS_BYTES, "LDS map");

constexpr int NWAVES = 8;
#define RLX_AGENT __ATOMIC_RELAXED, __HIP_MEMORY_SCOPE_AGENT
#define LDS_WAIT() asm volatile("s_waitcnt lgkmcnt(0)" ::: "memory")
#define VM_WAIT() asm volatile("s_waitcnt vmcnt(0)" ::: "memory")
#define LDS_BARRIER() do { asm volatile("s_waitcnt lgkmcnt(0)" ::: "memory"); __builtin_amdgcn_s_barrier(); asm volatile("" ::: "memory"); } while (0)

#define XB_TMO      128
#define XB_XCNT(j)  (256  + 64 * (j))
#define XB_XSUB(j)  (1280 + 64 * (j))
#define XB_XGEN(j)  (2304 + 64 * (j))
#define XB_TOP      3328
#define XB_TOPGEN   3392
#define XCD_BAR_WORDS 3456
#define XB_SPIN_CAP (1u << 18)
__device__ __forceinline__ unsigned xb_ld(unsigned* p)              { return __hip_atomic_load(p, __ATOMIC_RELAXED, __HIP_MEMORY_SCOPE_AGENT); }
__device__ __forceinline__ unsigned xb_add(unsigned* p, unsigned v) { return __hip_atomic_fetch_add(p, v, __ATOMIC_RELAXED, __HIP_MEMORY_SCOPE_AGENT); }
__device__ __forceinline__ unsigned xb_xcc_id() { return (unsigned)__builtin_amdgcn_s_getreg((3 << 11) | 20) & 0xFu; }
#define XB_SPIN(cond, bar) do { unsigned _sp = 0; while (cond) { __builtin_amdgcn_s_sleep(1); \
    if ((++_sp & 255u) == 0u) { if (xb_ld(&(bar)[XB_TMO])) break; if (_sp > XB_SPIN_CAP) { atomicAdd(&(bar)[XB_TMO], 1u); break; } } } } while (0)
struct XcdBarrier { unsigned* bar; unsigned x; volatile LAS unsigned* st; };
__device__ __forceinline__ XcdBarrier xcd_barrier_post(unsigned* bar, volatile LAS unsigned* st) {
    XcdBarrier b; b.bar = bar; b.x = xb_xcc_id(); b.st = st;
    if (threadIdx.x == 0) (void)xb_add(&bar[XB_XCNT(b.x)], 1u);
    return b;
}
__device__ __forceinline__ void xcd_barrier_complete(unsigned* bar, unsigned x, unsigned& nloc, unsigned& nx) {
    const unsigned G = gridDim.x * gridDim.y * gridDim.z;
    unsigned sum, cnt, mine, sp = 0u;
    for (;;) {
        sum = 0u; cnt = 0u; mine = 0u;
#pragma unroll
        for (unsigned j = 0; j < 16; ++j) { const unsigned c = xb_ld(&bar[XB_XCNT(j)]); sum += c; cnt += (c > 0u) ? 1u : 0u; mine = (j == x) ? c : mine; }
        if (sum == G) break;
        __builtin_amdgcn_s_sleep(1);
        if ((++sp & 255u) == 0u) { if (xb_ld(&bar[XB_TMO])) break; if (sp > XB_SPIN_CAP) { atomicAdd(&bar[XB_TMO], 1u); break; } }
    }
    nloc = mine > 0u ? mine : 1u; nx = cnt > 0u ? cnt : 1u;
}
__device__ __forceinline__ void xcd_barrier(const XcdBarrier& b) {
    asm volatile("s_waitcnt vmcnt(0)" ::: "memory");
    __syncthreads();
    if (threadIdx.x == 0) {
        unsigned* bar = b.bar;
        __builtin_amdgcn_s_waitcnt(0);
        unsigned nloc = b.st[0], nx = b.st[1];
        if (nloc == 0u) { xcd_barrier_complete(bar, b.x, nloc, nx); b.st[0] = nloc; b.st[1] = nx; }
        const unsigned old = xb_add(&bar[XB_XSUB(b.x)], 1u);
        const unsigned gen = old / nloc;
        if (old + 1u == (gen + 1u) * nloc) {
            __builtin_amdgcn_fence(__ATOMIC_RELEASE, "agent");
            asm volatile("s_waitcnt vmcnt(0)" ::: "memory");
            const unsigned og = xb_add(&bar[XB_TOP], 1u);
            const unsigned tg = og / nx;
            if (og + 1u == (tg + 1u) * nx) xb_add(&bar[XB_TOPGEN], 1u);
            else XB_SPIN(xb_ld(&bar[XB_TOPGEN]) == tg, bar);
            __builtin_amdgcn_fence(__ATOMIC_ACQUIRE, "agent");
            xb_add(&bar[XB_XGEN(b.x)], 1u);
            asm volatile("s_waitcnt vmcnt(0)" ::: "memory");
        } else {
            XB_SPIN(xb_ld(&bar[XB_XGEN(b.x)]) == gen, bar);
            __builtin_amdgcn_fence(__ATOMIC_ACQUIRE, "agent");
            asm volatile("s_waitcnt vmcnt(0)" ::: "memory");
        }
    }
    __syncthreads();
}

struct Frame {
    LAS unsigned char* lds;
    volatile LAS unsigned* MISC;
    unsigned* ctl;
    int tid, lane, wave, vcu, G;
    float* out; unsigned char* ws;
};
struct Args { const float* in[28]; float* out; unsigned char* ws; int ph_lo, ph_hi; };
typedef __bf16 bf16x2_t __attribute__((ext_vector_type(2)));
__device__ __forceinline__ unsigned cvtpk(float lo, float hi) { f32x2 v = {lo, hi}; bf16x2_t b = __builtin_convertvector(v, bf16x2_t); return __builtin_bit_cast(unsigned, b); }
__device__ __forceinline__ u32x4 pack8(const f32x4 a, const f32x4 b) { u32x4 w; w.x = cvtpk(a[0], a[1]); w.y = cvtpk(a[2], a[3]); w.z = cvtpk(b[0], b[1]); w.w = cvtpk(b[2], b[3]); return w; }
__device__ __forceinline__ void unpack8(const u32x4 w, f32x4& a, f32x4& b) { a = (f32x4){bflo(w.x), bfhi(w.x), bflo(w.y), bfhi(w.y)}; b = (f32x4){bflo(w.z), bfhi(w.z), bflo(w.w), bfhi(w.w)}; }

using pg8::Unit;
typedef const f32x4 (&AccRef)[2][2][4][2];
#define EPI_ROWS_BEGIN _Pragma("unroll") for (int ai = 0; ai < 2; ++ai) _Pragma("unroll") for (int m = 0; m < 4; ++m) { const int rr = ai * 128 + wr * 64 + m * 16 + fr;
#define EPI_ROWS_END }
struct EpiQKVU {
    bf16_t* O;
    __device__ __forceinline__ void operator()(AccRef acc, const Unit& u, int wr, int wc, int fr, int fq) const {
        const int t = u.ccol >> 9, colt = u.ccol & 511; bf16_t* base = O + (size_t)t * M * 512; const float sc = (t == 0) ? QSCALE : 1.f;
        const int col0 = colt + wc * 32 + 8 * fq;
        EPI_ROWS_BEGIN
            bf16_t* rowp = base + (size_t)(u.crow + rr) * 512 + col0;
#pragma unroll
            for (int bj = 0; bj < 2; ++bj) *(u32x4*)(rowp + bj * 128) = pack8(acc[ai][bj][m][0] * sc, acc[ai][bj][m][1] * sc);
        EPI_ROWS_END
    }
};
struct EpiGLU {
    const bf16_t* Y; const float* bias; bf16_t* MIX;
    __device__ __forceinline__ void operator()(AccRef acc, const Unit& u, int wr, int wc, int fr, int fq) const {
        const int col0 = u.ccol + wc * 32 + 8 * fq;
        f32x4 bv[2][2];
#pragma unroll
        for (int bj = 0; bj < 2; ++bj) { bv[bj][0] = *(const f32x4*)(bias + col0 + bj * 128); bv[bj][1] = *(const f32x4*)(bias + col0 + bj * 128 + 4); }
        EPI_ROWS_BEGIN
            const size_t row = (size_t)(u.crow + rr);
#pragma unroll
            for (int bj = 0; bj < 2; ++bj) {
                const u32x4 yw = *(const u32x4*)(Y + row * 512 + col0 + bj * 128); f32x4 y0, y1; unpack8(yw, y0, y1);
                f32x4 a0 = acc[ai][bj][m][0] + bv[bj][0], a1 = acc[ai][bj][m][1] + bv[bj][1];
#pragma unroll
                for (int j = 0; j < 4; ++j) { a0[j] = y0[j] * sigmoidf_(a0[j]); a1[j] = y1[j] * sigmoidf_(a1[j]); }
                *(u32x4*)(MIX + row * 1024 + 512 + col0 + bj * 128) = pack8(a0, a1);
            }
        EPI_ROWS_END
    }
};
struct EpiWout {
    const float* X; float* PRE; f32x2* STATS;
    __device__ __forceinline__ void operator()(AccRef acc, const Unit& u, int wr, int wc, int fr, int fq) const {
        const int col0 = u.ccol + wc * 32 + 8 * fq;
        EPI_ROWS_BEGIN
            const size_t row = (size_t)(u.crow + rr); float s = 0.f, q = 0.f;
#pragma unroll
            for (int bj = 0; bj < 2; ++bj) {
                const float* xp = X + row * 1024 + col0 + bj * 128;
                const f32x4 v0 = *(const f32x4*)xp * ALPHA + acc[ai][bj][m][0], v1 = *(const f32x4*)(xp + 4) * ALPHA + acc[ai][bj][m][1];
                float* pp = PRE + row * 1024 + col0 + bj * 128; *(f32x4*)pp = v0; *(f32x4*)(pp + 4) = v1;
                s += (v0[0] + v0[1]) + (v0[2] + v0[3]) + (v1[0] + v1[1]) + (v1[2] + v1[3]);
                q += (v0[0] * v0[0] + v0[1] * v0[1]) + (v0[2] * v0[2] + v0[3] * v0[3]) + (v1[0] * v1[0] + v1[1] * v1[1]) + (v1[2] * v1[2] + v1[3] * v1[3]);
            }
            s += __shfl_xor(s, 16); s += __shfl_xor(s, 32); q += __shfl_xor(q, 16); q += __shfl_xor(q, 32);
            if (fq == 0) STATS[row * 16 + (u.ccol >> 8) * 4 + wc] = (f32x2){s, q};
        EPI_ROWS_END
    }
};
constexpr float WSC = 1.f / 32.f;
struct EpiGU {
    unsigned char* HID;
    __device__ __forceinline__ void operator()(AccRef acc, const Unit& u, int wr, int wc, int fr, int fq) const {
        const int col0 = u.ccol + wc * 32 + 8 * fq;
        EPI_ROWS_BEGIN
            f32x4 h0, h1;
#pragma unroll
            for (int j = 0; j < 4; ++j) { const float g0 = acc[ai][0][m][0][j] * WSC, g1 = acc[ai][0][m][1][j] * WSC; h0[j] = g0 * sigmoidf_(g0) * (acc[ai][1][m][0][j] * WSC); h1[j] = g1 * sigmoidf_(g1) * (acc[ai][1][m][1][j] * WSC); }
            int p0 = __builtin_amdgcn_cvt_pk_fp8_f32(h0[0], h0[1], 0, false); p0 = __builtin_amdgcn_cvt_pk_fp8_f32(h0[2], h0[3], p0, true);
            int p1 = __builtin_amdgcn_cvt_pk_fp8_f32(h1[0], h1[1], 0, false); p1 = __builtin_amdgcn_cvt_pk_fp8_f32(h1[2], h1[3], p1, true);
            *(u32x2*)(HID + (size_t)(u.crow + rr) * 256 + col0) = (u32x2){(unsigned)p0, (unsigned)p1};
        EPI_ROWS_END
    }
};
struct EpiDown {
    unsigned char* SLAB; LAS const int* dw;
    __device__ __forceinline__ void operator()(AccRef acc, const Unit& u, int wr, int wc, int fr, int fq) const {
        const int col0 = u.ccol + wc * 32 + 8 * fq;
        EPI_ROWS_BEGIN
            const int dest = dw[(u.crow * 256 + rr) * 2]; const float w = __int_as_float(dw[(u.crow * 256 + rr) * 2 + 1]) * (16.f * WSC);
            if (dest >= 0) { unsigned char* rowp = SLAB + (size_t)dest * 1024 + col0;
#pragma unroll
                for (int bj = 0; bj < 2; ++bj) { const f32x4 a = acc[ai][bj][m][0] * w, c = acc[ai][bj][m][1] * w;
                    int p0 = __builtin_amdgcn_cvt_pk_fp8_f32(a[0], a[1], 0, false); p0 = __builtin_amdgcn_cvt_pk_fp8_f32(a[2], a[3], p0, true);
                    int p1 = __builtin_amdgcn_cvt_pk_fp8_f32(c[0], c[1], 0, false); p1 = __builtin_amdgcn_cvt_pk_fp8_f32(c[2], c[3], p1, true);
                    *(u32x2*)(rowp + bj * 128) = (u32x2){(unsigned)p0, (unsigned)p1}; } }
        EPI_ROWS_END
    }
};
struct EpiGS {
    bf16_t* GS;
    __device__ __forceinline__ void operator()(AccRef acc, const Unit& u, int wr, int wc, int fr, int fq) const {
        const int col0 = u.ccol + wc * 32 + 8 * fq;
        EPI_ROWS_BEGIN
#pragma unroll
            for (int bj = 0; bj < 2; ++bj) { f32x4 a0 = acc[ai][bj][m][0], a1 = acc[ai][bj][m][1];
#pragma unroll
                for (int j = 0; j < 4; ++j) { a0[j] = sigmoidf_(a0[j] * WSC); a1[j] = sigmoidf_(a1[j] * WSC); }
                *(u32x4*)(GS + (size_t)(u.crow + rr) * 1024 + col0 + bj * 128) = pack8(a0, a1); }
        EPI_ROWS_END
    }
};
struct EpiBase {
    const bf16_t* GSB; bf16_t* H;
    __device__ __forceinline__ void operator()(AccRef acc, const Unit& u, int wr, int wc, int fr, int fq) const {
        const int col0 = u.ccol + wc * 32 + 8 * fq;
        EPI_ROWS_BEGIN
#pragma unroll
            for (int bj = 0; bj < 2; ++bj) { const size_t off = (size_t)(u.crow + rr) * 1024 + col0 + bj * 128;
                f32x4 g0, g1, h0, h1; unpack8(*(const u32x4*)(GSB + off), g0, g1); unpack8(*(const u32x4*)(H + off), h0, h1);
                const f32x4 o0 = acc[ai][bj][m][0] * g0 + h0 * ALPHA, o1 = acc[ai][bj][m][1] * g1 + h1 * ALPHA;
                *(u32x4*)(H + off) = pack8(o0, o1); }
        EPI_ROWS_END
    }
};

__device__ __forceinline__ void moe_prefix(Frame& F) {
    LAS int* tst = (LAS int*)(F.lds + TST_OFF);
    __syncthreads();
    if (F.wave == 0) {
        int c[5], tot = 0;
#pragma unroll
        for (int j = 0; j < 5; ++j) { const int i = 5 * F.lane + j, q = i / 65, e = i % 65; c[j] = i < 260 ? (e < 64 ? ((int)__hip_atomic_load(F.ctl + CW_CNT + q * 64 + e, RLX_AGENT) + 255) >> 8 : 32) : 0; tot += c[j]; }
        int inc = tot;
#pragma unroll
        for (int o = 1; o < 64; o <<= 1) { const int v = __shfl_up(inc, o); if (F.lane >= o) inc += v; }
        int run = inc - tot;
#pragma unroll
        for (int j = 0; j < 5; ++j) { const int i = 5 * F.lane + j; if (i < 260) tst[i] = run; run += c[j]; }
        if (F.lane == 63) tst[260] = inc;
    }
    __syncthreads();
}
template <int MODE> __device__ __forceinline__ void moe_units(Frame& F, int tq) {
    LAS int* tst = (LAS int*)(F.lds + TST_OFF); LAS int* tab = (LAS int*)(F.lds + TAB_OFF); LAS int* idx = (LAS int*)(F.lds + IDX_OFF);
    const int* LIST = (const int*)(F.ws + WS_LIST); const int* LDEST = (const int*)(F.ws + WS_LDEST); const float* LISTW = (const float*)(F.ws + WS_LISTW);
    moe_prefix(F);
    const int tile0 = MODE == 0 ? 0 : tst[tq * 65], ntile = MODE == 0 ? tst[260] : tst[tq * 65 + 65] - tile0, nunit = MODE == 0 ? 2 * ntile : 4 * ntile;
    constexpr int CAP = MODE == 0 ? 12 : 6;
    int n = (nunit - F.vcu + F.G - 1) / F.G; n = n < 0 ? 0 : (n > CAP ? CAP : n);
    if (F.tid < 260) { const int lo = tst[F.tid], hi = tst[F.tid + 1];
#pragma unroll
        for (int s = 0; s < CAP; ++s) { const int L = s * F.G + F.vcu, tile = tile0 + (MODE == 0 ? (L >> 1) : (L >> 2));
            if (s < n && lo <= tile && tile < hi) { LAS int* t = tab + 4 + 6 * s; t[0] = F.tid % 65; t[1] = tile - lo; t[2] = tile; t[3] = MODE == 0 ? (L & 1) : (L & 3); t[4] = F.tid / 65; } } }
    if (F.tid == 0) { tab[0] = n; tab[1] = nunit; }
    __syncthreads();
    for (int it = F.tid; it < n * 256; it += 512) { const int s = it >> 8, r = it & 255; const int e = tab[4 + 6 * s], ti = tab[5 + 6 * s], q = tab[8 + 6 * s]; const int p = ti * 256 + r;
        if (MODE == 0) { int v;
            if (e < 64) { const int cnt = (int)__hip_atomic_load(F.ctl + CW_CNT + q * 64 + e, RLX_AGENT); v = p < cnt ? LIST[(size_t)(q * 64 + e) * LCAP + p] : q * TQ_TOK; }
            else v = q * TQ_TOK + p;
            idx[it] = v;
        } else { int dest = p * 9 + 8; float w = 1.f;
            if (e < 64) { const int cnt = (int)__hip_atomic_load(F.ctl + CW_CNT + q * 64 + e, RLX_AGENT); const size_t li = (size_t)(q * 64 + e) * LCAP + (p < cnt ? p : 0); dest = p < cnt ? LDEST[li] : -1; w = LISTW[li]; }
            idx[it * 2] = dest; idx[it * 2 + 1] = __float_as_int(w); } }
    __syncthreads();
}
struct GUSched {
    const bf16_t* H; const bf16_t* W; LAS const int* tab; LAS const int* idx;
    __device__ __forceinline__ bool next(int i, Unit& u) const { if (i >= tab[0]) return false; u.e = tab[4 + 6 * i]; const int tile = tab[6 + 6 * i], pn = tab[7 + 6 * i];
        u.aux = i; u.arow = 0; u.crow = tile * 256; u.ccol = pn * 128; u.brow = u.e * 512 + pn * 256; return true; }
    __device__ __forceinline__ const char* abase(const Unit&) const { return (const char*)H; }
    __device__ __forceinline__ const char* bbase(const Unit& u) const { return (const char*)W + (size_t)u.brow * 512 * 2; }
    __device__ __forceinline__ void avoff(const Unit& u, const int (&R)[2], const int (&C)[2], unsigned (&v)[2][2]) const {
#pragma unroll
        for (int h = 0; h < 2; ++h)
#pragma unroll
            for (int i = 0; i < 2; ++i) v[h][i] = (unsigned)(idx[u.aux * 256 + h * 128 + R[i]] * 512 + C[i]) * 2u;
    }
};
struct DownSched {
    const unsigned char* HID; const unsigned char* W; LAS const int* tab;
    __device__ __forceinline__ bool next(int i, Unit& u) const { if (i >= tab[0]) return false; u.e = tab[4 + 6 * i]; u.aux = tab[5 + 6 * i]; const int tile = tab[6 + 6 * i], pn = tab[7 + 6 * i];
        u.arow = tile * 256; u.ccol = pn * 256; u.brow = u.e * 1024 + pn * 256; u.crow = i; return true; }
    __device__ __forceinline__ const char* abase(const Unit& u) const { return (const char*)HID + (size_t)u.arow * 256; }
    __device__ __forceinline__ const char* bbase(const Unit& u) const { return (const char*)W + (size_t)u.brow * 256; }
    __device__ __forceinline__ void avoff(const Unit&, const int (&R)[2], const int (&C)[2], unsigned (&v)[2][2]) const {
#pragma unroll
        for (int h = 0; h < 2; ++h)
#pragma unroll
            for (int i = 0; i < 2; ++i) v[h][i] = (unsigned)((h * 128 + R[i]) * 128 + C[i]) * 2u;
    }
};

struct TrItem { const float* W; bf16_t* WT; int K, N, destrow0, k0, n0, f8; };
__device__ __forceinline__ void tr_load(const TrItem& it, f32x4 (&tv)[8], int lane) {
#pragma unroll
    for (int j = 0; j < 8; ++j) tv[j] = *(const f32x4*)(it.W + (size_t)(it.k0 + 8 * (lane >> 3) + j) * it.N + it.n0 + 4 * (lane & 7));
}
__device__ __forceinline__ void tr_store(const TrItem& it, const f32x4 (&tv)[8], int lane) {
    if (it.f8) {
#pragma unroll
        for (int c = 0; c < 4; ++c) { int p0 = __builtin_amdgcn_cvt_pk_fp8_f32(tv[0][c] * 32.f, tv[1][c] * 32.f, 0, false); p0 = __builtin_amdgcn_cvt_pk_fp8_f32(tv[2][c] * 32.f, tv[3][c] * 32.f, p0, true);
            int p1 = __builtin_amdgcn_cvt_pk_fp8_f32(tv[4][c] * 32.f, tv[5][c] * 32.f, 0, false); p1 = __builtin_amdgcn_cvt_pk_fp8_f32(tv[6][c] * 32.f, tv[7][c] * 32.f, p1, true);
            *(u32x2*)((unsigned char*)it.WT + (size_t)(it.destrow0 + 4 * (lane & 7) + c) * it.K + it.k0 + 8 * (lane >> 3)) = (u32x2){(unsigned)p0, (unsigned)p1}; }
        return; }
#pragma unroll
    for (int c = 0; c < 4; ++c) { u32x4 o; o.x = pk2(tv[0][c], tv[1][c]); o.y = pk2(tv[2][c], tv[3][c]); o.z = pk2(tv[4][c], tv[5][c]); o.w = pk2(tv[6][c], tv[7][c]);
        *(u32x4*)(it.WT + (size_t)(it.destrow0 + 4 * (lane & 7) + c) * it.K + it.k0 + 8 * (lane >> 3)) = o; }
}
constexpr int I_IN = 16 * 64, I_GLU = 8 * 16, I_OUT = 16 * 32, I_PG = 16 * 32, I_PLE = 4 * 32, I_SMALL = I_IN + I_GLU + I_OUT + I_PG + I_PLE, I_G = 65 * 128, I_U = 65 * 128, I_D = 65 * 128, I_EXP = I_G + I_U + I_D;
__device__ __forceinline__ TrItem tr_decode_small(Frame& F, const Args& A, int r) {
    if (r < I_IN) return TrItem{A.in[2], (bf16_t*)(F.ws + WS_WIN), 1024, 2048, (r % 64) * 32, (r / 64) * 64, (r % 64) * 32, 0}; r -= I_IN;
    if (r < I_GLU) return TrItem{A.in[11], (bf16_t*)(F.ws + WS_WGLU), 512, 512, (r % 16) * 32, (r / 16) * 64, (r % 16) * 32, 0}; r -= I_GLU;
    if (r < I_OUT) return TrItem{A.in[13], (bf16_t*)(F.ws + WS_WOUT), 1024, 1024, (r % 32) * 32, (r / 32) * 64, (r % 32) * 32, 0}; r -= I_OUT;
    if (r < I_PG) return TrItem{A.in[25], (bf16_t*)(F.ws + WS_WPG), 1024, 1024, (r % 32) * 32, (r / 32) * 64, (r % 32) * 32, 1}; r -= I_PG;
    return TrItem{A.in[24], (bf16_t*)(F.ws + WS_WPLE), 256, 1024, (r % 32) * 32, (r / 32) * 64, (r % 32) * 32, 0};
}
__device__ __forceinline__ TrItem tr_decode_exp(Frame& F, const Args& A, int r) {
    bf16_t* WGU = (bf16_t*)(F.ws + WS_WGU); bf16_t* WD = (bf16_t*)(F.ws + WS_WD);
    if (r < I_G + I_U) { const bool up = r >= I_G; if (up) r -= I_G; const int e = r / 128, rr = r % 128, n0 = (rr % 8) * 32, k0 = (rr / 8) * 64;
        const float* src = e < 64 ? (up ? A.in[19] : A.in[18]) + (size_t)e * 1024 * 256 : (up ? A.in[22] : A.in[21]);
        return TrItem{src, (bf16_t*)((unsigned char*)WGU + (size_t)e * 512 * 1024), 1024, 256, (n0 >> 7) * 256 + (n0 & 127) + (up ? 128 : 0), k0, n0, 1}; }
    r -= I_G + I_U;
    { const int e = r / 128, rr = r % 128, n0 = (rr % 32) * 32, k0 = (rr / 32) * 64; const float* src = e < 64 ? A.in[20] + (size_t)e * 256 * 1024 : A.in[23];
        return TrItem{src, (bf16_t*)((unsigned char*)WD + (size_t)e * 1024 * 256), 256, 1024, n0, k0, n0, 1}; }
}
__device__ __forceinline__ int cvt_expert_burst(Frame& F, const Args& A, int cur, int nmax) {
    const int NGW = F.G * NWAVES;
    for (int k = 0; k < nmax && cur < I_EXP; k += 2) {
        const bool two = (k + 1 < nmax) && (cur + NGW < I_EXP);
        const TrItem a = tr_decode_exp(F, A, cur); f32x4 ta[8], tb[8]; tr_load(a, ta, F.lane);
        TrItem bI = a; if (two) { bI = tr_decode_exp(F, A, cur + NGW); tr_load(bI, tb, F.lane); }
        tr_store(a, ta, F.lane); if (two) tr_store(bI, tb, F.lane);
        cur += two ? 2 * NGW : NGW;
    }
    return cur;
}
#ifndef P0_EXPERTS
#define P0_EXPERTS 0
#endif
__device__ __forceinline__ void p0_prologue(Frame& F, const Args& A) {
    const int gw = F.vcu * NWAVES + F.wave, NGW = F.G * NWAVES;
    if (gw < I_SMALL) {
        TrItem cur = tr_decode_small(F, A, gw); f32x4 tv[8], tn[8]; tr_load(cur, tv, F.lane);
        for (int it = gw; it < I_SMALL; it += NGW) {
            const bool has = it + NGW < I_SMALL; TrItem nxt = cur;
            if (has) { nxt = tr_decode_small(F, A, it + NGW); tr_load(nxt, tn, F.lane); }
            tr_store(cur, tv, F.lane);
            cur = nxt;
#pragma unroll
            for (int i = 0; i < 8; ++i) tv[i] = tn[i];
        }
    }
    if (P0_EXPERTS && gw < I_EXP) {
        TrItem cur = tr_decode_exp(F, A, gw); f32x4 tv[8], tn[8]; tr_load(cur, tv, F.lane);
        for (int it = gw; it < I_EXP; it += NGW) {
            const bool has = it + NGW < I_EXP; TrItem nxt = cur;
            if (has) { nxt = tr_decode_exp(F, A, it + NGW); tr_load(nxt, tn, F.lane); }
            tr_store(cur, tv, F.lane);
            cur = nxt;
#pragma unroll
            for (int i = 0; i < 8; ++i) tv[i] = tn[i];
        }
    }
    { const float* x = A.in[0]; bf16_t* XB = (bf16_t*)(F.ws + WS_B);
      for (int m = gw * 4; m < M; m += NGW * 4) { f32x4 v[4][4];
#pragma unroll
          for (int r = 0; r < 4; ++r)
#pragma unroll
              for (int j = 0; j < 4; ++j) v[r][j] = ((const f32x4*)(x + (size_t)(m + r) * DM))[F.lane + 64 * j];
#pragma unroll
          for (int r = 0; r < 4; ++r)
#pragma unroll
              for (int j = 0; j < 4; ++j) ((u32x2*)(XB + (size_t)(m + r) * DM))[F.lane + 64 * j] = (u32x2){pk2(v[r][j][0], v[r][j][1]), pk2(v[r][j][2], v[r][j][3])}; } }
    { const float* wr = A.in[16]; bf16_t* WR = (bf16_t*)(F.ws + WS_WR);
      for (int i = (F.vcu * NWAVES + F.wave) * 64 + F.lane; i < 64 * 1024; i += NGW * 64) { const int e = i >> 10, k = i & 1023; const float v = wr[(size_t)k * 64 + e];
          const unsigned hb = f2bf(v); const float hf = __builtin_bit_cast(float, hb << 16); WR[i] = (bf16_t)hb; WR[65536 + i] = (bf16_t)f2bf(v - hf); } }
}

__device__ __forceinline__ void p2_attn_naive(Frame& F) {
    const bf16_t* Q = (const bf16_t*)(F.ws + WS_C); const bf16_t* Kb = Q + (size_t)M * 512; const bf16_t* Vb = Kb + (size_t)M * 512; bf16_t* MIX = (bf16_t*)(F.ws + WS_B);
    const int gw = F.vcu * NWAVES + F.wave, NGW = F.G * NWAVES, lane = F.lane;
    for (int item = gw; item < M * NH; item += NGW) {
        const int h = item & 7, bt = item >> 3, t = bt & (SEQ - 1), b = bt >> 12;
        const float q = bf2f(Q[(size_t)bt * 512 + h * 64 + lane]);
        const float slope2 = exp2f(-(float)(h + 1)) * LOG2E;
        float m = -INFINITY, l = 0.f, o = 0.f;
        for (int br = 0; br < 3; ++br) { const int dil = (br == 0) ? 1 : (br == 1 ? 4 : 16);
            for (int j = 0; j <= 128; ++j) { const int pos = t - j * dil; if (pos < 0) break;
                const size_t ro = (size_t)(b * SEQ + pos) * 512 + h * 64 + lane;
                const float kk = bf2f(Kb[ro]), vv = bf2f(Vb[ro]);
                const float s = wave_sum(q * kk) - slope2 * (float)(j * dil);
                const float mn = fmaxf(m, s); const float corr = exp2f(m - mn); const float pe = exp2f(s - mn);
                l = l * corr + pe; o = o * corr + pe * vv; m = mn; } }
        MIX[(size_t)bt * 1024 + h * 64 + lane] = (bf16_t)f2bf(o / l);
    }
}
__device__ __forceinline__ float gelu_tanh(float v) { return 0.5f * v * (1.f + tanhf(0.7978845608028654f * (v + 0.044715f * v * v * v))); }
__device__ __forceinline__ void p2_ssm_naive(Frame& F, const Args& A) {
    if (F.wave != 0) return;
    const bf16_t* U = (const bf16_t*)(F.ws + WS_D); bf16_t* Y = (bf16_t*)(F.ws + WS_D) + (size_t)M * 512;
    const float* lam_re = A.in[3]; const float* lam_im = A.in[4]; const float* log_dt = A.in[5]; const float* b_re = A.in[6]; const float* b_im = A.in[7];
    const float* c_re = A.in[8]; const float* c_im = A.in[9]; const float* d_skip = A.in[10];
    const int n = F.lane;
    for (int item = F.vcu; item < BATCH * NG; item += F.G) {
        const int b = item / NG, g = item % NG;
        const float lr = lam_re[g * NS + n], li = lam_im[g * NS + n], dt = expf(log_dt[g]);
        const float er = expf(lr * dt); const float ar = er * cosf(li * dt), ai = er * sinf(li * dt);
        const float den = lr * lr + li * li;
        const float gr = ((ar - 1.f) * lr + ai * li) / den, gi = (ai * lr - (ar - 1.f) * li) / den;
        float bbr[16], bbi[16], cr[16], ci[16];
#pragma unroll
        for (int c = 0; c < 16; ++c) { const float br = b_re[(g * NS + n) * GC + c], bi = b_im[(g * NS + n) * GC + c];
            bbr[c] = gr * br - gi * bi; bbi[c] = gr * bi + gi * br; cr[c] = c_re[(g * GC + c) * NS + n]; ci[c] = c_im[(g * GC + c) * NS + n]; }
        const float dsk = (n < 16) ? d_skip[g * GC + n] : 0.f;
        float sr = 0.f, si = 0.f;
        for (int t = 0; t < SEQ; ++t) {
            const u32x4* up = (const u32x4*)(U + (size_t)(b * SEQ + t) * 512 + g * GC);
            float u[16]; { f32x4 a0, a1, a2, a3; unpack8(up[0], a0, a1); unpack8(up[1], a2, a3);
#pragma unroll
                for (int c = 0; c < 4; ++c) { u[c] = a0[c]; u[4 + c] = a1[c]; u[8 + c] = a2[c]; u[12 + c] = a3[c]; } }
            float bur = 0.f, bui = 0.f;
#pragma unroll
            for (int c = 0; c < 16; ++c) { bur += bbr[c] * u[c]; bui += bbi[c] * u[c]; }
            const float nr = ar * sr - ai * si + bur, ni = ar * si + ai * sr + bui; sr = nr; si = ni;
            float my = 0.f, uc = 0.f;
#pragma unroll
            for (int c = 0; c < 16; ++c) { const float v = wave_sum(cr[c] * sr - ci[c] * si); if (n == c) { my = v; uc = u[c]; } }
            if (n < 16) Y[(size_t)(b * SEQ + t) * 512 + g * GC + n] = (bf16_t)f2bf(gelu_tanh(my + dsk * uc));
        }
    }
}

constexpr int P5_WB = 0, P5_BUF = 34816, P5_PART = 17408, P5_PITCH = 272, P5_SCR = 69632, P5_HIST = 104448, P5_BASEL = P5_HIST + 256, P5_RB = P5_HIST + 512, P5_GB = P5_HIST + 1024;
__device__ __forceinline__ void p5_ln_router(Frame& F, const Args& A, int fake) {
    const float* PRE = F.out; const f32x4* STATS = (const f32x4*)(F.ws + WS_STATS); const float* gam = A.in[14]; const float* bet = A.in[15]; const float* rbias = A.in[17];
    bf16_t* H = (bf16_t*)(F.ws + WS_B); unsigned char* H8 = F.ws + WS_H8; const bf16_t* WR = (const bf16_t*)(F.ws + WS_WR);
    int* LIST = (int*)(F.ws + WS_LIST); float* LISTW = (float*)(F.ws + WS_LISTW); int* LDEST = (int*)(F.ws + WS_LDEST); int* CNT = (int*)(F.ctl + CW_CNT);
    LAS unsigned char* lds = F.lds; LAS float* scr = (LAS float*)(lds + P5_SCR) + F.wave * (16 * 68); LAS int* hist = (LAS int*)(lds + P5_HIST); LAS int* basel = (LAS int*)(lds + P5_BASEL); LAS float* rb = (LAS float*)(lds + P5_RB);
    const int tid = F.tid, lane = F.lane, fr = lane & 15, g = lane >> 4;
    for (int rg = F.vcu; rg < M / 128; rg += F.G) {
        const int row = rg * 128 + F.wave * 16 + fr;
        if (tid < 64) { hist[tid] = 0; rb[tid] = rbias[tid]; }
        { LAS float* gbl = (LAS float*)(lds + P5_GB); for (int i = tid; i < 256; i += 512) { *(LAS f32x4*)(gbl + 4 * i) = *(const f32x4*)(gam + 4 * i); *(LAS f32x4*)(gbl + 1024 + 4 * i) = *(const f32x4*)(bet + 4 * i); } }
        float mean, rstd;
        { const f32x4 p0 = STATS[(size_t)row * 8 + 2 * g], p1 = STATS[(size_t)row * 8 + 2 * g + 1]; float s = (p0[0] + p0[2]) + (p1[0] + p1[2]), q = (p0[1] + p0[3]) + (p1[1] + p1[3]);
          s += __shfl_xor(s, 16); s += __shfl_xor(s, 32); q += __shfl_xor(q, 16); q += __shfl_xor(q, 32);
          mean = s * (1.f / DM); const float var = fmaxf(q * (1.f / DM) - mean * mean, 0.f); rstd = rsqrtf(var + LN_EPS); }
        u32x4 st[4];
#pragma unroll
        for (int i = 0; i < 4; ++i) { const int q = tid + 512 * i, part = q >> 10, rem = q & 1023, e = rem >> 4, pc = rem & 15; st[i] = *(const u32x4*)(WR + (size_t)part * 65536 + e * 1024 + pc * 8); }
        const float* prow = PRE + (size_t)row * DM + 8 * g;
        f32x4 pv[8], pn[8];
#pragma unroll
        for (int ks = 0; ks < 4; ++ks) { pv[2 * ks] = *(const f32x4*)(prow + ks * 32); pv[2 * ks + 1] = *(const f32x4*)(prow + ks * 32 + 4); }
#pragma unroll
        for (int i = 0; i < 4; ++i) { const int q = tid + 512 * i, part = q >> 10, rem = q & 1023, e = rem >> 4, pc = rem & 15; *(LAS u32x4*)(lds + P5_WB + part * P5_PART + e * P5_PITCH + pc * 16) = st[i]; }
        LDS_BARRIER();
        f32x4 acc[4];
#pragma unroll
        for (int nt = 0; nt < 4; ++nt) acc[nt] = (f32x4){0.f, 0.f, 0.f, 0.f};
        const LAS float* gbl = (const LAS float*)(lds + P5_GB) + 8 * g;
#pragma unroll 1
        for (int kc = 0; kc < 8; ++kc) {
            if (kc < 7) {
#pragma unroll
                for (int i = 0; i < 4; ++i) { const int q = tid + 512 * i, part = q >> 10, rem = q & 1023, e = rem >> 4, pc = rem & 15; st[i] = *(const u32x4*)(WR + (size_t)part * 65536 + e * 1024 + (kc + 1) * 128 + pc * 8); }
#pragma unroll
                for (int ks = 0; ks < 4; ++ks) { pn[2 * ks] = *(const f32x4*)(prow + (kc + 1) * 128 + ks * 32); pn[2 * ks + 1] = *(const f32x4*)(prow + (kc + 1) * 128 + ks * 32 + 4); }
            }
            LAS unsigned char* wb = lds + P5_WB + (kc & 1) * P5_BUF;
#pragma unroll
            for (int ks = 0; ks < 4; ++ks) {
                const int kk = kc * 128 + ks * 32 + 8 * g;
                f32x4 v0 = pv[2 * ks], v1 = pv[2 * ks + 1];
                const f32x4 g0 = *(const LAS f32x4*)(gbl + kc * 128 + ks * 32), g1 = *(const LAS f32x4*)(gbl + kc * 128 + ks * 32 + 4), b0 = *(const LAS f32x4*)(gbl + 1024 + kc * 128 + ks * 32), b1 = *(const LAS f32x4*)(gbl + 1024 + kc * 128 + ks * 32 + 4);
                v0 = (v0 - mean) * rstd * g0 + b0; v1 = (v1 - mean) * rstd * g1 + b1;
                const u32x4 hw = pack8(v0, v1);
                *(u32x4*)(H + (size_t)row * DM + kk) = hw;
                { int p0 = __builtin_amdgcn_cvt_pk_fp8_f32(v0[0], v0[1], 0, false); p0 = __builtin_amdgcn_cvt_pk_fp8_f32(v0[2], v0[3], p0, true); int p1 = __builtin_amdgcn_cvt_pk_fp8_f32(v1[0], v1[1], 0, false); p1 = __builtin_amdgcn_cvt_pk_fp8_f32(v1[2], v1[3], p1, true);
                  *(u32x2*)(H8 + (size_t)row * DM + kk) = (u32x2){(unsigned)p0, (unsigned)p1}; }
                f32x4 h0, h1; unpack8(hw, h0, h1);
                const u32x4 lw = pack8(v0 - h0, v1 - h1);
                const bf16x8 ahi = __builtin_bit_cast(bf16x8, hw), alo = __builtin_bit_cast(bf16x8, lw);
#pragma unroll
                for (int nt = 0; nt < 4; ++nt) {
                    const bf16x8 bhi = *(const LAS bf16x8*)(wb + (16 * nt + fr) * P5_PITCH + (ks * 32 + 8 * g) * 2);
                    const bf16x8 blo = *(const LAS bf16x8*)(wb + P5_PART + (16 * nt + fr) * P5_PITCH + (ks * 32 + 8 * g) * 2);
                    acc[nt] = __builtin_amdgcn_mfma_f32_16x16x32_bf16(ahi, bhi, acc[nt], 0, 0, 0);
                    acc[nt] = __builtin_amdgcn_mfma_f32_16x16x32_bf16(alo, bhi, acc[nt], 0, 0, 0);
                    acc[nt] = __builtin_amdgcn_mfma_f32_16x16x32_bf16(ahi, blo, acc[nt], 0, 0, 0);
                }
            }
            if (kc < 7) {
                LAS unsigned char* wn = lds + P5_WB + ((kc + 1) & 1) * P5_BUF;
#pragma unroll
                for (int i = 0; i < 4; ++i) { const int q = tid + 512 * i, part = q >> 10, rem = q & 1023, e = rem >> 4, pc = rem & 15; *(LAS u32x4*)(wn + part * P5_PART + e * P5_PITCH + pc * 16) = st[i]; }
#pragma unroll
                for (int i = 0; i < 8; ++i) pv[i] = pn[i];
            }
            LDS_BARRIER();
        }
        if (fake) continue;
#pragma unroll
        for (int nt = 0; nt < 4; ++nt)
#pragma unroll
            for (int r = 0; r < 4; ++r) scr[(4 * g + r) * 68 + 16 * nt + fr] = sigmoidf_(acc[nt][r]);
        __syncthreads();
        const int trow = lane >> 2, q4 = lane & 3;
        float sc[16], cand[16];
        { const LAS f32x4* sp = (const LAS f32x4*)(scr + trow * 68 + 16 * q4); const LAS f32x4* bp = (const LAS f32x4*)(rb + 16 * q4);
#pragma unroll
          for (int j = 0; j < 4; ++j) { const f32x4 s4 = sp[j], b4 = bp[j];
#pragma unroll
              for (int e = 0; e < 4; ++e) { sc[4 * j + e] = s4[e]; cand[4 * j + e] = s4[e] + b4[e]; } } }
        float gsc[2];
#pragma unroll
        for (int h = 0; h < 2; ++h) { float m1 = -INFINITY, m2 = -INFINITY;
#pragma unroll
            for (int j = 0; j < 8; ++j) { const float v = cand[8 * h + j]; const float lo_ = fminf(m1, v); m1 = fmaxf(m1, v); m2 = fmaxf(m2, lo_); }
            gsc[h] = m1 + m2; }
        float gs[8];
#pragma unroll
        for (int k = 0; k < 4; ++k) { gs[2 * k] = __shfl(gsc[0], (lane & ~3) + k); gs[2 * k + 1] = __shfl(gsc[1], (lane & ~3) + k); }
        unsigned gm = 0;
#pragma unroll
        for (int it = 0; it < 4; ++it) { float best = -INFINITY; int bi = 0;
#pragma unroll
            for (int gg = 0; gg < 8; ++gg) { const bool ok = !((gm >> gg) & 1u) && gs[gg] > best; best = ok ? gs[gg] : best; bi = ok ? gg : bi; }
            gm |= 1u << bi; }
#pragma unroll
        for (int j = 0; j < 16; ++j) if (!((gm >> (2 * q4 + (j >> 3))) & 1u)) cand[j] = -INFINITY;
        int idx[8]; float wv[8]; float wsum = 0.f;
#pragma unroll
        for (int it = 0; it < 8; ++it) {
            float bv = -INFINITY; int be = 0;
#pragma unroll
            for (int j = 0; j < 16; ++j) { const bool ok = cand[j] > bv; bv = ok ? cand[j] : bv; be = ok ? j : be; }
            be += 16 * q4;
#pragma unroll
            for (int o = 1; o < 4; o <<= 1) { const float ov = __shfl_xor(bv, o); const int oe = __shfl_xor(be, o); const bool take = (ov > bv) || (ov == bv && oe < be); bv = take ? ov : bv; be = take ? oe : be; }
            float mysc = 0.f;
#pragma unroll
            for (int j = 0; j < 16; ++j) { const bool hit = (be == 16 * q4 + j); cand[j] = hit ? -INFINITY : cand[j]; mysc = hit ? sc[j] : mysc; }
            const float w = __shfl(mysc, (lane & ~3) + (be >> 4));
            idx[it] = be; wv[it] = w; wsum += w;
        }
        int myrk[2];
#pragma unroll
        for (int h = 0; h < 2; ++h) { int e = 0;
#pragma unroll
            for (int it = 0; it < 8; ++it) if (it == 2 * q4 + h) e = idx[it];
            myrk[h] = __hip_atomic_fetch_add(hist + e, 1, __ATOMIC_RELAXED, __HIP_MEMORY_SCOPE_WORKGROUP); }
        __syncthreads();
        const int tq = rg >> 6;
        if (tid < 64) { const int c = hist[tid]; basel[tid] = c ? atomicAdd(CNT + tq * 64 + tid, c) : 0; }
        __syncthreads();
        { const int tok = rg * 128 + F.wave * 16 + trow; const float inv = ROUTED_SCALE / wsum;
#pragma unroll
          for (int h = 0; h < 2; ++h) { int e = 0; float w = 0.f;
#pragma unroll
              for (int it = 0; it < 8; ++it) if (it == 2 * q4 + h) { e = idx[it]; w = wv[it]; }
              const int pos = basel[e] + myrk[h]; const size_t li = (size_t)(tq * 64 + e) * LCAP + pos;
              LIST[li] = tok; LISTW[li] = w * inv; LDEST[li] = (tok - tq * TQ_TOK) * 9 + 2 * q4 + h; } }
        __syncthreads();
    }
}

__device__ __forceinline__ void p_combine_ln2(Frame& F, const Args& A, int tq, const unsigned char* SLAB, int b0, int nb) {
    const bf16_t* BASE = (const bf16_t*)(F.ws + WS_BASE); const float* gam = A.in[26]; const float* bet = A.in[27];
    if (F.vcu < b0 || F.vcu >= b0 + nb) return;
    const int gw = (F.vcu - b0) * NWAVES + F.wave, NGW = nb * NWAVES, lane = F.lane;
    for (int tl = gw; tl < TQ_TOK; tl += NGW) {
        const int t = tq * TQ_TOK + tl;
        u32x4 w[9]; u32x4 bw[2];
#pragma unroll
        for (int h = 0; h < 2; ++h) bw[h] = *(const u32x4*)(BASE + (size_t)t * 1024 + lane * 16 + h * 8);
#pragma unroll
        for (int k = 0; k < 9; ++k) w[k] = *(const u32x4*)(SLAB + ((size_t)tl * 9 + k) * 1024 + lane * 16);
        f32x4 s4[4];
#pragma unroll
        for (int j = 0; j < 4; ++j) s4[j] = (f32x4){0.f, 0.f, 0.f, 0.f};
#pragma unroll
        for (int k = 0; k < 9; ++k)
#pragma unroll
            for (int j = 0; j < 4; ++j) { const f32x2 d0 = __builtin_amdgcn_cvt_pk_f32_fp8((int)w[k][j], false), d1 = __builtin_amdgcn_cvt_pk_f32_fp8((int)w[k][j], true); s4[j] += (f32x4){d0[0], d0[1], d1[0], d1[1]}; }
        f32x4 v[4]; unpack8(bw[0], v[0], v[1]); unpack8(bw[1], v[2], v[3]);
#pragma unroll
        for (int j = 0; j < 4; ++j) v[j] += s4[j] * 0.0625f;
        float s = 0.f;
#pragma unroll
        for (int j = 0; j < 4; ++j) s += (v[j][0] + v[j][1]) + (v[j][2] + v[j][3]);
        const float mean = wave_sum(s) * (1.f / DM); float s2 = 0.f;
#pragma unroll
        for (int j = 0; j < 4; ++j) { v[j] = v[j] - mean; s2 += (v[j][0] * v[j][0] + v[j][1] * v[j][1]) + (v[j][2] * v[j][2] + v[j][3] * v[j][3]); }
        const float rstd = rsqrtf(wave_sum(s2) * (1.f / DM) + LN_EPS);
        float* op = F.out + (size_t)t * DM + lane * 16;
#pragma unroll
        for (int j = 0; j < 4; ++j) { const f32x4 gg = *(const f32x4*)(gam + lane * 16 + 4 * j), bb = *(const f32x4*)(bet + lane * 16 + 4 * j); *(f32x4*)(op + 4 * j) = v[j] * rstd * gg + bb; }
    }
}
__device__ __forceinline__ void p_convert_p(Frame& F, const Args& A) {
    const float* P = A.in[1]; bf16_t* PB = (bf16_t*)F.out;
    const int gw = F.vcu * NWAVES + F.wave, NGW = F.G * NWAVES;
    for (int m = gw * 8; m < M; m += NGW * 8) { f32x4 v[8];
#pragma unroll
        for (int r = 0; r < 8; ++r) v[r] = ((const f32x4*)(P + (size_t)(m + r) * PLE))[F.lane];
#pragma unroll
        for (int r = 0; r < 8; ++r) ((u32x2*)(PB + (size_t)(m + r) * PLE))[F.lane] = (u32x2){pk2(v[r][0], v[r][1]), pk2(v[r][2], v[r][3])}; }
}

constexpr size_t WS_KT = WS_E, WS_EM = WS_E + 2 * MiB, WS_MY = WS_E + 12 * MiB, WS_A64 = WS_E + 22 * MiB;
constexpr int KT_ELEMS = 65 * 256;
__device__ __forceinline__ void p0_ssm_tables(Frame& F, const Args& A, int gi, int sl) {
    const float* lam_re = A.in[3]; const float* lam_im = A.in[4]; const float* log_dt = A.in[5]; const float* b_re = A.in[6]; const float* b_im = A.in[7];
    const float* c_re = A.in[8]; const float* c_im = A.in[9];
    LAS f32x2* POW = (LAS f32x2*)(F.lds);
    LAS f32x2* BB = (LAS f32x2*)(F.lds + 33280);
    LAS f32x2* CC = (LAS f32x2*)(F.lds + 33280 + 8192);
    const int tid = F.tid; const float dt = expf(log_dt[gi]);
    __syncthreads();
    for (int idx = tid; idx < 65 * 64; idx += 512) { const int d = idx >> 6, n = idx & 63; const float lr = lam_re[gi * NS + n], li = lam_im[gi * NS + n];
        const float mag = expf(lr * dt * (float)d); float sn, cs; sincosf(li * dt * (float)d, &sn, &cs); POW[idx] = (f32x2){mag * cs, mag * sn}; }
    for (int idx = tid; idx < 64 * 16; idx += 512) { const int n = idx >> 4, c = idx & 15; const float lr = lam_re[gi * NS + n], li = lam_im[gi * NS + n];
        const float er = expf(lr * dt); float sn, cs; sincosf(li * dt, &sn, &cs); const float ar = er * cs, ai = er * sn, den = lr * lr + li * li;
        const float gr = ((ar - 1.f) * lr + ai * li) / den, gim = (ai * lr - (ar - 1.f) * li) / den;
        const float br = b_re[(gi * NS + n) * GC + c], bi = b_im[(gi * NS + n) * GC + c];
        BB[idx] = (f32x2){gr * br - gim * bi, gr * bi + gim * br}; }
    for (int idx = tid; idx < 16 * 64; idx += 512) CC[idx] = (f32x2){c_re[gi * 1024 + idx], c_im[gi * 1024 + idx]};
    __syncthreads();
    bf16_t* KT = (bf16_t*)(F.ws + WS_KT) + (size_t)gi * KT_ELEMS; bf16_t* EM = (bf16_t*)(F.ws + WS_EM) + (size_t)gi * 128 * 1024; bf16_t* MY = (bf16_t*)(F.ws + WS_MY) + (size_t)gi * 1024 * 128;
    for (int idx = sl * (KT_ELEMS / 8) + tid; idx < (sl + 1) * (KT_ELEMS / 8); idx += 512) { const int dd = idx >> 8, c = (idx >> 4) & 15, cp = idx & 15; float acc = 0.f;
        if (dd > 0) { const int d = dd - 1;
            for (int n = 0; n < 64; ++n) { const f32x2 p = POW[d * 64 + n], bb = BB[n * 16 + cp], cc = CC[c * 64 + n];
                const float wr = p[0] * bb[0] - p[1] * bb[1], wi = p[0] * bb[1] + p[1] * bb[0]; acc += cc[0] * wr - cc[1] * wi; } }
        KT[idx] = (bf16_t)f2bf(acc); }
    for (int idx = sl * 16384 + tid; idx < (sl + 1) * 16384; idx += 512) { const int ri = idx >> 10, k = idx & 1023, n = ri & 63, part = ri >> 6, j = k >> 4, cp = k & 15;
        const f32x2 p = POW[(63 - j) * 64 + n], bb = BB[n * 16 + cp]; const float v = part == 0 ? p[0] * bb[0] - p[1] * bb[1] : p[0] * bb[1] + p[1] * bb[0];
        EM[idx] = (bf16_t)f2bf(v); }
    for (int idx = sl * 16384 + tid; idx < (sl + 1) * 16384; idx += 512) { const int row = idx >> 7, ki = idx & 127, t = row >> 4, c = row & 15, n = ki & 63, part = ki >> 6;
        const f32x2 p = POW[(t + 1) * 64 + n], cc = CC[c * 64 + n]; const float v = part == 0 ? cc[0] * p[0] - cc[1] * p[1] : -(cc[0] * p[1] + cc[1] * p[0]);
        MY[idx] = (bf16_t)f2bf(v); }
    if (sl == 0 && tid < 64) ((f32x2*)(F.ws + WS_A64))[gi * 64 + tid] = POW[64 * 64 + tid];
    __syncthreads();
}

__device__ __forceinline__ float gelu_tanh_f(float v) { const float u = 0.7978845608028654f * (v + 0.044715f * v * v * v); const float e = __expf(2.f * u); return v * (1.f - 1.f / (e + 1.f)); }
constexpr int SS_KT = 0, SS_ES = 33280, SS_MYB = 33280, SS_MYP = 272, SS_EMB = 66560, SS_EMP = 144, SS_EMBUF = 128 * SS_EMP, SS_SP = 103424, SS_SPP = 136;
static_assert(SS_EMB + 2 * SS_EMBUF <= SS_SP && SS_MYB + 256 * SS_MYP <= SS_SP && SS_SP + 64 * SS_SPP * 2 <= RING_BYTES, "SSM LDS map");
__device__ __forceinline__ void ssm_unit(Frame& F, const Args& A, int b, int gi, int fake) {
    const bf16_t* U = (const bf16_t*)(F.ws + WS_D); bf16_t* Y = (bf16_t*)(F.ws + WS_D) + (size_t)M * 512; const float* d_skip = A.in[10];
    const bf16_t* KTg = (const bf16_t*)(F.ws + WS_KT) + (size_t)gi * KT_ELEMS; const bf16_t* EM = (const bf16_t*)(F.ws + WS_EM) + (size_t)gi * 128 * 1024; const bf16_t* MY = (const bf16_t*)(F.ws + WS_MY) + (size_t)gi * 1024 * 128;
    LAS unsigned char* lds = F.lds; LAS bf16_t* KT = (LAS bf16_t*)(lds + SS_KT); LAS float* ES = (LAS float*)(lds + SS_ES); LAS bf16_t* SP = (LAS bf16_t*)(lds + SS_SP);
    const int tid = F.tid, lane = F.lane, fr = lane & 15, g = lane >> 4, w = F.wave, nt = w & 3, wh = w >> 2;
    __syncthreads();
    for (int i = tid; i < KT_ELEMS / 8; i += 512) ((LAS u32x4*)KT)[i] = ((const u32x4*)KTg)[i];
    const size_t tokb = (size_t)b * SEQ + (size_t)(16 * nt + fr) * 64;
    const bf16_t* ub = U + tokb * 512 + gi * 16 + 8 * (g & 1) + (size_t)(g >> 1) * 512;
    if (!(fake & 2)) { f32x4 acc[4];
#pragma unroll
      for (int i = 0; i < 4; ++i) acc[i] = (f32x4){0.f, 0.f, 0.f, 0.f};
      const int er0 = tid >> 3, es = tid & 7;
      const bf16_t* eg = EM + (size_t)er0 * 1024 + es * 8;
      u32x4 re[4][2]; bf16x8 rb[4][2];
#define SS_LD(j, kc) do { re[j][0] = *(const u32x4*)(eg + (kc) * 64); re[j][1] = *(const u32x4*)(eg + (size_t)64 * 1024 + (kc) * 64); \
          rb[j][0] = *(const bf16x8*)(ub + (size_t)(2 * (kc)) * 1024); rb[j][1] = *(const bf16x8*)(ub + (size_t)(2 * (kc) + 1) * 1024); } while (0)
#pragma unroll
      for (int j = 0; j < 4; ++j) SS_LD(j, j);
#pragma unroll
      for (int kq = 0; kq < 16; kq += 4) {
#pragma unroll
          for (int j = 0; j < 4; ++j) { const int kc = kq + j; LAS unsigned char* eb = lds + SS_EMB + (kc & 1) * SS_EMBUF;
              *(LAS u32x4*)(eb + er0 * SS_EMP + es * 16) = re[j][0]; *(LAS u32x4*)(eb + (er0 + 64) * SS_EMP + es * 16) = re[j][1];
              const bf16x8 b0 = rb[j][0], b1 = rb[j][1];
              if (kc + 4 < 16) SS_LD(j, kc + 4);
              LDS_BARRIER();
              bf16x8 af[2][4];
#pragma unroll
              for (int q = 0; q < 2; ++q)
#pragma unroll
                  for (int i = 0; i < 4; ++i) af[q][i] = *(const LAS bf16x8*)(eb + (wh * 64 + i * 16 + fr) * SS_EMP + q * 64 + g * 16);
#pragma unroll
              for (int i = 0; i < 4; ++i) { acc[i] = __builtin_amdgcn_mfma_f32_16x16x32_bf16(af[0][i], b0, acc[i], 0, 0, 0); acc[i] = __builtin_amdgcn_mfma_f32_16x16x32_bf16(af[1][i], b1, acc[i], 0, 0, 0); } } }
#undef SS_LD
#pragma unroll
      for (int i = 0; i < 4; ++i)
#pragma unroll
          for (int r = 0; r < 4; ++r) ES[(wh * 64 + i * 16 + 4 * g + r) * 65 + 16 * nt + fr] = acc[i][r]; }
    __syncthreads();
    if (tid < 64 && !(fake & 4)) { const f32x2 a = ((const f32x2*)(F.ws + WS_A64))[gi * 64 + tid]; float sr = 0.f, si = 0.f;
        for (int c = 0; c < 64; ++c) { SP[c * SS_SPP + tid] = (bf16_t)f2bf(sr); SP[c * SS_SPP + 64 + tid] = (bf16_t)f2bf(si);
            const float er = ES[tid * 65 + c], ei = ES[(64 + tid) * 65 + c]; const float nr = a[0] * sr - a[1] * si + er, ni = a[0] * si + a[1] * sr + ei; sr = nr; si = ni; } }
    const int mr0 = tid >> 4, ms = tid & 15; const bf16_t* mg = MY + (size_t)mr0 * 128 + ms * 8;
    u32x4 rm[8];
#pragma unroll
    for (int i = 0; i < 8; ++i) rm[i] = *(const u32x4*)(mg + (size_t)(32 * i) * 128);
    LDS_BARRIER();
    if (!(fake & 8)) { const f32x4 dsk = *(const f32x4*)(d_skip + gi * 16 + 4 * g);
      const LAS bf16_t* ka = KT + fr * 16 + 8 * (g & 1) + (1 - (g >> 1) + wh) * 256;
#pragma unroll 1
      for (int B = 0; B < 4; ++B) {
          f32x4 acc[8];
#pragma unroll
          for (int i = 0; i < 8; ++i) acc[i] = (f32x4){0.f, 0.f, 0.f, 0.f};
          bf16x8 ring[4];
#pragma unroll
          for (int j = 0; j < 4; ++j) ring[j] = *(const bf16x8*)(ub + (size_t)j * 1024);
#pragma unroll
          for (int i = 0; i < 8; ++i) *(LAS u32x4*)(lds + SS_MYB + (mr0 + 32 * i) * SS_MYP + ms * 16) = rm[i];
          if (B < 3) {
#pragma unroll
              for (int i = 0; i < 8; ++i) rm[i] = *(const u32x4*)(mg + (size_t)(256 * (B + 1) + 32 * i) * 128); }
          LDS_BARRIER();
#pragma unroll
          for (int ks = 0; ks < 4; ++ks) { const bf16x8 bs = *(const LAS bf16x8*)(SP + (16 * nt + fr) * SS_SPP + ks * 32 + 8 * g);
              bf16x8 af[8];
#pragma unroll
              for (int i = 0; i < 8; ++i) af[i] = *(const LAS bf16x8*)(lds + SS_MYB + ((2 * i + wh) * 16 + fr) * SS_MYP + ks * 64 + g * 16);
#pragma unroll
              for (int i = 0; i < 8; ++i) acc[i] = __builtin_amdgcn_mfma_f32_16x16x32_bf16(af[i], bs, acc[i], 0, 0, 0); }
#pragma unroll 1
          for (int kb = 0; kb < 8 * B; kb += 4) {
#pragma unroll
              for (int j = 0; j < 4; ++j) { const int ks = kb + j;
                  const bf16x8 bf = ring[j]; ring[j] = *(const bf16x8*)(ub + (size_t)(ks + 4) * 1024);
                  const LAS bf16_t* kk = ka + (8 * B - ks) * 512;
                  bf16x8 af[8];
#pragma unroll
                  for (int i = 0; i < 8; ++i) af[i] = *(const LAS bf16x8*)(kk + i * 512);
                  __builtin_amdgcn_sched_barrier(0);
#pragma unroll
                  for (int i = 0; i < 8; ++i) acc[i] = __builtin_amdgcn_mfma_f32_16x16x32_bf16(af[i], bf, acc[i], 0, 0, 0);
                  __builtin_amdgcn_sched_barrier(0); } }
#pragma unroll
          for (int d = 0; d < 8; ++d) {
              const bf16x8 bf = ring[d & 3]; if (d < 4) ring[d & 3] = *(const bf16x8*)(ub + (size_t)(8 * B + d + 4) * 1024);
#pragma unroll
              for (int i = d; i < 8; ++i) { const bf16x8 af = *(const LAS bf16x8*)(ka + (i - d) * 512); acc[i] = __builtin_amdgcn_mfma_f32_16x16x32_bf16(af, bf, acc[i], 0, 0, 0); } }
#pragma unroll
          for (int i = 0; i < 8; ++i) { const int t = 2 * (8 * B + i) + wh; const size_t off = (tokb + t) * 512 + gi * 16 + 4 * g;
              const u32x2 uw = *(const u32x2*)(U + off); const f32x4 uv = (f32x4){bflo(uw.x), bfhi(uw.x), bflo(uw.y), bfhi(uw.y)};
              f32x4 y = acc[i] + dsk * uv;
#pragma unroll
              for (int r = 0; r < 4; ++r) y[r] = gelu_tanh_f(y[r]);
              if (!(fake & 1)) *(u32x2*)(Y + off) = (u32x2){cvtpk(y[0], y[1]), cvtpk(y[2], y[3])}; }
          LDS_BARRIER();
      } }
}

constexpr int AT_QU = 512  , AT_OST = 0, AT_OP = 72  , AT_M = 73728, AT_L = 75776, AT_V = 77824, AT_VW = 4608, AT_VP = 144;
typedef short s16x4 __attribute__((ext_vector_type(4)));
__device__ __forceinline__ s16x4 vtr(const LAS unsigned char* p) { return __builtin_bit_cast(s16x4, __builtin_amdgcn_ds_read_tr16_b64_v4i16((LAS s16x4*)p)); }
__device__ __forceinline__ float xmax16(float x) { auto r = __builtin_amdgcn_permlane16_swap(__float_as_uint(x), __float_as_uint(x), false, false); return fmaxf(__uint_as_float(r[0]), __uint_as_float(r[1])); }
__device__ __forceinline__ float xmax32(float x) { auto r = __builtin_amdgcn_permlane32_swap(__float_as_uint(x), __float_as_uint(x), false, false); return fmaxf(__uint_as_float(r[0]), __uint_as_float(r[1])); }
template <bool SHARED>
__device__ __forceinline__ void attn_branch(Frame& F, int b, int h, int t0, int br, int r, int pp, int fake) {
    const bf16_t* Qg = (const bf16_t*)(F.ws + WS_C); bf16_t* MIXo = (bf16_t*)(F.ws + WS_B);
    LAS unsigned char* lds = F.lds; LAS bf16_t* Ost = (LAS bf16_t*)(lds + AT_OST); LAS float* Mst = (LAS float*)(lds + AT_M); LAS float* Lst = (LAS float*)(lds + AT_L);
    const int lane = F.lane, fr = lane & 15, g = lane >> 4;
    const float slope2 = exp2f(-(float)(h + 1)) * LOG2E, sr = slope2 * (float)r;
    const size_t rowb = (size_t)b * SEQ;
    const int vrow = lane >> 3, vch = lane & 7;
    constexpr int NS_ = SHARED ? 1 : 2;
    int qpos[2], lo[2], hi[2], k0s[NS_]; bf16x8 qf0[2], qf1[2]; float m[2], l[2]; f32x4 o[2][4]; bf16x8 kf[NS_][2][2]; u32x4 vr[NS_][4]; f32x4 biasC[2][2];
    LAS unsigned char* vb[NS_]; const LAS unsigned char* trp[NS_];
#pragma unroll
    for (int X = 0; X < 2; ++X) {
        int base;
        if (SHARED) { const int p = F.wave + 8 * pp, cls = p % r, pi = p / r; base = t0 + cls + (2 * pi + X) * 16 * r; }
        else { const int s = F.wave + 8 * X; base = t0 + s; }
        qpos[X] = base + r * fr;
        const int k0 = (SHARED ? base - 16 * r * X : base) - 128 * r;
        if (X < NS_) k0s[X < NS_ ? X : 0] = k0;
        const int nmin = k0 < 0 ? (-k0 + r - 1) / r : 0, sh = SHARED ? 16 * X : 0;
        lo[X] = (fr + sh) > nmin ? (fr + sh) : nmin; hi[X] = fr + sh + 128;
        const bf16_t* qp = Qg + (rowb + qpos[X]) * 512 + h * 64 + 8 * g; qf0[X] = *(const bf16x8*)qp; qf1[X] = *(const bf16x8*)(qp + 32);
        m[X] = -1e30f; l[X] = 0.f;
#pragma unroll
        for (int dt = 0; dt < 4; ++dt) o[X][dt] = (f32x4){0.f, 0.f, 0.f, 0.f};
#pragma unroll
        for (int T = 0; T < 2; ++T)
#pragma unroll
            for (int rr = 0; rr < 4; ++rr) biasC[X][T][rr] = sr * (float)(16 * T + 4 * g + rr - sh - 128 - fr);
    }
    const __amdgpu_buffer_rsrc_t rs = __builtin_amdgcn_make_buffer_rsrc((void*)F.ws, 0, 0x7fffffff, 0x00020000);
    int koff[NS_][2], voff[NS_][4], nminu[NS_];
#pragma unroll
    for (int Y = 0; Y < NS_; ++Y) {
        vb[Y] = lds + AT_V + F.wave * AT_VW; trp[Y] = vb[Y] + (4 * g + (fr >> 2)) * AT_VP + (fr & 3) * 8;
        nminu[Y] = k0s[Y] < 0 ? (-k0s[Y] + r - 1) / r : 0;
#pragma unroll
        for (int T = 0; T < 2; ++T) koff[Y][T] = (int)(WS_C + (size_t)M * 1024) + (int)((((long)rowb + k0s[Y] + r * (16 * T + fr)) * 512 + h * 64 + 8 * g) * 2);
#pragma unroll
        for (int i = 0; i < 4; ++i) voff[Y][i] = (int)(WS_C + (size_t)M * 2048) + (int)((((long)rowb + k0s[Y] + r * (vrow + 8 * i)) * 512 + h * 64 + vch * 8) * 2);
    }
    const int kstepb = fake ? 0 : 32768 * r;
#define AT_LOAD(Y, n0) do { const int so_ = ((n0) >> 5) * kstepb; _Pragma("unroll") for (int T = 0; T < 2; ++T) { \
            kf[Y][T][0] = __builtin_bit_cast(bf16x8, __builtin_amdgcn_raw_buffer_load_b128(rs, koff[Y][T], so_, 0)); kf[Y][T][1] = __builtin_bit_cast(bf16x8, __builtin_amdgcn_raw_buffer_load_b128(rs, koff[Y][T] + 64, so_, 0)); } \
        _Pragma("unroll") for (int i = 0; i < 4; ++i) vr[Y][i] = __builtin_amdgcn_raw_buffer_load_b128(rs, voff[Y][i], so_, 0); } while (0)
#pragma unroll
    for (int Y = 0; Y < NS_; ++Y) AT_LOAD(Y, 0);
#pragma unroll 1
    for (int st = 0; st < 5; ++st) {
        const int n0 = st * 32; f32x4 sT[2][2]; bf16x8 pb[2];
#pragma unroll
        for (int Y = 0; Y < NS_; ++Y)
#pragma unroll
            for (int i = 0; i < 4; ++i) *(LAS u32x4*)(vb[Y] + (vrow + 8 * i) * AT_VP + vch * 16) = vr[Y][i];
#pragma unroll
        for (int X = 0; X < 2; ++X)
#pragma unroll
            for (int T = 0; T < 2; ++T) { constexpr int dummy = 0; (void)dummy; const int Y = SHARED ? 0 : X;
                sT[X][T] = __builtin_amdgcn_mfma_f32_16x16x32_bf16(kf[Y][T][0], qf0[X], biasC[X][T], 0, 0, 0); sT[X][T] = __builtin_amdgcn_mfma_f32_16x16x32_bf16(kf[Y][T][1], qf1[X], sT[X][T], 0, 0, 0); }
        if (st < 4) {
#pragma unroll
            for (int Y = 0; Y < NS_; ++Y) AT_LOAD(Y, n0 + 32); }
        const float off = sr * (float)n0;
#pragma unroll
        for (int X = 0; X < 2; ++X) {
            const int Y = SHARED ? 0 : X;
            const bool full = (st >= 1) && (st <= 3) && (n0 >= nminu[Y]);
            if (!full) { const unsigned span = (unsigned)(hi[X] - lo[X]);
#pragma unroll
                for (int T = 0; T < 2; ++T)
#pragma unroll
                    for (int rr = 0; rr < 4; ++rr) { const int n = n0 + 16 * T + 4 * g + rr; if ((unsigned)(n - lo[X]) > span) sT[X][T][rr] = -1e30f; } }
            float pmax = fmaxf(fmaxf(fmaxf(sT[X][0][0], sT[X][0][1]), fmaxf(sT[X][0][2], sT[X][0][3])), fmaxf(fmaxf(sT[X][1][0], sT[X][1][1]), fmaxf(sT[X][1][2], sT[X][1][3])));
            pmax = xmax32(xmax16(pmax)) + off;
            const float mn = fmaxf(m[X], pmax);
            if (__any(mn > m[X])) { const float f = __builtin_amdgcn_exp2f(m[X] - mn); l[X] *= f;
#pragma unroll
                for (int dt = 0; dt < 4; ++dt) o[X][dt] = o[X][dt] * f; }
            m[X] = mn; const float ml = mn - off; float ps = 0.f;
#pragma unroll
            for (int T = 0; T < 2; ++T)
#pragma unroll
                for (int rr = 0; rr < 4; ++rr) { const float p = __builtin_amdgcn_exp2f(sT[X][T][rr] - ml); sT[X][T][rr] = p; ps += p; }
            l[X] += ps;
            const u32x4 pw = (u32x4){cvtpk(sT[X][0][0], sT[X][0][1]), cvtpk(sT[X][0][2], sT[X][0][3]), cvtpk(sT[X][1][0], sT[X][1][1]), cvtpk(sT[X][1][2], sT[X][1][3])};
            pb[X] = __builtin_bit_cast(bf16x8, pw);
        }
#pragma unroll
        for (int dt = 0; dt < 4; ++dt) {
            bf16x8 vf[NS_];
#pragma unroll
            for (int Y = 0; Y < NS_; ++Y) { const s16x4 lo4 = vtr(trp[Y] + dt * 32), hi4 = vtr(trp[Y] + 16 * AT_VP + dt * 32); vf[Y] = (bf16x8){lo4[0], lo4[1], lo4[2], lo4[3], hi4[0], hi4[1], hi4[2], hi4[3]}; }
#pragma unroll
            for (int X = 0; X < 2; ++X) o[X][dt] = __builtin_amdgcn_mfma_f32_16x16x32_bf16(vf[SHARED ? 0 : X], pb[X], o[X][dt], 0, 0, 0);
        }
    }
#undef AT_LOAD
#pragma unroll
    for (int X = 0; X < 2; ++X) {
        float lx = l[X]; lx += __shfl_xor(lx, 16); lx += __shfl_xor(lx, 32); float mx = m[X];
        const int qi = qpos[X] - t0;
        if (br > 0) { const float ms = Mst[qi], ls = Lst[qi]; const float mn = fmaxf(mx, ms), f1 = __builtin_amdgcn_exp2f(mx - mn), f2 = __builtin_amdgcn_exp2f(ms - mn);
#pragma unroll
            for (int dt = 0; dt < 4; ++dt) { const u32x2 ow = *(const LAS u32x2*)(Ost + qi * AT_OP + 16 * dt + 4 * g); const f32x4 os = (f32x4){bflo(ow.x), bfhi(ow.x), bflo(ow.y), bfhi(ow.y)}; o[X][dt] = o[X][dt] * f1 + os * f2; }
            lx = lx * f1 + ls * f2; mx = mn; }
        if (br < 2) {
#pragma unroll
            for (int dt = 0; dt < 4; ++dt) *(LAS u32x2*)(Ost + qi * AT_OP + 16 * dt + 4 * g) = (u32x2){cvtpk(o[X][dt][0], o[X][dt][1]), cvtpk(o[X][dt][2], o[X][dt][3])};
            if (g == 0) { Mst[qi] = mx; Lst[qi] = lx; }
        } else if (!fake) { const float inv = 1.f / lx; bf16_t* op = MIXo + (rowb + qpos[X]) * 1024 + h * 64 + 4 * g;
#pragma unroll
            for (int dt = 0; dt < 4; ++dt) { const f32x4 v = o[X][dt] * inv; *(u32x2*)(op + 16 * dt) = (u32x2){cvtpk(v[0], v[1]), cvtpk(v[2], v[3])}; } }
    }
}
struct CvtPend { int cur; bool has; TrItem it; f32x4 tv[8]; };
__device__ __forceinline__ void cvt_step(Frame& F, const Args& A, CvtPend& P) {
    if (P.has) tr_store(P.it, P.tv, F.lane);
    P.has = P.cur < I_EXP;
    if (P.has) { P.it = tr_decode_exp(F, A, P.cur); tr_load(P.it, P.tv, F.lane); P.cur += F.G * NWAVES; }
}
__device__ __forceinline__ void attn_unit(Frame& F, const Args& A, int b, int h, int t0, int fake, CvtPend& P) {
#pragma unroll 1
    for (int br = 0; br < 3; ++br) { const int r = br == 0 ? 16 : (br == 1 ? 4 : 1);
#pragma unroll 1
        for (int pp = 0; pp < 2; ++pp) { attn_branch<true>(F, b, h, t0, br, r, pp, fake); if (!fake && !P0_EXPERTS) cvt_step(F, A, P); }
        __syncthreads(); }
}
__device__ __forceinline__ void p2_mixers(Frame& F, const Args& A) {
    CvtPend P; P.cur = F.vcu * NWAVES + F.wave; P.has = false;
#ifndef REP_SSM
#define REP_SSM 1
#endif
#ifndef REP_ATT
#define REP_ATT 1
#endif
#ifndef SSM_FAKE
#define SSM_FAKE 0
#endif
#ifndef ATT_FAKE
#define ATT_FAKE 0
#endif
    for (int rp = 0; rp < REP_SSM; ++rp)
    for (int u = F.vcu; u < BATCH * NG; u += F.G) ssm_unit(F, A, u / NG, u % NG, rp > 0 ? SSM_FAKE : 0);
    __syncthreads();
    for (int rp = 0; rp < REP_ATT; ++rp)
    for (int u = F.vcu; u < BATCH * NH * (SEQ / AT_QU); u += F.G) { const int qb = u & 7, bh = u >> 3; attn_unit(F, A, bh >> 3, bh & 7, qb * AT_QU, rp > 0 ? ATT_FAKE : 0, P); }
    if (P.has) tr_store(P.it, P.tv, F.lane);
    if (!P0_EXPERTS) (void)cvt_expert_burst(F, A, P.cur, 1 << 20);
}

constexpr int N_PHASES = 12;
__global__ void __launch_bounds__(NWAVES * 64, 2) mk_fwd(Args args) {
    extern __shared__ __attribute__((aligned(16))) unsigned char lds_raw[];
    Frame F;
    F.lds = (LAS unsigned char*)lds_raw;
    F.MISC = (volatile LAS unsigned*)(F.lds + MISC_OFF);
    F.tid = threadIdx.x; F.lane = F.tid & 63; F.wave = __builtin_amdgcn_readfirstlane(F.tid >> 6);
    F.G = gridDim.x; { const int bx = blockIdx.x; F.vcu = (F.G % 8 == 0) ? (bx % 8) * (F.G / 8) + bx / 8 : bx; }
    F.ws = args.ws; F.out = args.out; F.ctl = (unsigned*)(args.ws + WS_CTL);
    for (int u = F.tid; u < (LDS_BYTES - LDSCTL_OFF) / 4; u += NWAVES * 64) ((LAS unsigned*)(F.lds + LDSCTL_OFF))[u] = 0u;
    __syncthreads();
    const int lo = args.ph_lo, hi = args.ph_hi;
    XcdBarrier bar; bar.bar = F.ctl + CW_BAR; bar.x = 0; bar.st = nullptr;
    if (hi - lo > 1) bar = xcd_barrier_post(F.ctl + CW_BAR, F.MISC + 8);
#ifndef PH_MASK
#define PH_MASK 0xfff
#endif
#define IN(k) (((PH_MASK >> (k)) & 1) && lo <= (k) && (k) < hi)
#ifndef REPEAT_MASK
#define REPEAT_MASK 0
#endif
#ifndef P5_FAKE
#define P5_FAKE 0
#endif
#ifndef PROBE_EPI_MODE
#define PROBE_EPI_MODE 0
#endif
#define PH(k) if (IN(k)) for (int rep_ = 0; rep_ < 1 + ((REPEAT_MASK >> (k)) & 1); ++rep_)
#define RELAUNDER() do { int t_ = threadIdx.x; asm volatile("" : "+v"(t_)); F.tid = t_; F.lane = t_ & 63; F.wave = __builtin_amdgcn_readfirstlane(t_ >> 6); \
        GAS unsigned char* w_ = (GAS unsigned char*)args.ws; GAS float* o_ = (GAS float*)args.out; asm volatile("" : "+s"(w_), "+s"(o_)); F.ws = (unsigned char*)w_; F.out = (float*)o_; F.ctl = (unsigned*)(w_ + WS_CTL); } while (0)
#define XB ((bf16_t*)(F.ws + WS_B))
#define MIX XB
#define H XB
#define Qb ((bf16_t*)(F.ws + WS_C))
#define Ub ((bf16_t*)(F.ws + WS_D))
#define Yb (Ub + (size_t)M * 512)
#define SEAM(k) do { if (IN(k) && IN((k) + 1)) xcd_barrier(bar); } while (0)
    LAS unsigned char* ring = F.lds + RING_OFF;

    PH(0) { RELAUNDER(); for (int it = F.vcu; it < NG * 8; it += F.G) p0_ssm_tables(F, args, it >> 3, it & 7); p0_prologue(F, args); } SEAM(0);
    PH(1) { RELAUNDER();
        pg8::PlainSched S; S.init(XB, (const bf16_t*)(F.ws + WS_WIN), M, ZC, DM, F.G, (int)blockIdx.x);
        EpiQKVU E{Qb};
        pg8::gemm_phase<EpiQKVU, pg8::PlainSched, true>(ring, DM, S, E);
    } SEAM(1);
    PH(2) { RELAUNDER(); p2_mixers(F, args); } SEAM(2);
    PH(3) { RELAUNDER();
        pg8::PlainSched S; S.init(Yb, (const bf16_t*)(F.ws + WS_WGLU), M, SW, SW, F.G, (int)blockIdx.x);
        EpiGLU E{Yb, args.in[12], MIX};
        pg8::gemm_phase<EpiGLU, pg8::PlainSched, true>(ring, SW, S, E);
    } SEAM(3);
    PH(4) { RELAUNDER();
        pg8::PlainSched S; S.init(MIX, (const bf16_t*)(F.ws + WS_WOUT), M, DM, DM, F.G, (int)blockIdx.x);
        EpiWout E{args.in[0], F.out, (f32x2*)(F.ws + WS_STATS)};
        pg8::gemm_phase<EpiWout, pg8::PlainSched, true>(ring, DM, S, E);
    } SEAM(4);
    PH(5) { RELAUNDER();
#if (REPEAT_MASK >> 5) & 1
        if (rep_ == 1 && !P5_FAKE) { xcd_barrier(bar); if (blockIdx.x == 0 && F.tid < 256) __hip_atomic_store(F.ctl + CW_CNT + F.tid, 0u, RLX_AGENT); xcd_barrier(bar); }
#endif
        p5_ln_router(F, args, rep_ == 1 ? P5_FAKE : 0); } SEAM(5);
#define SLABQ(q) ((unsigned char*)(F.ws + (((q) & 1) ? WS_SLAB1 : WS_SLAB0)))
#define DOWN(q) do { DownSched S{(const unsigned char*)(F.ws + WS_HID), (const unsigned char*)(F.ws + WS_WD), (LAS const int*)(F.lds + TAB_OFF)}; \
        EpiDown E{SLABQ(q), (LAS const int*)(F.lds + IDX_OFF)}; pg8::gemm_phase<EpiDown, DownSched, false, true>(ring, EH / 2, S, E); } while (0)
#define COMB_LIGHT(q) p_combine_ln2(F, args, (q), SLABQ(q), 0, F.G)
    PH(6) { RELAUNDER();
        p_convert_p(F, args);
        { pg8::PlainSched S; S.init((const bf16_t*)(F.ws + WS_H8), (const bf16_t*)(F.ws + WS_WPG), M, DM, DM / 2, F.G, (int)blockIdx.x);
          EpiGS E{(bf16_t*)((char*)F.out + OUT_GS)};
          pg8::gemm_phase<EpiGS, pg8::PlainSched, true, true>(ring, DM / 2, S, E); }
        moe_units<0>(F, 0);
        { GUSched S{(const bf16_t*)(F.ws + WS_H8), (const bf16_t*)(F.ws + WS_WGU), (LAS const int*)(F.lds + TAB_OFF), (LAS const int*)(F.lds + IDX_OFF)}; EpiGU E{(unsigned char*)(F.ws + WS_HID)};
          pg8::gemm_phase<EpiGU, GUSched, true, true>(ring, DM / 2, S, E); }
    } SEAM(6);
    PH(7) { RELAUNDER();
        { pg8::PlainSched S; S.init((const bf16_t*)F.out, (const bf16_t*)(F.ws + WS_WPLE), M, DM, PLE, F.G, (int)blockIdx.x);
          EpiBase E{(const bf16_t*)((const char*)F.out + OUT_GS), H};
          pg8::gemm_phase<EpiBase, pg8::PlainSched, true>(ring, PLE, S, E); }
        moe_units<1>(F, 0); DOWN(0);
    } SEAM(7);
#ifndef REP_COMB
#define REP_COMB 1
#endif
#ifndef REP_DOWN
#define REP_DOWN 1
#endif
    PH(8)  { RELAUNDER(); moe_units<1>(F, 1); for (int rc = 0; rc < REP_COMB; ++rc) COMB_LIGHT(0); for (int rd = 0; rd < REP_DOWN; ++rd) DOWN(1); } SEAM(8);
    PH(9)  { RELAUNDER(); moe_units<1>(F, 2); COMB_LIGHT(1); DOWN(2); } SEAM(9);
    PH(10) { RELAUNDER(); moe_units<1>(F, 3); COMB_LIGHT(2); DOWN(3); } SEAM(10);
    PH(11) { RELAUNDER(); p_combine_ln2(F, args, 3, SLABQ(3), 0, F.G); }
#undef SLABQ
#undef DOWN
#undef COMB_LIGHT
#undef IN
#undef SEAM
#undef XB
#undef MIX
#undef H
#undef Qb
#undef Ub
#undef Yb

}

#ifndef HYBRID
#define HYBRID 0
#endif
#ifndef ONE_LAUNCH
#define ONE_LAUNCH 0
#endif
extern "C" void kernel_launch(void* const* d_in, const int* in_sizes, int n_in, void* d_out, int out_size, void* d_ws, size_t ws_size, hipStream_t stream) {
    static int grid = 0;
    if (grid == 0) {
        if (n_in != 28 || out_size != M * DM || ws_size < WS_END) { fprintf(stderr, "kernel_launch: unexpected shapes (n_in %d out %d ws %zu)\n", n_in, out_size, ws_size); grid = -1; return; }
        int dev = 0, cus = 0;
        if (hipGetDevice(&dev) != hipSuccess || hipDeviceGetAttribute(&cus, hipDeviceAttributeMultiprocessorCount, dev) != hipSuccess) { grid = -1; return; }
        if (hipFuncSetAttribute((const void*)mk_fwd, hipFuncAttributeMaxDynamicSharedMemorySize, LDS_BYTES) != hipSuccess) { fprintf(stderr, "kernel_launch: hipFuncSetAttribute failed\n"); grid = -1; return; }
        grid = cus;
    }
    if (grid < 0) return;
    (void)hipMemsetAsync((char*)d_ws + WS_CTL, 0, CTL_ZERO_BYTES, stream);
    Args a{};
    for (int i = 0; i < 28; ++i) a.in[i] = (const float*)d_in[i];
    a.out = (float*)d_out; a.ws = (unsigned char*)d_ws;
    const int last_phase = (HYBRID == 2) ? 5 : N_PHASES;
    if (ONE_LAUNCH) { a.ph_lo = 0; a.ph_hi = last_phase; hipLaunchKernelGGL(mk_fwd, dim3(grid), dim3(NWAVES * 64), LDS_BYTES, stream, a); }
    else for (int p = 0; p < last_phase; ++p) { a.ph_lo = p; a.ph_hi = p + 1; hipLaunchKernelGGL(mk_fwd, dim3(grid), dim3(NWAVES * 64), LDS_BYTES, stream, a); }
#if HYBRID == 2
    {
        using nv::GP;
        const float* pin = (const float*)d_in[1];
        const float* ln1_g = (const float*)d_in[14]; const float* ln1_b = (const float*)d_in[15]; const float* w_router = (const float*)d_in[16]; const float* router_bias = (const float*)d_in[17];
        const float* w_gate = (const float*)d_in[18]; const float* w_up = (const float*)d_in[19]; const float* w_down = (const float*)d_in[20];
        const float* ws_gate = (const float*)d_in[21]; const float* ws_up = (const float*)d_in[22]; const float* ws_down = (const float*)d_in[23];
        const float* w_ple = (const float*)d_in[24]; const float* w_pg = (const float*)d_in[25]; const float* ln2_g = (const float*)d_in[26]; const float* ln2_b = (const float*)d_in[27];
        float* out = (float*)d_out; char* ws = (char*)d_ws;
        float* HID = (float*)(ws); float* H = (float*)(ws + 256 * MiB); float* HIDS = (float*)(ws + 384 * MiB); float* SC = (float*)(ws + 448 * MiB);
        int* LIST = (int*)(ws + 456 * MiB); float* LISTW = (float*)(ws + 464 * MiB); int* CNT = (int*)(ws + 472 * MiB); int* OFF = CNT + 64;
        GP g{};
        nv::k_ln<<<M / 4, 256, 0, stream>>>(out, H, ln1_g, ln1_b);
        g = GP{}; g.A = H; g.lda = DM; g.B = w_router; g.ldb = NE; g.K = DM; g.nrows = M; g.C = SC; g.ldc = NE;
        nv::k_gemm<3><<<dim3(1, M / 64), 256, 0, stream>>>(g);
        (void)hipMemsetAsync(CNT, 0, 128 * sizeof(int), stream);
        nv::k_topk<<<M / 256, 256, 0, stream>>>(SC, router_bias, CNT, LIST, LISTW);
        nv::k_prefix<<<1, 64, 0, stream>>>(CNT, OFF);
        (void)hipMemsetAsync(out, 0, (size_t)M * DM * sizeof(float), stream);
        g = GP{}; g.A = H; g.lda = DM; g.B = w_gate; g.B2 = w_up; g.ldb = EH; g.K = DM; g.C = HID; g.ldc = EH; g.cnt = CNT; g.off = OFF; g.list = LIST; g.listw = LISTW;
        nv::k_gemm<4><<<dim3(EH / 64, M / 64, NE), 256, 0, stream>>>(g);
        g = GP{}; g.A = HID; g.lda = EH; g.B = w_down; g.ldb = DM; g.K = EH; g.C = out; g.ldc = DM; g.cnt = CNT; g.off = OFF; g.list = LIST; g.listw = LISTW;
        nv::k_gemm<5><<<dim3(DM / 64, M / 64, NE), 256, 0, stream>>>(g);
        g = GP{}; g.A = H; g.lda = DM; g.B = ws_gate; g.B2 = ws_up; g.ldb = EH; g.K = DM; g.nrows = M; g.C = HIDS; g.ldc = EH;
        nv::k_gemm<6><<<dim3(EH / 64, M / 64), 256, 0, stream>>>(g);
        g = GP{}; g.A = HIDS; g.lda = EH; g.B = ws_down; g.ldb = DM; g.K = EH; g.nrows = M; g.C = out; g.ldc = DM;
        nv::k_gemm<7><<<dim3(DM / 64, M / 64), 256, 0, stream>>>(g);
        g = GP{}; g.A = pin; g.lda = PLE; g.B = w_ple; g.ldb = DM; g.K = PLE; g.nrows = M; g.C = out; g.ldc = DM; g.A2 = H; g.lda2 = DM; g.B2 = w_pg; g.ldb2 = DM; g.K2 = DM;
        nv::k_gemm<8><<<dim3(DM / 64, M / 64), 256, 0, stream>>>(g);
        nv::k_ln<<<M / 4, 256, 0, stream>>>(out, out, ln2_g, ln2_b);
    }
#endif
}
```

```cpp
#include <hip/hip_runtime.h>
#include <cstdint>
#include <cstdio>
#include <cmath>

#define LAS __attribute__((address_space(3)))
#define GAS __attribute__((address_space(1)))
typedef unsigned short bf16_t;
typedef short bf16x8 __attribute__((ext_vector_type(8)));
typedef float f32x4 __attribute__((ext_vector_type(4)));
typedef float f32x2 __attribute__((ext_vector_type(2)));
typedef unsigned u32x4 __attribute__((ext_vector_type(4)));
typedef unsigned u32x2 __attribute__((ext_vector_type(2)));

constexpr int BATCH = 8, SEQ = 4096, DM = 1024, M = BATCH * SEQ;
constexpr int NH = 8, HD = 64, AW = 512, SW = 512, NG = 32, GC = 16, NS = 64;
constexpr int NE = 64, TOPK = 8, EH = 256, PLE = 256, ZC = 2048;
constexpr float ALPHA = 1.189207115002721f;
constexpr float LN_EPS = 1e-5f;
constexpr float ROUTED_SCALE = 2.5f;
constexpr float LOG2E = 1.4426950408889634f;
constexpr float QSCALE = 0.125f * LOG2E;

__device__ __forceinline__ unsigned f2bf(float f) { unsigned u = __builtin_bit_cast(unsigned, f); return (u + 0x7fffu + ((u >> 16) & 1u)) >> 16; }
__device__ __forceinline__ unsigned pk2(float lo, float hi) { return f2bf(lo) | (f2bf(hi) << 16); }
__device__ __forceinline__ float bf2f(unsigned short b) { return __builtin_bit_cast(float, (unsigned)b << 16); }
__device__ __forceinline__ float bflo(unsigned w) { return __builtin_bit_cast(float, w << 16); }
__device__ __forceinline__ float bfhi(unsigned w) { return __builtin_bit_cast(float, w & 0xffff0000u); }
__device__ __forceinline__ float wave_sum(float v) {
#pragma unroll
    for (int o = 1; o < 64; o <<= 1) v += __shfl_xor(v, o);
    return v;
}
__device__ __forceinline__ float sigmoidf_(float x) { return 1.f / (1.f + __expf(-x)); }
#define HYBRID 0
#define ONE_LAUNCH 1

namespace pg8 {
constexpr int BM = 256, BK = 64, HALF = 128, HTB = HALF * BK * 2  , STAGE_BYTES = 8 * HTB, NXCD = 8, WGM = 8;

__host__ __device__ __forceinline__ int lds_byte(int r, int c) { const int st = (r >> 4) * 2 + (c >> 5), rr = r & 15, cc = c & 31, ob = rr * 64 + cc * 2; return st * 1024 + (ob ^ (((ob >> 9) & 1) << 5)); }
__host__ __device__ __forceinline__ void stage_rc(int b, int& R, int& C) { const int st = b / 1024, sb = b % 1024, swz = sb ^ (((sb >> 9) & 1) << 5); R = (st >> 1) * 16 + swz / 64; C = (st & 1) * 32 + (swz % 64) / 2; }
__host__ __device__ __forceinline__ int perm32(int rho) { const int n = rho >> 4, i = rho & 15; return 8 * (i >> 2) + 4 * n + (i & 3); }

struct Unit { int arow, brow, crow, ccol, e, aux; };

typedef int i32x8 __attribute__((ext_vector_type(8)));
typedef int i32x4 __attribute__((ext_vector_type(4)));
__device__ __forceinline__ i32x8 cat8(bf16x8 a, bf16x8 b) { return __builtin_shufflevector(__builtin_bit_cast(i32x4, a), __builtin_bit_cast(i32x4, b), 0, 1, 2, 3, 4, 5, 6, 7); }
template <class Epi, class Sched, bool ALIGN_EPI, bool F8 = false, int BMODE = 0>
__device__ __forceinline__ void gemm_phase(LAS unsigned char* lds, const int K, const Sched& S, const Epi& E) {
    int tid_l = threadIdx.x; asm volatile("" : "+v"(tid_l));
    const int tid = tid_l, wid = __builtin_amdgcn_readfirstlane(tid >> 6), lane = tid & 63, wr = wid >> 2, wc = wid & 3, fr = lane & 15, fq = lane >> 4;
    const int nt = K / BK;
    unsigned voffB[2];
#pragma unroll
    for (int i = 0; i < 2; ++i) { int R, C; stage_rc(tid * 16 + i * 8192, R, C); const int Rb = (R & ~31) + perm32(R & 31); voffB[i] = BMODE == 0 ? (unsigned)(Rb * K + C) * 2u : (unsigned)((64 * (Rb >> 5) + (Rb & 31)) * K + C) * 2u; }
#define PG8_AVOFF(u_, v_) do { int Ra[2], Ca[2]; int t_ = tid; asm volatile("" : "+v"(t_)); _Pragma("unroll") for (int i = 0; i < 2; ++i) stage_rc(t_ * 16 + i * 8192, Ra[i], Ca[i]); S.avoff(u_, Ra, Ca, v_); } while (0)
    const size_t kstep = (size_t)(BK * 2);
    const size_t hstep = (size_t)(BMODE == 0 ? HALF : 32) * K * 2;
    const unsigned ldsw = (unsigned)wid * 1024u;
    const int aoff = lds_byte(wr * 64 + fr, fq * 8), boff = lds_byte(wc * 32 + fr, fq * 8);
#define PG8_SA(b, h) (((b) * 2 + (h)) * HTB)
#define PG8_SB(b, h) ((4 + (b) * 2 + (h)) * HTB)
#define PG8_STAGE(bufoff, gbase, v0, v1) do { \
        __builtin_amdgcn_global_load_lds((const unsigned*)((const char*)(gbase) + (v0)), (LAS unsigned*)(lds + (bufoff) + ldsw), 16, 0, 0); \
        __builtin_amdgcn_global_load_lds((const unsigned*)((const char*)(gbase) + (v1)), (LAS unsigned*)(lds + (bufoff) + ldsw + 8192), 16, 0, 0); } while (0)
#define PG8_LDA(dst, b, h) do { if constexpr (F8) { _Pragma("unroll") for (int m = 0; m < 4; ++m) dst##8[m] = cat8(*(const LAS bf16x8*)(lds + PG8_SA(b, h) + aoff + m * 2048), *(const LAS bf16x8*)(lds + PG8_SA(b, h) + aoff + m * 2048 + 1024)); } \
        else { _Pragma("unroll") for (int m = 0; m < 4; ++m) _Pragma("unroll") for (int k = 0; k < 2; ++k) dst[m][k] = *(const LAS bf16x8*)(lds + PG8_SA(b, h) + aoff + m * 2048 + k * 1024); } } while (0)
#define PG8_LDB(dst, b, h) do { if constexpr (F8) { _Pragma("unroll") for (int n = 0; n < 2; ++n) dst##8[n] = cat8(*(const LAS bf16x8*)(lds + PG8_SB(b, h) + boff + n * 2048), *(const LAS bf16x8*)(lds + PG8_SB(b, h) + boff + n * 2048 + 1024)); } \
        else { _Pragma("unroll") for (int n = 0; n < 2; ++n) _Pragma("unroll") for (int k = 0; k < 2; ++k) dst[n][k] = *(const LAS bf16x8*)(lds + PG8_SB(b, h) + boff + n * 2048 + k * 1024); } } while (0)
#define PG8_MMA(ai, bj, At, Bt) do { __builtin_amdgcn_s_setprio(1); if constexpr (F8) { _Pragma("unroll") for (int m = 0; m < 4; ++m) _Pragma("unroll") for (int n = 0; n < 2; ++n) \
            acc[ai][bj][m][n] = __builtin_amdgcn_mfma_scale_f32_16x16x128_f8f6f4(Bt##8[n], At##8[m], acc[ai][bj][m][n], 0, 0, 0, 0x7f7f7f7f, 0, 0x7f7f7f7f); } \
        else { _Pragma("unroll") for (int m = 0; m < 4; ++m) _Pragma("unroll") for (int n = 0; n < 2; ++n) _Pragma("unroll") for (int k = 0; k < 2; ++k) \
            acc[ai][bj][m][n] = __builtin_amdgcn_mfma_f32_16x16x32_bf16(Bt[n][k], At[m][k], acc[ai][bj][m][n], 0, 0, 0); } __builtin_amdgcn_s_setprio(0); } while (0)
#define PG8_WAIT_V(n) asm volatile("s_waitcnt vmcnt(" #n ")" ::: "memory")
#define PG8_WAIT_L(n) asm volatile("s_waitcnt lgkmcnt(" #n ")" ::: "memory")
#define PG8_BAR __builtin_amdgcn_s_barrier()
#define PG8_SCHED __builtin_amdgcn_sched_barrier(0)
    Unit cur, nxt; int ui = 0;
    if (!S.next(0, cur)) return;
    f32x4 acc[2][2][4][2];
#pragma unroll
    for (int a = 0; a < 2; ++a)
#pragma unroll
        for (int b = 0; b < 2; ++b)
#pragma unroll
            for (int m = 0; m < 4; ++m)
#pragma unroll
                for (int n = 0; n < 2; ++n) acc[a][b][m][n] = (f32x4){0.f, 0.f, 0.f, 0.f};
    bf16x8 At[4][2], B0[2][2], B1[2][2]; i32x8 At8[4], B08[2], B18[2];
    unsigned cv[2][2];
    PG8_AVOFF(cur, cv);
    const char* cA = S.abase(cur); const char* cB = S.bbase(cur);
    PG8_STAGE(PG8_SB(0, 0), cB, voffB[0], voffB[1]); PG8_STAGE(PG8_SB(0, 1), cB + hstep, voffB[0], voffB[1]); PG8_STAGE(PG8_SA(0, 0), cA, cv[0][0], cv[0][1]); PG8_STAGE(PG8_SA(0, 1), cA, cv[1][0], cv[1][1]);
    if (wr == 1) PG8_BAR;
    PG8_WAIT_V(2); PG8_BAR;
    PG8_STAGE(PG8_SB(1, 0), cB + kstep, voffB[0], voffB[1]); PG8_STAGE(PG8_SA(1, 0), cA + kstep, cv[0][0], cv[0][1]); PG8_STAGE(PG8_SB(1, 1), cB + hstep + kstep, voffB[0], voffB[1]);
    PG8_WAIT_V(6); PG8_BAR;
    for (;;) {
        const bool has_next = S.next(ui + 1, nxt);
        const char* nA = cA; const char* nB = cB;
        if (has_next) { nA = S.abase(nxt); nB = S.bbase(nxt); }
#pragma unroll 1
        for (int t = 0; t < nt; t += 2) {
            const bool last = (t == nt - 2);
            const char* a1 = cA + (size_t)(t + 1) * kstep;
            const char* a2 = last ? nA : cA + (size_t)(t + 2) * kstep; const char* b2 = last ? nB : cB + (size_t)(t + 2) * kstep;
            const char* a3 = a2 + kstep; const char* b3 = b2 + kstep;
            PG8_LDB(B0, 0, 0); PG8_LDB(B1, 0, 1); PG8_SCHED; PG8_LDA(At, 0, 0); PG8_STAGE(PG8_SA(1, 1), a1, cv[1][0], cv[1][1]);
            if (last && has_next) PG8_AVOFF(nxt, cv);
            PG8_WAIT_V(8); PG8_WAIT_L(0); PG8_BAR; PG8_MMA(0, 0, At, B0); PG8_MMA(0, 1, At, B1); PG8_BAR; PG8_SCHED;
            PG8_LDA(At, 0, 1); PG8_STAGE(PG8_SB(0, 0), b2, voffB[0], voffB[1]); PG8_STAGE(PG8_SB(0, 1), b2 + hstep, voffB[0], voffB[1]); PG8_STAGE(PG8_SA(0, 0), a2, cv[0][0], cv[0][1]);
            PG8_WAIT_V(8); PG8_WAIT_L(0); PG8_BAR; PG8_MMA(1, 0, At, B0); PG8_MMA(1, 1, At, B1); PG8_BAR; PG8_SCHED;
            PG8_LDB(B0, 1, 0); PG8_LDB(B1, 1, 1); PG8_SCHED; PG8_LDA(At, 1, 0); PG8_STAGE(PG8_SA(0, 1), a2, cv[1][0], cv[1][1]);
            PG8_WAIT_V(8); PG8_WAIT_L(0); PG8_BAR; PG8_MMA(0, 0, At, B0); PG8_MMA(0, 1, At, B1); PG8_BAR; PG8_SCHED;
            PG8_LDA(At, 1, 1); PG8_STAGE(PG8_SB(1, 0), b3, voffB[0], voffB[1]); PG8_STAGE(PG8_SB(1, 1), b3 + hstep, voffB[0], voffB[1]); PG8_STAGE(PG8_SA(1, 0), a3, cv[0][0], cv[0][1]);
            PG8_WAIT_V(8); PG8_WAIT_L(0); PG8_BAR; PG8_MMA(1, 0, At, B0); PG8_MMA(1, 1, At, B1); PG8_BAR; PG8_SCHED;
        }
        if constexpr (ALIGN_EPI) { if (wr == 0) PG8_BAR; }
        E(acc, cur, wr, wc, fr, fq);
        if (!has_next) break;
#pragma unroll
        for (int a = 0; a < 2; ++a)
#pragma unroll
            for (int b = 0; b < 2; ++b)
#pragma unroll
                for (int m = 0; m < 4; ++m)
#pragma unroll
                    for (int n = 0; n < 2; ++n) acc[a][b][m][n] = (f32x4){0.f, 0.f, 0.f, 0.f};
        cur = nxt; cA = nA; cB = nB; ++ui;
        if constexpr (ALIGN_EPI) { if (wr == 1) PG8_BAR; }
    }
    PG8_WAIT_V(0);
    if constexpr (!ALIGN_EPI) { if (wr == 0) PG8_BAR; }
    PG8_BAR;
#undef PG8_AVOFF
#undef PG8_SA
#undef PG8_SB
#undef PG8_STAGE
#undef PG8_LDA
#undef PG8_LDB
#undef PG8_MMA
#undef PG8_WAIT_V
#undef PG8_WAIT_L
#undef PG8_BAR
#undef PG8_SCHED
}

struct PlainSched {
    const bf16_t* A; const bf16_t* Bt; int K; int nM, nN, nwg, G, c;
    __device__ void init(const bf16_t* A_, const bf16_t* Bt_, int Mr, int N, int K_, int G_, int c_) { A = A_; Bt = Bt_; K = K_; nM = Mr / BM; nN = N / BM; nwg = nM * nN; G = G_; c = c_; }
    __device__ __forceinline__ bool next(int i, Unit& u) const {
        const long L = (long)i * G + c; if (L >= nwg) return false;
        int wgid = (int)L; { const int q = nwg / NXCD, r = nwg % NXCD, xcd = wgid % NXCD, off = wgid / NXCD; wgid = (xcd < r ? xcd * (q + 1) : r * (q + 1) + (xcd - r) * q) + off; }
        const int nig = WGM * nN, gid = wgid / nig, fm = gid * WGM, gsz = (nM - fm) < WGM ? (nM - fm) : WGM;
        const int pm = fm + ((wgid % nig) % gsz), pn = (wgid % nig) / gsz;
        u.arow = pm * BM; u.brow = pn * BM; u.crow = pm * BM; u.ccol = pn * BM; u.e = 0; u.aux = 0; return true;
    }
    __device__ __forceinline__ const char* abase(const Unit& u) const { return (const char*)A + (size_t)u.arow * K * 2; }
    __device__ __forceinline__ const char* bbase(const Unit& u) const { return (const char*)Bt + (size_t)u.brow * K * 2; }
    __device__ __forceinline__ void avoff(const Unit&, const int (&R)[2], const int (&C)[2], unsigned (&v)[2][2]) const {
#pragma unroll
        for (int h = 0; h < 2; ++h)
#pragma unroll
            for (int i = 0; i < 2; ++i) v[h][i] = (unsigned)((h * HALF + R[i]) * K + C[i]) * 2u;
    }
};
}

constexpr size_t MiB = 1u << 20;
constexpr size_t WS_CTL = 0, CTL_ZERO_BYTES = 64 * 1024;
constexpr size_t WS_LDEST = 1 * MiB;
constexpr size_t WS_LIST = 9 * MiB;
constexpr size_t WS_LISTW = 17 * MiB;
constexpr size_t WS_STATS = 25 * MiB;
constexpr size_t WS_WR = 29 * MiB;
constexpr size_t WS_WIN = 30 * MiB;
constexpr size_t WS_WGLU = 34 * MiB;
constexpr size_t WS_WOUT = 35 * MiB;
constexpr size_t WS_WPG = 37 * MiB;
constexpr size_t WS_WGU = 39 * MiB;
constexpr size_t WS_WD = 104 * MiB;
constexpr size_t WS_WPLE = 136 * MiB + 512 * 1024;
constexpr size_t WS_B = 137 * MiB;
constexpr size_t WS_C = 201 * MiB;
constexpr size_t WS_D = 297 * MiB;
constexpr size_t WS_E = 361 * MiB;
constexpr size_t WS_BASE = WS_B;
constexpr size_t WS_HID = 201 * MiB;
constexpr size_t WS_SLAB0 = 30 * MiB, WS_SLAB1 = 377 * MiB;
constexpr size_t OUT_GS = 16 * MiB;
constexpr size_t WS_H8 = 449 * MiB;
constexpr size_t WS_END = 512 * MiB;
constexpr int TQ_TOK = 8192, LCAP = 8192;
static_assert(WS_WD + (size_t)65 * 1024 * 256 * 2 <= WS_WPLE && WS_HID + (size_t)360448 * 512 <= WS_SLAB1 && WS_SLAB1 + (size_t)TQ_TOK * 9 * 1024 <= WS_END && WS_SLAB0 + (size_t)TQ_TOK * 9 * 1024 <= WS_WD, "ws map");
constexpr int CW_CNT = 64;
constexpr int CW_BAR = 1024;

constexpr int RING_OFF = 0, RING_BYTES = 131072;
constexpr int LDSCTL_OFF = RING_BYTES;
constexpr int MISC_OFF = LDSCTL_OFF;
constexpr int TAB_OFF = LDSCTL_OFF + 128;
constexpr int TST_OFF = LDSCTL_OFF + 512;
constexpr int IDX_OFF = LDSCTL_OFF + 2048;
constexpr int LDS_BYTES = 147456;
static_assert(IDX_OFF + 12 * 1024 <= LDS_BYTES, "LDS map");

constexpr int NWAVES = 8;
#define RLX_AGENT __ATOMIC_RELAXED, __HIP_MEMORY_SCOPE_AGENT
#define LDS_WAIT() asm volatile("s_waitcnt lgkmcnt(0)" ::: "memory")
#define VM_WAIT() asm volatile("s_waitcnt vmcnt(0)" ::: "memory")
#define LDS_BARRIER() do { asm volatile("s_waitcnt lgkmcnt(0)" ::: "memory"); __builtin_amdgcn_s_barrier(); asm volatile("" ::: "memory"); } while (0)

#define XB_TMO      128
#define XB_XCNT(j)  (256  + 64 * (j))
#define XB_XSUB(j)  (1280 + 64 * (j))
#define XB_XGEN(j)  (2304 + 64 * (j))
#define XB_TOP      3328
#define XB_TOPGEN   3392
#define XCD_BAR_WORDS 3456
#define XB_SPIN_CAP (1u << 18)
__device__ __forceinline__ unsigned xb_ld(unsigned* p)              { return __hip_atomic_load(p, __ATOMIC_RELAXED, __HIP_MEMORY_SCOPE_AGENT); }
__device__ __forceinline__ unsigned xb_add(unsigned* p, unsigned v) { return __hip_atomic_fetch_add(p, v, __ATOMIC_RELAXED, __HIP_MEMORY_SCOPE_AGENT); }
__device__ __forceinline__ unsigned xb_xcc_id() { return (unsigned)__builtin_amdgcn_s_getreg((3 << 11) | 20) & 0xFu; }
#define XB_SPIN(cond, bar) do { unsigned _sp = 0; while (cond) { __builtin_amdgcn_s_sleep(1); \
    if ((++_sp & 255u) == 0u) { if (xb_ld(&(bar)[XB_TMO])) break; if (_sp > XB_SPIN_CAP) { atomicAdd(&(bar)[XB_TMO], 1u); break; } } } } while (0)
struct XcdBarrier { unsigned* bar; unsigned x; volatile LAS unsigned* st; };
__device__ __forceinline__ XcdBarrier xcd_barrier_post(unsigned* bar, volatile LAS unsigned* st) {
    XcdBarrier b; b.bar = bar; b.x = xb_xcc_id(); b.st = st;
    if (threadIdx.x == 0) (void)xb_add(&bar[XB_XCNT(b.x)], 1u);
    return b;
}
__device__ __forceinline__ void xcd_barrier_complete(unsigned* bar, unsigned x, unsigned& nloc, unsigned& nx) {
    const unsigned G = gridDim.x * gridDim.y * gridDim.z;
    unsigned sum, cnt, mine, sp = 0u;
    for (;;) {
        sum = 0u; cnt = 0u; mine = 0u;
#pragma unroll
        for (unsigned j = 0; j < 16; ++j) { const unsigned c = xb_ld(&bar[XB_XCNT(j)]); sum += c; cnt += (c > 0u) ? 1u : 0u; mine = (j == x) ? c : mine; }
        if (sum == G) break;
        __builtin_amdgcn_s_sleep(1);
        if ((++sp & 255u) == 0u) { if (xb_ld(&bar[XB_TMO])) break; if (sp > XB_SPIN_CAP) { atomicAdd(&bar[XB_TMO], 1u); break; } }
    }
    nloc = mine > 0u ? mine : 1u; nx = cnt > 0u ? cnt : 1u;
}
__device__ __forceinline__ void xcd_barrier(const XcdBarrier& b) {
    asm volatile("s_waitcnt vmcnt(0)" ::: "memory");
    __syncthreads();
    if (threadIdx.x == 0) {
        unsigned* bar = b.bar;
        __builtin_amdgcn_s_waitcnt(0);
        unsigned nloc = b.st[0], nx = b.st[1];
        if (nloc == 0u) { xcd_barrier_complete(bar, b.x, nloc, nx); b.st[0] = nloc; b.st[1] = nx; }
        const unsigned old = xb_add(&bar[XB_XSUB(b.x)], 1u);
        const unsigned gen = old / nloc;
        if (old + 1u == (gen + 1u) * nloc) {
            __builtin_amdgcn_fence(__ATOMIC_RELEASE, "agent");
            asm volatile("s_waitcnt vmcnt(0)" ::: "memory");
            const unsigned og = xb_add(&bar[XB_TOP], 1u);
            const unsigned tg = og / nx;
            if (og + 1u == (tg + 1u) * nx) xb_add(&bar[XB_TOPGEN], 1u);
            else XB_SPIN(xb_ld(&bar[XB_TOPGEN]) == tg, bar);
            __builtin_amdgcn_fence(__ATOMIC_ACQUIRE, "agent");
            xb_add(&bar[XB_XGEN(b.x)], 1u);
            asm volatile("s_waitcnt vmcnt(0)" ::: "memory");
        } else {
            XB_SPIN(xb_ld(&bar[XB_XGEN(b.x)]) == gen, bar);
            __builtin_amdgcn_fence(__ATOMIC_ACQUIRE, "agent");
            asm volatile("s_waitcnt vmcnt(0)" ::: "memory");
        }
    }
    __syncthreads();
}

struct Frame {
    LAS unsigned char* lds;
    volatile LAS unsigned* MISC;
    unsigned* ctl;
    int tid, lane, wave, vcu, G;
    float* out; unsigned char* ws;
};
struct Args { const float* in[28]; float* out; unsigned char* ws; int ph_lo, ph_hi; };
typedef __bf16 bf16x2_t __attribute__((ext_vector_type(2)));
__device__ __forceinline__ unsigned cvtpk(float lo, float hi) { f32x2 v = {lo, hi}; bf16x2_t b = __builtin_convertvector(v, bf16x2_t); return __builtin_bit_cast(unsigned, b); }
__device__ __forceinline__ u32x4 pack8(const f32x4 a, const f32x4 b) { u32x4 w; w.x = cvtpk(a[0], a[1]); w.y = cvtpk(a[2], a[3]); w.z = cvtpk(b[0], b[1]); w.w = cvtpk(b[2], b[3]); return w; }
__device__ __forceinline__ void unpack8(const u32x4 w, f32x4& a, f32x4& b) { a = (f32x4){bflo(w.x), bfhi(w.x), bflo(w.y), bfhi(w.y)}; b = (f32x4){bflo(w.z), bfhi(w.z), bflo(w.w), bfhi(w.w)}; }

using pg8::Unit;
typedef const f32x4 (&AccRef)[2][2][4][2];
#define EPI_ROWS_BEGIN _Pragma("unroll") for (int ai = 0; ai < 2; ++ai) _Pragma("unroll") for (int m = 0; m < 4; ++m) { const int rr = ai * 128 + wr * 64 + m * 16 + fr;
#define EPI_ROWS_END }
struct EpiQKVU {
    bf16_t* O;
    __device__ __forceinline__ void operator()(AccRef acc, const Unit& u, int wr, int wc, int fr, int fq) const {
        const int t = u.ccol >> 9, colt = u.ccol & 511; bf16_t* base = O + (size_t)t * M * 512; const float sc = (t == 0) ? QSCALE : 1.f;
        const int col0 = colt + wc * 32 + 8 * fq;
        EPI_ROWS_BEGIN
            bf16_t* rowp = base + (size_t)(u.crow + rr) * 512 + col0;
#pragma unroll
            for (int bj = 0; bj < 2; ++bj) *(u32x4*)(rowp + bj * 128) = pack8(acc[ai][bj][m][0] * sc, acc[ai][bj][m][1] * sc);
        EPI_ROWS_END
    }
};
struct EpiGLU {
    const bf16_t* Y; const float* bias; bf16_t* MIX;
    __device__ __forceinline__ void operator()(AccRef acc, const Unit& u, int wr, int wc, int fr, int fq) const {
        const int col0 = u.ccol + wc * 32 + 8 * fq;
        f32x4 bv[2][2];
#pragma unroll
        for (int bj = 0; bj < 2; ++bj) { bv[bj][0] = *(const f32x4*)(bias + col0 + bj * 128); bv[bj][1] = *(const f32x4*)(bias + col0 + bj * 128 + 4); }
        EPI_ROWS_BEGIN
            const size_t row = (size_t)(u.crow + rr);
#pragma unroll
            for (int bj = 0; bj < 2; ++bj) {
                const u32x4 yw = *(const u32x4*)(Y + row * 512 + col0 + bj * 128); f32x4 y0, y1; unpack8(yw, y0, y1);
                f32x4 a0 = acc[ai][bj][m][0] + bv[bj][0], a1 = acc[ai][bj][m][1] + bv[bj][1];
#pragma unroll
                for (int j = 0; j < 4; ++j) { a0[j] = y0[j] * sigmoidf_(a0[j]); a1[j] = y1[j] * sigmoidf_(a1[j]); }
                *(u32x4*)(MIX + row * 1024 + 512 + col0 + bj * 128) = pack8(a0, a1);
            }
        EPI_ROWS_END
    }
};
struct EpiWout {
    const float* X; float* PRE; f32x2* STATS;
    __device__ __forceinline__ void operator()(AccRef acc, const Unit& u, int wr, int wc, int fr, int fq) const {
        const int col0 = u.ccol + wc * 32 + 8 * fq;
        EPI_ROWS_BEGIN
            const size_t row = (size_t)(u.crow + rr); float s = 0.f, q = 0.f;
#pragma unroll
            for (int bj = 0; bj < 2; ++bj) {
                const float* xp = X + row * 1024 + col0 + bj * 128;
                const f32x4 v0 = *(const f32x4*)xp * ALPHA + acc[ai][bj][m][0], v1 = *(const f32x4*)(xp + 4) * ALPHA + acc[ai][bj][m][1];
                float* pp = PRE + row * 1024 + col0 + bj * 128; *(f32x4*)pp = v0; *(f32x4*)(pp + 4) = v1;
                s += (v0[0] + v0[1]) + (v0[2] + v0[3]) + (v1[0] + v1[1]) + (v1[2] + v1[3]);
                q += (v0[0] * v0[0] + v0[1] * v0[1]) + (v0[2] * v0[2] + v0[3] * v0[3]) + (v1[0] * v1[0] + v1[1] * v1[1]) + (v1[2] * v1[2] + v1[3] * v1[3]);
            }
            s += __shfl_xor(s, 16); s += __shfl_xor(s, 32); q += __shfl_xor(q, 16); q += __shfl_xor(q, 32);
            if (fq == 0) STATS[row * 16 + (u.ccol >> 8) * 4 + wc] = (f32x2){s, q};
        EPI_ROWS_END
    }
};
constexpr float WSC = 1.f / 32.f;
struct EpiGU {
    unsigned char* HID;
    __device__ __forceinline__ void operator()(AccRef acc, const Unit& u, int wr, int wc, int fr, int fq) const {
        const int col0 = u.ccol + wc * 32 + 8 * fq;
        EPI_ROWS_BEGIN
            f32x4 h0, h1;
#pragma unroll
            for (int j = 0; j < 4; ++j) { const float g0 = acc[ai][0][m][0][j] * WSC, g1 = acc[ai][0][m][1][j] * WSC; h0[j] = g0 * sigmoidf_(g0) * (acc[ai][1][m][0][j] * WSC); h1[j] = g1 * sigmoidf_(g1) * (acc[ai][1][m][1][j] * WSC); }
            int p0 = __builtin_amdgcn_cvt_pk_fp8_f32(h0[0], h0[1], 0, false); p0 = __builtin_amdgcn_cvt_pk_fp8_f32(h0[2], h0[3], p0, true);
            int p1 = __builtin_amdgcn_cvt_pk_fp8_f32(h1[0], h1[1], 0, false); p1 = __builtin_amdgcn_cvt_pk_fp8_f32(h1[2], h1[3], p1, true);
            *(u32x2*)(HID + (size_t)(u.crow + rr) * 256 + col0) = (u32x2){(unsigned)p0, (unsigned)p1};
        EPI_ROWS_END
    }
};
struct EpiDown {
    unsigned char* SLAB; LAS const int* dw;
    __device__ __forceinline__ void operator()(AccRef acc, const Unit& u, int wr, int wc, int fr, int fq) const {
        const int col0 = u.ccol + wc * 64 + 8 * fq;
        EPI_ROWS_BEGIN
            const int dest = dw[(u.crow * 256 + rr) * 2]; const float w = __int_as_float(dw[(u.crow * 256 + rr) * 2 + 1]) * (16.f * WSC);
            if (dest >= 0) { unsigned char* rowp = SLAB + (size_t)dest * 1024 + col0;
#pragma unroll
                for (int bj = 0; bj < 2; ++bj) { const f32x4 a = acc[ai][bj][m][0] * w, c = acc[ai][bj][m][1] * w;
                    int p0 = __builtin_amdgcn_cvt_pk_fp8_f32(a[0], a[1], 0, false); p0 = __builtin_amdgcn_cvt_pk_fp8_f32(a[2], a[3], p0, true);
                    int p1 = __builtin_amdgcn_cvt_pk_fp8_f32(c[0], c[1], 0, false); p1 = __builtin_amdgcn_cvt_pk_fp8_f32(c[2], c[3], p1, true);
                    *(u32x2*)(rowp + bj * 32) = (u32x2){(unsigned)p0, (unsigned)p1}; } }
        EPI_ROWS_END
    }
};
struct EpiGS {
    bf16_t* GS;
    __device__ __forceinline__ void operator()(AccRef acc, const Unit& u, int wr, int wc, int fr, int fq) const {
        const int col0 = u.ccol + wc * 32 + 8 * fq;
        EPI_ROWS_BEGIN
#pragma unroll
            for (int bj = 0; bj < 2; ++bj) { f32x4 a0 = acc[ai][bj][m][0], a1 = acc[ai][bj][m][1];
#pragma unroll
                for (int j = 0; j < 4; ++j) { a0[j] = sigmoidf_(a0[j] * WSC); a1[j] = sigmoidf_(a1[j] * WSC); }
                *(u32x4*)(GS + (size_t)(u.crow + rr) * 1024 + col0 + bj * 128) = pack8(a0, a1); }
        EPI_ROWS_END
    }
};
struct EpiBase {
    const bf16_t* GSB; bf16_t* H;
    __device__ __forceinline__ void operator()(AccRef acc, const Unit& u, int wr, int wc, int fr, int fq) const {
        const int col0 = u.ccol + wc * 32 + 8 * fq;
        EPI_ROWS_BEGIN
#pragma unroll
            for (int bj = 0; bj < 2; ++bj) { const size_t off = (size_t)(u.crow + rr) * 1024 + col0 + bj * 128;
                f32x4 g0, g1, h0, h1; unpack8(*(const u32x4*)(GSB + off), g0, g1); unpack8(*(const u32x4*)(H + off), h0, h1);
                const f32x4 o0 = acc[ai][bj][m][0] * g0 + h0 * ALPHA, o1 = acc[ai][bj][m][1] * g1 + h1 * ALPHA;
                *(u32x4*)(H + off) = pack8(o0, o1); }
        EPI_ROWS_END
    }
};

__device__ __forceinline__ void moe_prefix(Frame& F) {
    LAS int* tst = (LAS int*)(F.lds + TST_OFF);
    __syncthreads();
    if (F.wave == 0) {
        int c[5], tot = 0;
#pragma unroll
        for (int j = 0; j < 5; ++j) { const int i = 5 * F.lane + j, q = i / 65, e = i % 65; c[j] = i < 260 ? (e < 64 ? ((int)__hip_atomic_load(F.ctl + CW_CNT + q * 64 + e, RLX_AGENT) + 255) >> 8 : 32) : 0; tot += c[j]; }
        int inc = tot;
#pragma unroll
        for (int o = 1; o < 64; o <<= 1) { const int v = __shfl_up(inc, o); if (F.lane >= o) inc += v; }
        int run = inc - tot;
#pragma unroll
        for (int j = 0; j < 5; ++j) { const int i = 5 * F.lane + j; if (i < 260) tst[i] = run; run += c[j]; }
        if (F.lane == 63) tst[260] = inc;
    }
    __syncthreads();
}
template <int MODE> __device__ __forceinline__ void moe_units(Frame& F, int tq) {
    LAS int* tst = (LAS int*)(F.lds + TST_OFF); LAS int* tab = (LAS int*)(F.lds + TAB_OFF); LAS int* idx = (LAS int*)(F.lds + IDX_OFF);
    const int* LIST = (const int*)(F.ws + WS_LIST); const int* LDEST = (const int*)(F.ws + WS_LDEST); const float* LISTW = (const float*)(F.ws + WS_LISTW);
    moe_prefix(F);
    const int tile0 = MODE == 0 ? 0 : tst[tq * 65], ntile = MODE == 0 ? tst[260] : tst[tq * 65 + 65] - tile0, nunit = MODE == 0 ? 2 * ntile : 4 * ntile;
    constexpr int CAP = MODE == 0 ? 12 : 6;
    int n = (nunit - F.vcu + F.G - 1) / F.G; n = n < 0 ? 0 : (n > CAP ? CAP : n);
    if (F.tid < 260) { const int lo = tst[F.tid], hi = tst[F.tid + 1];
#pragma unroll
        for (int s = 0; s < CAP; ++s) { const int L = s * F.G + F.vcu, tile = tile0 + (MODE == 0 ? (L >> 1) : (L >> 2));
            if (s < n && lo <= tile && tile < hi) { LAS int* t = tab + 4 + 6 * s; t[0] = F.tid % 65; t[1] = tile - lo; t[2] = tile; t[3] = MODE == 0 ? (L & 1) : (L & 3); t[4] = F.tid / 65; } } }
    if (F.tid == 0) { tab[0] = n; tab[1] = nunit; }
    __syncthreads();
    for (int it = F.tid; it < n * 256; it += 512) { const int s = it >> 8, r = it & 255; const int e = tab[4 + 6 * s], ti = tab[5 + 6 * s], q = tab[8 + 6 * s]; const int p = ti * 256 + r;
        if (MODE == 0) { int v;
            if (e < 64) { const int cnt = (int)__hip_atomic_load(F.ctl + CW_CNT + q * 64 + e, RLX_AGENT); v = p < cnt ? LIST[(size_t)(q * 64 + e) * LCAP + p] : q * TQ_TOK; }
            else v = q * TQ_TOK + p;
            idx[it] = v;
        } else { int dest = p * 9 + 8; float w = 1.f;
            if (e < 64) { const int cnt = (int)__hip_atomic_load(F.ctl + CW_CNT + q * 64 + e, RLX_AGENT); const size_t li = (size_t)(q * 64 + e) * LCAP + (p < cnt ? p : 0); dest = p < cnt ? LDEST[li] : -1; w = LISTW[li]; }
            idx[it * 2] = dest; idx[it * 2 + 1] = __float_as_int(w); } }
    __syncthreads();
}
struct GUSched {
    const bf16_t* H; const bf16_t* W; LAS const int* tab; LAS const int* idx;
    __device__ __forceinline__ bool next(int i, Unit& u) const { if (i >= tab[0]) return false; u.e = tab[4 + 6 * i]; const int tile = tab[6 + 6 * i], pn = tab[7 + 6 * i];
        u.aux = i; u.arow = 0; u.crow = tile * 256; u.ccol = pn * 128; u.brow = u.e * 512 + pn * 256; return true; }
    __device__ __forceinline__ const char* abase(const Unit&) const { return (const char*)H; }
    __device__ __forceinline__ const char* bbase(const Unit& u) const { return (const char*)W + (size_t)u.brow * 512 * 2; }
    __device__ __forceinline__ void avoff(const Unit& u, const int (&R)[2], const int (&C)[2], unsigned (&v)[2][2]) const {
#pragma unroll
        for (int h = 0; h < 2; ++h)
#pragma unroll
            for (int i = 0; i < 2; ++i) v[h][i] = (unsigned)(idx[u.aux * 256 + h * 128 + R[i]] * 512 + C[i]) * 2u;
    }
};
struct DownSched {
    const unsigned char* HID; const unsigned char* W; LAS const int* tab;
    __device__ __forceinline__ bool next(int i, Unit& u) const { if (i >= tab[0]) return false; u.e = tab[4 + 6 * i]; u.aux = tab[5 + 6 * i]; const int tile = tab[6 + 6 * i], pn = tab[7 + 6 * i];
        u.arow = tile * 256; u.ccol = pn * 256; u.brow = u.e * 1024 + pn * 256; u.crow = i; return true; }
    __device__ __forceinline__ const char* abase(const Unit& u) const { return (const char*)HID + (size_t)u.arow * 256; }
    __device__ __forceinline__ const char* bbase(const Unit& u) const { return (const char*)W + (size_t)u.brow * 256; }
    __device__ __forceinline__ void avoff(const Unit&, const int (&R)[2], const int (&C)[2], unsigned (&v)[2][2]) const {
#pragma unroll
        for (int h = 0; h < 2; ++h)
#pragma unroll
            for (int i = 0; i < 2; ++i) v[h][i] = (unsigned)((h * 128 + R[i]) * 128 + C[i]) * 2u;
    }
};

struct TrItem { const float* W; bf16_t* WT; int K, N, destrow0, k0, n0, f8; };
__device__ __forceinline__ void tr_load(const TrItem& it, f32x4 (&tv)[8], int lane) {
#pragma unroll
    for (int j = 0; j < 8; ++j) tv[j] = *(const f32x4*)(it.W + (size_t)(it.k0 + 8 * (lane >> 3) + j) * it.N + it.n0 + 4 * (lane & 7));
}
__device__ __forceinline__ void tr_store(const TrItem& it, const f32x4 (&tv)[8], int lane) {
    if (it.f8) {
#pragma unroll
        for (int c = 0; c < 4; ++c) { int p0 = __builtin_amdgcn_cvt_pk_fp8_f32(tv[0][c] * 32.f, tv[1][c] * 32.f, 0, false); p0 = __builtin_amdgcn_cvt_pk_fp8_f32(tv[2][c] * 32.f, tv[3][c] * 32.f, p0, true);
            int p1 = __builtin_amdgcn_cvt_pk_fp8_f32(tv[4][c] * 32.f, tv[5][c] * 32.f, 0, false); p1 = __builtin_amdgcn_cvt_pk_fp8_f32(tv[6][c] * 32.f, tv[7][c] * 32.f, p1, true);
            *(u32x2*)((unsigned char*)it.WT + (size_t)(it.destrow0 + 4 * (lane & 7) + c) * it.K + it.k0 + 8 * (lane >> 3)) = (u32x2){(unsigned)p0, (unsigned)p1}; }
        return; }
#pragma unroll
    for (int c = 0; c < 4; ++c) { u32x4 o; o.x = pk2(tv[0][c], tv[1][c]); o.y = pk2(tv[2][c], tv[3][c]); o.z = pk2(tv[4][c], tv[5][c]); o.w = pk2(tv[6][c], tv[7][c]);
        *(u32x4*)(it.WT + (size_t)(it.destrow0 + 4 * (lane & 7) + c) * it.K + it.k0 + 8 * (lane >> 3)) = o; }
}
constexpr int I_IN = 16 * 64, I_GLU = 8 * 16, I_OUT = 16 * 32, I_PG = 16 * 32, I_PLE = 4 * 32, I_SMALL = I_IN + I_GLU + I_OUT + I_PG + I_PLE, I_G = 65 * 128, I_U = 65 * 128, I_D = 65 * 128, I_EXP = I_G + I_U + I_D;
__device__ __forceinline__ TrItem tr_decode_small(Frame& F, const Args& A, int r) {
    if (r < I_IN) return TrItem{A.in[2], (bf16_t*)(F.ws + WS_WIN), 1024, 2048, (r % 64) * 32, (r / 64) * 64, (r % 64) * 32, 0}; r -= I_IN;
    if (r < I_GLU) return TrItem{A.in[11], (bf16_t*)(F.ws + WS_WGLU), 512, 512, (r % 16) * 32, (r / 16) * 64, (r % 16) * 32, 0}; r -= I_GLU;
    if (r < I_OUT) return TrItem{A.in[13], (bf16_t*)(F.ws + WS_WOUT), 1024, 1024, (r % 32) * 32, (r / 32) * 64, (r % 32) * 32, 0}; r -= I_OUT;
    if (r < I_PG) return TrItem{A.in[25], (bf16_t*)(F.ws + WS_WPG), 1024, 1024, (r % 32) * 32, (r / 32) * 64, (r % 32) * 32, 1}; r -= I_PG;
    return TrItem{A.in[24], (bf16_t*)(F.ws + WS_WPLE), 256, 1024, (r % 32) * 32, (r / 32) * 64, (r % 32) * 32, 0};
}
__device__ __forceinline__ TrItem tr_decode_exp(Frame& F, const Args& A, int r) {
    bf16_t* WGU = (bf16_t*)(F.ws + WS_WGU); bf16_t* WD = (bf16_t*)(F.ws + WS_WD);
    if (r < I_G + I_U) { const bool up = r >= I_G; if (up) r -= I_G; const int e = r / 128, rr = r % 128, n0 = (rr % 8) * 32, k0 = (rr / 8) * 64;
        const float* src = e < 64 ? (up ? A.in[19] : A.in[18]) + (size_t)e * 1024 * 256 : (up ? A.in[22] : A.in[21]);
        return TrItem{src, (bf16_t*)((unsigned char*)WGU + (size_t)e * 512 * 1024), 1024, 256, (n0 >> 7) * 256 + (n0 & 127) + (up ? 128 : 0), k0, n0, 1}; }
    r -= I_G + I_U;
    { const int e = r / 128, rr = r % 128, n0 = (rr % 32) * 32, k0 = (rr / 32) * 64; const float* src = e < 64 ? A.in[20] + (size_t)e * 256 * 1024 : A.in[23];
        return TrItem{src, (bf16_t*)((unsigned char*)WD + (size_t)e * 1024 * 256), 256, 1024, n0, k0, n0, 1}; }
}
__device__ __forceinline__ int cvt_expert_burst(Frame& F, const Args& A, int cur, int nmax) {
    const int NGW = F.G * NWAVES;
    for (int k = 0; k < nmax && cur < I_EXP; k += 2) {
        const bool two = (k + 1 < nmax) && (cur + NGW < I_EXP);
        const TrItem a = tr_decode_exp(F, A, cur); f32x4 ta[8], tb[8]; tr_load(a, ta, F.lane);
        TrItem bI = a; if (two) { bI = tr_decode_exp(F, A, cur + NGW); tr_load(bI, tb, F.lane); }
        tr_store(a, ta, F.lane); if (two) tr_store(bI, tb, F.lane);
        cur += two ? 2 * NGW : NGW;
    }
    return cur;
}
#ifndef P0_EXPERTS
#define P0_EXPERTS 0
#endif
__device__ __forceinline__ void p0_prologue(Frame& F, const Args& A) {
    const int gw = F.vcu * NWAVES + F.wave, NGW = F.G * NWAVES;
    if (gw < I_SMALL) {
        TrItem cur = tr_decode_small(F, A, gw); f32x4 tv[8], tn[8]; tr_load(cur, tv, F.lane);
        for (int it = gw; it < I_SMALL; it += NGW) {
            const bool has = it + NGW < I_SMALL; TrItem nxt = cur;
            if (has) { nxt = tr_decode_small(F, A, it + NGW); tr_load(nxt, tn, F.lane); }
            tr_store(cur, tv, F.lane);
            cur = nxt;
#pragma unroll
            for (int i = 0; i < 8; ++i) tv[i] = tn[i];
        }
    }
    if (P0_EXPERTS && gw < I_EXP) {
        TrItem cur = tr_decode_exp(F, A, gw); f32x4 tv[8], tn[8]; tr_load(cur, tv, F.lane);
        for (int it = gw; it < I_EXP; it += NGW) {
            const bool has = it + NGW < I_EXP; TrItem nxt = cur;
            if (has) { nxt = tr_decode_exp(F, A, it + NGW); tr_load(nxt, tn, F.lane); }
            tr_store(cur, tv, F.lane);
            cur = nxt;
#pragma unroll
            for (int i = 0; i < 8; ++i) tv[i] = tn[i];
        }
    }
    { const float* x = A.in[0]; bf16_t* XB = (bf16_t*)(F.ws + WS_B);
      for (int m = gw * 4; m < M; m += NGW * 4) { f32x4 v[4][4];
#pragma unroll
          for (int r = 0; r < 4; ++r)
#pragma unroll
              for (int j = 0; j < 4; ++j) v[r][j] = ((const f32x4*)(x + (size_t)(m + r) * DM))[F.lane + 64 * j];
#pragma unroll
          for (int r = 0; r < 4; ++r)
#pragma unroll
              for (int j = 0; j < 4; ++j) ((u32x2*)(XB + (size_t)(m + r) * DM))[F.lane + 64 * j] = (u32x2){pk2(v[r][j][0], v[r][j][1]), pk2(v[r][j][2], v[r][j][3])}; } }
    { const float* wr = A.in[16]; bf16_t* WR = (bf16_t*)(F.ws + WS_WR);
      for (int i = (F.vcu * NWAVES + F.wave) * 64 + F.lane; i < 64 * 1024; i += NGW * 64) { const int e = i >> 10, k = i & 1023; const float v = wr[(size_t)k * 64 + e];
          const unsigned hb = f2bf(v); const float hf = __builtin_bit_cast(float, hb << 16); WR[i] = (bf16_t)hb; WR[65536 + i] = (bf16_t)f2bf(v - hf); } }
}

__device__ __forceinline__ void p2_attn_naive(Frame& F) {
    const bf16_t* Q = (const bf16_t*)(F.ws + WS_C); const bf16_t* Kb = Q + (size_t)M * 512; const bf16_t* Vb = Kb + (size_t)M * 512; bf16_t* MIX = (bf16_t*)(F.ws + WS_B);
    const int gw = F.vcu * NWAVES + F.wave, NGW = F.G * NWAVES, lane = F.lane;
    for (int item = gw; item < M * NH; item += NGW) {
        const int h = item & 7, bt = item >> 3, t = bt & (SEQ - 1), b = bt >> 12;
        const float q = bf2f(Q[(size_t)bt * 512 + h * 64 + lane]);
        const float slope2 = exp2f(-(float)(h + 1)) * LOG2E;
        float m = -INFINITY, l = 0.f, o = 0.f;
        for (int br = 0; br < 3; ++br) { const int dil = (br == 0) ? 1 : (br == 1 ? 4 : 16);
            for (int j = 0; j <= 128; ++j) { const int pos = t - j * dil; if (pos < 0) break;
                const size_t ro = (size_t)(b * SEQ + pos) * 512 + h * 64 + lane;
                const float kk = bf2f(Kb[ro]), vv = bf2f(Vb[ro]);
                const float s = wave_sum(q * kk) - slope2 * (float)(j * dil);
                const float mn = fmaxf(m, s); const float corr = exp2f(m - mn); const float pe = exp2f(s - mn);
                l = l * corr + pe; o = o * corr + pe * vv; m = mn; } }
        MIX[(size_t)bt * 1024 + h * 64 + lane] = (bf16_t)f2bf(o / l);
    }
}
__device__ __forceinline__ float gelu_tanh(float v) { return 0.5f * v * (1.f + tanhf(0.7978845608028654f * (v + 0.044715f * v * v * v))); }
__device__ __forceinline__ void p2_ssm_naive(Frame& F, const Args& A) {
    if (F.wave != 0) return;
    const bf16_t* U = (const bf16_t*)(F.ws + WS_D); bf16_t* Y = (bf16_t*)(F.ws + WS_D) + (size_t)M * 512;
    const float* lam_re = A.in[3]; const float* lam_im = A.in[4]; const float* log_dt = A.in[5]; const float* b_re = A.in[6]; const float* b_im = A.in[7];
    const float* c_re = A.in[8]; const float* c_im = A.in[9]; const float* d_skip = A.in[10];
    const int n = F.lane;
    for (int item = F.vcu; item < BATCH * NG; item += F.G) {
        const int b = item / NG, g = item % NG;
        const float lr = lam_re[g * NS + n], li = lam_im[g * NS + n], dt = expf(log_dt[g]);
        const float er = expf(lr * dt); const float ar = er * cosf(li * dt), ai = er * sinf(li * dt);
        const float den = lr * lr + li * li;
        const float gr = ((ar - 1.f) * lr + ai * li) / den, gi = (ai * lr - (ar - 1.f) * li) / den;
        float bbr[16], bbi[16], cr[16], ci[16];
#pragma unroll
        for (int c = 0; c < 16; ++c) { const float br = b_re[(g * NS + n) * GC + c], bi = b_im[(g * NS + n) * GC + c];
            bbr[c] = gr * br - gi * bi; bbi[c] = gr * bi + gi * br; cr[c] = c_re[(g * GC + c) * NS + n]; ci[c] = c_im[(g * GC + c) * NS + n]; }
        const float dsk = (n < 16) ? d_skip[g * GC + n] : 0.f;
        float sr = 0.f, si = 0.f;
        for (int t = 0; t < SEQ; ++t) {
            const u32x4* up = (const u32x4*)(U + (size_t)(b * SEQ + t) * 512 + g * GC);
            float u[16]; { f32x4 a0, a1, a2, a3; unpack8(up[0], a0, a1); unpack8(up[1], a2, a3);
#pragma unroll
                for (int c = 0; c < 4; ++c) { u[c] = a0[c]; u[4 + c] = a1[c]; u[8 + c] = a2[c]; u[12 + c] = a3[c]; } }
            float bur = 0.f, bui = 0.f;
#pragma unroll
            for (int c = 0; c < 16; ++c) { bur += bbr[c] * u[c]; bui += bbi[c] * u[c]; }
            const float nr = ar * sr - ai * si + bur, ni = ar * si + ai * sr + bui; sr = nr; si = ni;
            float my = 0.f, uc = 0.f;
#pragma unroll
            for (int c = 0; c < 16; ++c) { const float v = wave_sum(cr[c] * sr - ci[c] * si); if (n == c) { my = v; uc = u[c]; } }
            if (n < 16) Y[(size_t)(b * SEQ + t) * 512 + g * GC + n] = (bf16_t)f2bf(gelu_tanh(my + dsk * uc));
        }
    }
}

constexpr int P5_WB = 0, P5_BUF = 34816, P5_PART = 17408, P5_PITCH = 272, P5_SCR = 69632, P5_HIST = 104448, P5_BASEL = P5_HIST + 256, P5_RB = P5_HIST + 512, P5_GB = P5_HIST + 1024;
__device__ __forceinline__ void p5_ln_router(Frame& F, const Args& A, int fake) {
    const float* PRE = F.out; const f32x4* STATS = (const f32x4*)(F.ws + WS_STATS); const float* gam = A.in[14]; const float* bet = A.in[15]; const float* rbias = A.in[17];
    bf16_t* H = (bf16_t*)(F.ws + WS_B); unsigned char* H8 = F.ws + WS_H8; const bf16_t* WR = (const bf16_t*)(F.ws + WS_WR);
    int* LIST = (int*)(F.ws + WS_LIST); float* LISTW = (float*)(F.ws + WS_LISTW); int* LDEST = (int*)(F.ws + WS_LDEST); int* CNT = (int*)(F.ctl + CW_CNT);
    LAS unsigned char* lds = F.lds; LAS float* scr = (LAS float*)(lds + P5_SCR) + F.wave * (16 * 68); LAS int* hist = (LAS int*)(lds + P5_HIST); LAS int* basel = (LAS int*)(lds + P5_BASEL); LAS float* rb = (LAS float*)(lds + P5_RB);
    const int tid = F.tid, lane = F.lane, fr = lane & 15, g = lane >> 4;
    for (int rg = F.vcu; rg < M / 128; rg += F.G) {
        const int row = rg * 128 + F.wave * 16 + fr;
        if (tid < 64) { hist[tid] = 0; rb[tid] = rbias[tid]; }
        { LAS float* gbl = (LAS float*)(lds + P5_GB); for (int i = tid; i < 256; i += 512) { *(LAS f32x4*)(gbl + 4 * i) = *(const f32x4*)(gam + 4 * i); *(LAS f32x4*)(gbl + 1024 + 4 * i) = *(const f32x4*)(bet + 4 * i); } }
        float mean, rstd;
        { const f32x4 p0 = STATS[(size_t)row * 8 + 2 * g], p1 = STATS[(size_t)row * 8 + 2 * g + 1]; float s = (p0[0] + p0[2]) + (p1[0] + p1[2]), q = (p0[1] + p0[3]) + (p1[1] + p1[3]);
          s += __shfl_xor(s, 16); s += __shfl_xor(s, 32); q += __shfl_xor(q, 16); q += __shfl_xor(q, 32);
          mean = s * (1.f / DM); const float var = fmaxf(q * (1.f / DM) - mean * mean, 0.f); rstd = rsqrtf(var + LN_EPS); }
        u32x4 st[4];
#pragma unroll
        for (int i = 0; i < 4; ++i) { const int q = tid + 512 * i, part = q >> 10, rem = q & 1023, e = rem >> 4, pc = rem & 15; st[i] = *(const u32x4*)(WR + (size_t)part * 65536 + e * 1024 + pc * 8); }
        const float* prow = PRE + (size_t)row * DM + 8 * g;
        f32x4 pv[8], pn[8];
#pragma unroll
        for (int ks = 0; ks < 4; ++ks) { pv[2 * ks] = *(const f32x4*)(prow + ks * 32); pv[2 * ks + 1] = *(const f32x4*)(prow + ks * 32 + 4); }
#pragma unroll
        for (int i = 0; i < 4; ++i) { const int q = tid + 512 * i, part = q >> 10, rem = q & 1023, e = rem >> 4, pc = rem & 15; *(LAS u32x4*)(lds + P5_WB + part * P5_PART + e * P5_PITCH + pc * 16) = st[i]; }
        LDS_BARRIER();
        f32x4 acc[4];
#pragma unroll
        for (int nt = 0; nt < 4; ++nt) acc[nt] = (f32x4){0.f, 0.f, 0.f, 0.f};
        const LAS float* gbl = (const LAS float*)(lds + P5_GB) + 8 * g;
#pragma unroll 1
        for (int kc = 0; kc < 8; ++kc) {
            if (kc < 7) {
#pragma unroll
                for (int i = 0; i < 4; ++i) { const int q = tid + 512 * i, part = q >> 10, rem = q & 1023, e = rem >> 4, pc = rem & 15; st[i] = *(const u32x4*)(WR + (size_t)part * 65536 + e * 1024 + (kc + 1) * 128 + pc * 8); }
#pragma unroll
                for (int ks = 0; ks < 4; ++ks) { pn[2 * ks] = *(const f32x4*)(prow + (kc + 1) * 128 + ks * 32); pn[2 * ks + 1] = *(const f32x4*)(prow + (kc + 1) * 128 + ks * 32 + 4); }
            }
            LAS unsigned char* wb = lds + P5_WB + (kc & 1) * P5_BUF;
#pragma unroll
            for (int ks = 0; ks < 4; ++ks) {
                const int kk = kc * 128 + ks * 32 + 8 * g;
                f32x4 v0 = pv[2 * ks], v1 = pv[2 * ks + 1];
                const f32x4 g0 = *(const LAS f32x4*)(gbl + kc * 128 + ks * 32), g1 = *(const LAS f32x4*)(gbl + kc * 128 + ks * 32 + 4), b0 = *(const LAS f32x4*)(gbl + 1024 + kc * 128 + ks * 32), b1 = *(const LAS f32x4*)(gbl + 1024 + kc * 128 + ks * 32 + 4);
                v0 = (v0 - mean) * rstd * g0 + b0; v1 = (v1 - mean) * rstd * g1 + b1;
                const u32x4 hw = pack8(v0, v1);
                *(u32x4*)(H + (size_t)row * DM + kk) = hw;
                { int p0 = __builtin_amdgcn_cvt_pk_fp8_f32(v0[0], v0[1], 0, false); p0 = __builtin_amdgcn_cvt_pk_fp8_f32(v0[2], v0[3], p0, true); int p1 = __builtin_amdgcn_cvt_pk_fp8_f32(v1[0], v1[1], 0, false); p1 = __builtin_amdgcn_cvt_pk_fp8_f32(v1[2], v1[3], p1, true);
                  *(u32x2*)(H8 + (size_t)row * DM + kk) = (u32x2){(unsigned)p0, (unsigned)p1}; }
                f32x4 h0, h1; unpack8(hw, h0, h1);
                const u32x4 lw = pack8(v0 - h0, v1 - h1);
                const bf16x8 ahi = __builtin_bit_cast(bf16x8, hw), alo = __builtin_bit_cast(bf16x8, lw);
#pragma unroll
                for (int nt = 0; nt < 4; ++nt) {
                    const bf16x8 bhi = *(const LAS bf16x8*)(wb + (16 * nt + fr) * P5_PITCH + (ks * 32 + 8 * g) * 2);
                    const bf16x8 blo = *(const LAS bf16x8*)(wb + P5_PART + (16 * nt + fr) * P5_PITCH + (ks * 32 + 8 * g) * 2);
                    acc[nt] = __builtin_amdgcn_mfma_f32_16x16x32_bf16(ahi, bhi, acc[nt], 0, 0, 0);
                    acc[nt] = __builtin_amdgcn_mfma_f32_16x16x32_bf16(alo, bhi, acc[nt], 0, 0, 0);
                    acc[nt] = __builtin_amdgcn_mfma_f32_16x16x32_bf16(ahi, blo, acc[nt], 0, 0, 0);
                }
            }
            if (kc < 7) {
                LAS unsigned char* wn = lds + P5_WB + ((kc + 1) & 1) * P5_BUF;
#pragma unroll
                for (int i = 0; i < 4; ++i) { const int q = tid + 512 * i, part = q >> 10, rem = q & 1023, e = rem >> 4, pc = rem & 15; *(LAS u32x4*)(wn + part * P5_PART + e * P5_PITCH + pc * 16) = st[i]; }
#pragma unroll
                for (int i = 0; i < 8; ++i) pv[i] = pn[i];
            }
            LDS_BARRIER();
        }
        if (fake) continue;
#pragma unroll
        for (int nt = 0; nt < 4; ++nt)
#pragma unroll
            for (int r = 0; r < 4; ++r) scr[(4 * g + r) * 68 + 16 * nt + fr] = sigmoidf_(acc[nt][r]);
        __syncthreads();
        const int trow = lane >> 2, q4 = lane & 3;
        float sc[16], cand[16];
        { const LAS f32x4* sp = (const LAS f32x4*)(scr + trow * 68 + 16 * q4); const LAS f32x4* bp = (const LAS f32x4*)(rb + 16 * q4);
#pragma unroll
          for (int j = 0; j < 4; ++j) { const f32x4 s4 = sp[j], b4 = bp[j];
#pragma unroll
              for (int e = 0; e < 4; ++e) { sc[4 * j + e] = s4[e]; cand[4 * j + e] = s4[e] + b4[e]; } } }
        float gsc[2];
#pragma unroll
        for (int h = 0; h < 2; ++h) { float m1 = -INFINITY, m2 = -INFINITY;
#pragma unroll
            for (int j = 0; j < 8; ++j) { const float v = cand[8 * h + j]; const float lo_ = fminf(m1, v); m1 = fmaxf(m1, v); m2 = fmaxf(m2, lo_); }
            gsc[h] = m1 + m2; }
        float gs[8];
#pragma unroll
        for (int k = 0; k < 4; ++k) { gs[2 * k] = __shfl(gsc[0], (lane & ~3) + k); gs[2 * k + 1] = __shfl(gsc[1], (lane & ~3) + k); }
        unsigned gm = 0;
#pragma unroll
        for (int it = 0; it < 4; ++it) { float best = -INFINITY; int bi = 0;
#pragma unroll
            for (int gg = 0; gg < 8; ++gg) { const bool ok = !((gm >> gg) & 1u) && gs[gg] > best; best = ok ? gs[gg] : best; bi = ok ? gg : bi; }
            gm |= 1u << bi; }
#pragma unroll
        for (int j = 0; j < 16; ++j) if (!((gm >> (2 * q4 + (j >> 3))) & 1u)) cand[j] = -INFINITY;
        int idx[8]; float wv[8]; float wsum = 0.f;
#pragma unroll
        for (int it = 0; it < 8; ++it) {
            float bv = -INFINITY; int be = 0;
#pragma unroll
            for (int j = 0; j < 16; ++j) { const bool ok = cand[j] > bv; bv = ok ? cand[j] : bv; be = ok ? j : be; }
            be += 16 * q4;
#pragma unroll
            for (int o = 1; o < 4; o <<= 1) { const float ov = __shfl_xor(bv, o); const int oe = __shfl_xor(be, o); const bool take = (ov > bv) || (ov == bv && oe < be); bv = take ? ov : bv; be = take ? oe : be; }
            float mysc = 0.f;
#pragma unroll
            for (int j = 0; j < 16; ++j) { const bool hit = (be == 16 * q4 + j); cand[j] = hit ? -INFINITY : cand[j]; mysc = hit ? sc[j] : mysc; }
            const float w = __shfl(mysc, (lane & ~3) + (be >> 4));
            idx[it] = be; wv[it] = w; wsum += w;
        }
        int myrk[2];
#pragma unroll
        for (int h = 0; h < 2; ++h) { int e = 0;
#pragma unroll
            for (int it = 0; it < 8; ++it) if (it == 2 * q4 + h) e = idx[it];
            myrk[h] = __hip_atomic_fetch_add(hist + e, 1, __ATOMIC_RELAXED, __HIP_MEMORY_SCOPE_WORKGROUP); }
        __syncthreads();
        const int tq = rg >> 6;
        if (tid < 64) { const int c = hist[tid]; basel[tid] = c ? atomicAdd(CNT + tq * 64 + tid, c) : 0; }
        __syncthreads();
        { const int tok = rg * 128 + F.wave * 16 + trow; const float inv = ROUTED_SCALE / wsum;
#pragma unroll
          for (int h = 0; h < 2; ++h) { int e = 0; float w = 0.f;
#pragma unroll
              for (int it = 0; it < 8; ++it) if (it == 2 * q4 + h) { e = idx[it]; w = wv[it]; }
              const int pos = basel[e] + myrk[h]; const size_t li = (size_t)(tq * 64 + e) * LCAP + pos;
              LIST[li] = tok; LISTW[li] = w * inv; LDEST[li] = (tok - tq * TQ_TOK) * 9 + 2 * q4 + h; } }
        __syncthreads();
    }
}

__device__ __forceinline__ void p_combine_ln2(Frame& F, const Args& A, int tq, const unsigned char* SLAB, int b0, int nb) {
    const bf16_t* BASE = (const bf16_t*)(F.ws + WS_BASE); const float* gam = A.in[26]; const float* bet = A.in[27];
    if (F.vcu < b0 || F.vcu >= b0 + nb) return;
    const int gw = (F.vcu - b0) * NWAVES + F.wave, NGW = nb * NWAVES, lane = F.lane;
    for (int tl = gw; tl < TQ_TOK; tl += NGW) {
        const int t = tq * TQ_TOK + tl;
        u32x4 w[9]; u32x4 bw[2];
#pragma unroll
        for (int h = 0; h < 2; ++h) bw[h] = *(const u32x4*)(BASE + (size_t)t * 1024 + lane * 16 + h * 8);
#pragma unroll
        for (int k = 0; k < 9; ++k) w[k] = *(const u32x4*)(SLAB + ((size_t)tl * 9 + k) * 1024 + lane * 16);
        f32x4 s4[4];
#pragma unroll
        for (int j = 0; j < 4; ++j) s4[j] = (f32x4){0.f, 0.f, 0.f, 0.f};
#pragma unroll
        for (int k = 0; k < 9; ++k)
#pragma unroll
            for (int j = 0; j < 4; ++j) { const f32x2 d0 = __builtin_amdgcn_cvt_pk_f32_fp8((int)w[k][j], false), d1 = __builtin_amdgcn_cvt_pk_f32_fp8((int)w[k][j], true); s4[j] += (f32x4){d0[0], d0[1], d1[0], d1[1]}; }
        f32x4 v[4]; unpack8(bw[0], v[0], v[1]); unpack8(bw[1], v[2], v[3]);
#pragma unroll
        for (int j = 0; j < 4; ++j) v[j] += s4[j] * 0.0625f;
        float s = 0.f;
#pragma unroll
        for (int j = 0; j < 4; ++j) s += (v[j][0] + v[j][1]) + (v[j][2] + v[j][3]);
        const float mean = wave_sum(s) * (1.f / DM); float s2 = 0.f;
#pragma unroll
        for (int j = 0; j < 4; ++j) { v[j] = v[j] - mean; s2 += (v[j][0] * v[j][0] + v[j][1] * v[j][1]) + (v[j][2] * v[j][2] + v[j][3] * v[j][3]); }
        const float rstd = rsqrtf(wave_sum(s2) * (1.f / DM) + LN_EPS);
        float* op = F.out + (size_t)t * DM + lane * 16;
#pragma unroll
        for (int j = 0; j < 4; ++j) { const f32x4 gg = *(const f32x4*)(gam + lane * 16 + 4 * j), bb = *(const f32x4*)(bet + lane * 16 + 4 * j); *(f32x4*)(op + 4 * j) = v[j] * rstd * gg + bb; }
    }
}
__device__ __forceinline__ void p_convert_p(Frame& F, const Args& A) {
    const float* P = A.in[1]; bf16_t* PB = (bf16_t*)F.out;
    const int gw = F.vcu * NWAVES + F.wave, NGW = F.G * NWAVES;
    for (int m = gw * 8; m < M; m += NGW * 8) { f32x4 v[8];
#pragma unroll
        for (int r = 0; r < 8; ++r) v[r] = ((const f32x4*)(P + (size_t)(m + r) * PLE))[F.lane];
#pragma unroll
        for (int r = 0; r < 8; ++r) ((u32x2*)(PB + (size_t)(m + r) * PLE))[F.lane] = (u32x2){pk2(v[r][0], v[r][1]), pk2(v[r][2], v[r][3])}; }
}

constexpr size_t WS_KT = WS_E, WS_EM = WS_E + 2 * MiB, WS_MY = WS_E + 12 * MiB, WS_A64 = WS_E + 22 * MiB;
constexpr int KT_ELEMS = 65 * 256;
__device__ __forceinline__ void p0_ssm_tables(Frame& F, const Args& A, int gi, int sl) {
    const float* lam_re = A.in[3]; const float* lam_im = A.in[4]; const float* log_dt = A.in[5]; const float* b_re = A.in[6]; const float* b_im = A.in[7];
    const float* c_re = A.in[8]; const float* c_im = A.in[9];
    LAS f32x2* POW = (LAS f32x2*)(F.lds);
    LAS f32x2* BB = (LAS f32x2*)(F.lds + 33280);
    LAS f32x2* CC = (LAS f32x2*)(F.lds + 33280 + 8192);
    const int tid = F.tid; const float dt = expf(log_dt[gi]);
    __syncthreads();
    for (int idx = tid; idx < 65 * 64; idx += 512) { const int d = idx >> 6, n = idx & 63; const float lr = lam_re[gi * NS + n], li = lam_im[gi * NS + n];
        const float mag = expf(lr * dt * (float)d); float sn, cs; sincosf(li * dt * (float)d, &sn, &cs); POW[idx] = (f32x2){mag * cs, mag * sn}; }
    for (int idx = tid; idx < 64 * 16; idx += 512) { const int n = idx >> 4, c = idx & 15; const float lr = lam_re[gi * NS + n], li = lam_im[gi * NS + n];
        const float er = expf(lr * dt); float sn, cs; sincosf(li * dt, &sn, &cs); const float ar = er * cs, ai = er * sn, den = lr * lr + li * li;
        const float gr = ((ar - 1.f) * lr + ai * li) / den, gim = (ai * lr - (ar - 1.f) * li) / den;
        const float br = b_re[(gi * NS + n) * GC + c], bi = b_im[(gi * NS + n) * GC + c];
        BB[idx] = (f32x2){gr * br - gim * bi, gr * bi + gim * br}; }
    for (int idx = tid; idx < 16 * 64; idx += 512) CC[idx] = (f32x2){c_re[gi * 1024 + idx], c_im[gi * 1024 + idx]};
    __syncthreads();
    bf16_t* KT = (bf16_t*)(F.ws + WS_KT) + (size_t)gi * KT_ELEMS; bf16_t* EM = (bf16_t*)(F.ws + WS_EM) + (size_t)gi * 128 * 1024; bf16_t* MY = (bf16_t*)(F.ws + WS_MY) + (size_t)gi * 1024 * 128;
    for (int idx = sl * (KT_ELEMS / 8) + tid; idx < (sl + 1) * (KT_ELEMS / 8); idx += 512) { const int dd = idx >> 8, c = (idx >> 4) & 15, cp = idx & 15; float acc = 0.f;
        if (dd > 0) { const int d = dd - 1;
            for (int n = 0; n < 64; ++n) { const f32x2 p = POW[d * 64 + n], bb = BB[n * 16 + cp], cc = CC[c * 64 + n];
                const float wr = p[0] * bb[0] - p[1] * bb[1], wi = p[0] * bb[1] + p[1] * bb[0]; acc += cc[0] * wr - cc[1] * wi; } }
        KT[idx] = (bf16_t)f2bf(acc); }
    for (int idx = sl * 16384 + tid; idx < (sl + 1) * 16384; idx += 512) { const int ri = idx >> 10, k = idx & 1023, n = ri & 63, part = ri >> 6, j = k >> 4, cp = k & 15;
        const f32x2 p = POW[(63 - j) * 64 + n], bb = BB[n * 16 + cp]; const float v = part == 0 ? p[0] * bb[0] - p[1] * bb[1] : p[0] * bb[1] + p[1] * bb[0];
        EM[idx] = (bf16_t)f2bf(v); }
    for (int idx = sl * 16384 + tid; idx < (sl + 1) * 16384; idx += 512) { const int row = idx >> 7, ki = idx & 127, t = row >> 4, c = row & 15, n = ki & 63, part = ki >> 6;
        const f32x2 p = POW[(t + 1) * 64 + n], cc = CC[c * 64 + n]; const float v = part == 0 ? cc[0] * p[0] - cc[1] * p[1] : -(cc[0] * p[1] + cc[1] * p[0]);
        MY[idx] = (bf16_t)f2bf(v); }
    if (sl == 0 && tid < 64) ((f32x2*)(F.ws + WS_A64))[gi * 64 + tid] = POW[64 * 64 + tid];
    __syncthreads();
}

__device__ __forceinline__ float gelu_tanh_f(float v) { const float u = 0.7978845608028654f * (v + 0.044715f * v * v * v); const float e = __expf(2.f * u); return v * (1.f - 1.f / (e + 1.f)); }
constexpr int SS_KT = 0, SS_ES = 33280, SS_MYB = 33280, SS_MYP = 272, SS_EMB = 66560, SS_EMP = 144, SS_EMBUF = 128 * SS_EMP, SS_SP = 103424, SS_SPP = 136;
static_assert(SS_EMB + 2 * SS_EMBUF <= SS_SP && SS_MYB + 256 * SS_MYP <= SS_SP && SS_SP + 64 * SS_SPP * 2 <= RING_BYTES, "SSM LDS map");
__device__ __forceinline__ void ssm_unit(Frame& F, const Args& A, int b, int gi, int fake) {
    const bf16_t* U = (const bf16_t*)(F.ws + WS_D); bf16_t* Y = (bf16_t*)(F.ws + WS_D) + (size_t)M * 512; const float* d_skip = A.in[10];
    const bf16_t* KTg = (const bf16_t*)(F.ws + WS_KT) + (size_t)gi * KT_ELEMS; const bf16_t* EM = (const bf16_t*)(F.ws + WS_EM) + (size_t)gi * 128 * 1024; const bf16_t* MY = (const bf16_t*)(F.ws + WS_MY) + (size_t)gi * 1024 * 128;
    LAS unsigned char* lds = F.lds; LAS bf16_t* KT = (LAS bf16_t*)(lds + SS_KT); LAS float* ES = (LAS float*)(lds + SS_ES); LAS bf16_t* SP = (LAS bf16_t*)(lds + SS_SP);
    const int tid = F.tid, lane = F.lane, fr = lane & 15, g = lane >> 4, w = F.wave, nt = w & 3, wh = w >> 2;
    __syncthreads();
    for (int i = tid; i < KT_ELEMS / 8; i += 512) ((LAS u32x4*)KT)[i] = ((const u32x4*)KTg)[i];
    const size_t tokb = (size_t)b * SEQ + (size_t)(16 * nt + fr) * 64;
    const bf16_t* ub = U + tokb * 512 + gi * 16 + 8 * (g & 1) + (size_t)(g >> 1) * 512;
    if (!(fake & 2)) { f32x4 acc[4];
#pragma unroll
      for (int i = 0; i < 4; ++i) acc[i] = (f32x4){0.f, 0.f, 0.f, 0.f};
      const int er0 = tid >> 3, es = tid & 7;
      const bf16_t* eg = EM + (size_t)er0 * 1024 + es * 8;
      u32x4 re[4][2]; bf16x8 rb[4][2];
#define SS_LD(j, kc) do { re[j][0] = *(const u32x4*)(eg + (kc) * 64); re[j][1] = *(const u32x4*)(eg + (size_t)64 * 1024 + (kc) * 64); \
          rb[j][0] = *(const bf16x8*)(ub + (size_t)(2 * (kc)) * 1024); rb[j][1] = *(const bf16x8*)(ub + (size_t)(2 * (kc) + 1) * 1024); } while (0)
#pragma unroll
      for (int j = 0; j < 4; ++j) SS_LD(j, j);
#pragma unroll
      for (int kq = 0; kq < 16; kq += 4) {
#pragma unroll
          for (int j = 0; j < 4; ++j) { const int kc = kq + j; LAS unsigned char* eb = lds + SS_EMB + (kc & 1) * SS_EMBUF;
              *(LAS u32x4*)(eb + er0 * SS_EMP + es * 16) = re[j][0]; *(LAS u32x4*)(eb + (er0 + 64) * SS_EMP + es * 16) = re[j][1];
              const bf16x8 b0 = rb[j][0], b1 = rb[j][1];
              if (kc + 4 < 16) SS_LD(j, kc + 4);
              LDS_BARRIER();
              bf16x8 af[2][4];
#pragma unroll
              for (int q = 0; q < 2; ++q)
#pragma unroll
                  for (int i = 0; i < 4; ++i) af[q][i] = *(const LAS bf16x8*)(eb + (wh * 64 + i * 16 + fr) * SS_EMP + q * 64 + g * 16);
#pragma unroll
              for (int i = 0; i < 4; ++i) { acc[i] = __builtin_amdgcn_mfma_f32_16x16x32_bf16(af[0][i], b0, acc[i], 0, 0, 0); acc[i] = __builtin_amdgcn_mfma_f32_16x16x32_bf16(af[1][i], b1, acc[i], 0, 0, 0); } } }
#undef SS_LD
#pragma unroll
      for (int i = 0; i < 4; ++i)
#pragma unroll
          for (int r = 0; r < 4; ++r) ES[(wh * 64 + i * 16 + 4 * g + r) * 65 + 16 * nt + fr] = acc[i][r]; }
    __syncthreads();
    if (tid < 64 && !(fake & 4)) { const f32x2 a = ((const f32x2*)(F.ws + WS_A64))[gi * 64 + tid]; float sr = 0.f, si = 0.f;
        for (int c = 0; c < 64; ++c) { SP[c * SS_SPP + tid] = (bf16_t)f2bf(sr); SP[c * SS_SPP + 64 + tid] = (bf16_t)f2bf(si);
            const float er = ES[tid * 65 + c], ei = ES[(64 + tid) * 65 + c]; const float nr = a[0] * sr - a[1] * si + er, ni = a[0] * si + a[1] * sr + ei; sr = nr; si = ni; } }
    const int mr0 = tid >> 4, ms = tid & 15; const bf16_t* mg = MY + (size_t)mr0 * 128 + ms * 8;
    u32x4 rm[8];
#pragma unroll
    for (int i = 0; i < 8; ++i) rm[i] = *(const u32x4*)(mg + (size_t)(32 * i) * 128);
    LDS_BARRIER();
    if (!(fake & 8)) { const f32x4 dsk = *(const f32x4*)(d_skip + gi * 16 + 4 * g);
      const LAS bf16_t* ka = KT + fr * 16 + 8 * (g & 1) + (1 - (g >> 1) + wh) * 256;
#pragma unroll 1
      for (int B = 0; B < 4; ++B) {
          f32x4 acc[8];
#pragma unroll
          for (int i = 0; i < 8; ++i) acc[i] = (f32x4){0.f, 0.f, 0.f, 0.f};
          bf16x8 ring[4];
#pragma unroll
          for (int j = 0; j < 4; ++j) ring[j] = *(const bf16x8*)(ub + (size_t)j * 1024);
#pragma unroll
          for (int i = 0; i < 8; ++i) *(LAS u32x4*)(lds + SS_MYB + (mr0 + 32 * i) * SS_MYP + ms * 16) = rm[i];
          if (B < 3) {
#pragma unroll
              for (int i = 0; i < 8; ++i) rm[i] = *(const u32x4*)(mg + (size_t)(256 * (B + 1) + 32 * i) * 128); }
          LDS_BARRIER();
#pragma unroll
          for (int ks = 0; ks < 4; ++ks) { const bf16x8 bs = *(const LAS bf16x8*)(SP + (16 * nt + fr) * SS_SPP + ks * 32 + 8 * g);
              bf16x8 af[8];
#pragma unroll
              for (int i = 0; i < 8; ++i) af[i] = *(const LAS bf16x8*)(lds + SS_MYB + ((2 * i + wh) * 16 + fr) * SS_MYP + ks * 64 + g * 16);
#pragma unroll
              for (int i = 0; i < 8; ++i) acc[i] = __builtin_amdgcn_mfma_f32_16x16x32_bf16(af[i], bs, acc[i], 0, 0, 0); }
#pragma unroll 1
          for (int kb = 0; kb < 8 * B; kb += 4) {
#pragma unroll
              for (int j = 0; j < 4; ++j) { const int ks = kb + j;
                  const bf16x8 bf = ring[j]; ring[j] = *(const bf16x8*)(ub + (size_t)(ks + 4) * 1024);
                  const LAS bf16_t* kk = ka + (8 * B - ks) * 512;
                  bf16x8 af[8];
#pragma unroll
                  for (int i = 0; i < 8; ++i) af[i] = *(const LAS bf16x8*)(kk + i * 512);
                  __builtin_amdgcn_sched_barrier(0);
#pragma unroll
                  for (int i = 0; i < 8; ++i) acc[i] = __builtin_amdgcn_mfma_f32_16x16x32_bf16(af[i], bf, acc[i], 0, 0, 0);
                  __builtin_amdgcn_sched_barrier(0); } }
#pragma unroll
          for (int d = 0; d < 8; ++d) {
              const bf16x8 bf = ring[d & 3]; if (d < 4) ring[d & 3] = *(const bf16x8*)(ub + (size_t)(8 * B + d + 4) * 1024);
#pragma unroll
              for (int i = d; i < 8; ++i) { const bf16x8 af = *(const LAS bf16x8*)(ka + (i - d) * 512); acc[i] = __builtin_amdgcn_mfma_f32_16x16x32_bf16(af, bf, acc[i], 0, 0, 0); } }
#pragma unroll
          for (int i = 0; i < 8; ++i) { const int t = 2 * (8 * B + i) + wh; const size_t off = (tokb + t) * 512 + gi * 16 + 4 * g;
              const u32x2 uw = *(const u32x2*)(U + off); const f32x4 uv = (f32x4){bflo(uw.x), bfhi(uw.x), bflo(uw.y), bfhi(uw.y)};
              f32x4 y = acc[i] + dsk * uv;
#pragma unroll
              for (int r = 0; r < 4; ++r) y[r] = gelu_tanh_f(y[r]);
              if (!(fake & 1)) *(u32x2*)(Y + off) = (u32x2){cvtpk(y[0], y[1]), cvtpk(y[2], y[3])}; }
          LDS_BARRIER();
      } }
}

constexpr int AT_QU = 512  , AT_OST = 0, AT_OP = 72  , AT_M = 73728, AT_L = 75776, AT_V = 77824, AT_VW = 4608, AT_VP = 144;
typedef short s16x4 __attribute__((ext_vector_type(4)));
__device__ __forceinline__ s16x4 vtr(const LAS unsigned char* p) { return __builtin_bit_cast(s16x4, __builtin_amdgcn_ds_read_tr16_b64_v4i16((LAS s16x4*)p)); }
__device__ __forceinline__ float xmax16(float x) { auto r = __builtin_amdgcn_permlane16_swap(__float_as_uint(x), __float_as_uint(x), false, false); return fmaxf(__uint_as_float(r[0]), __uint_as_float(r[1])); }
__device__ __forceinline__ float xmax32(float x) { auto r = __builtin_amdgcn_permlane32_swap(__float_as_uint(x), __float_as_uint(x), false, false); return fmaxf(__uint_as_float(r[0]), __uint_as_float(r[1])); }
template <bool SHARED>
__device__ __forceinline__ void attn_branch(Frame& F, int b, int h, int t0, int br, int r, int pp, int fake) {
    const bf16_t* Qg = (const bf16_t*)(F.ws + WS_C); bf16_t* MIXo = (bf16_t*)(F.ws + WS_B);
    LAS unsigned char* lds = F.lds; LAS bf16_t* Ost = (LAS bf16_t*)(lds + AT_OST); LAS float* Mst = (LAS float*)(lds + AT_M); LAS float* Lst = (LAS float*)(lds + AT_L);
    const int lane = F.lane, fr = lane & 15, g = lane >> 4;
    const float slope2 = exp2f(-(float)(h + 1)) * LOG2E, sr = slope2 * (float)r;
    const size_t rowb = (size_t)b * SEQ;
    const int vrow = lane >> 3, vch = lane & 7;
    constexpr int NS_ = SHARED ? 1 : 2;
    int qpos[2], lo[2], hi[2], k0s[NS_]; bf16x8 qf0[2], qf1[2]; float m[2], l[2]; f32x4 o[2][4]; u32x4 kr[NS_][4]; u32x4 vr[NS_][4]; f32x4 biasC[2][2];
    LAS unsigned char* vb[NS_]; const LAS unsigned char* trp[NS_];
#pragma unroll
    for (int X = 0; X < 2; ++X) {
        int base;
        if (SHARED) { const int p = F.wave + 8 * pp, cls = p % r, pi = p / r; base = t0 + cls + (2 * pi + X) * 16 * r; }
        else { const int s = F.wave + 8 * X; base = t0 + s; }
        qpos[X] = base + r * fr;
        const int k0 = (SHARED ? base - 16 * r * X : base) - 128 * r;
        if (X < NS_) k0s[X < NS_ ? X : 0] = k0;
        const int nmin = k0 < 0 ? (-k0 + r - 1) / r : 0, sh = SHARED ? 16 * X : 0;
        lo[X] = (fr + sh) > nmin ? (fr + sh) : nmin; hi[X] = fr + sh + 128;
        const bf16_t* qp = Qg + (rowb + qpos[X]) * 512 + h * 64 + 8 * g; qf0[X] = *(const bf16x8*)qp; qf1[X] = *(const bf16x8*)(qp + 32);
        m[X] = -1e30f; l[X] = 0.f;
#pragma unroll
        for (int dt = 0; dt < 4; ++dt) o[X][dt] = (f32x4){0.f, 0.f, 0.f, 0.f};
#pragma unroll
        for (int T = 0; T < 2; ++T)
#pragma unroll
            for (int rr = 0; rr < 4; ++rr) biasC[X][T][rr] = sr * (float)(16 * T + 4 * g + rr - sh - 128 - fr);
    }
    const __amdgpu_buffer_rsrc_t rs = __builtin_amdgcn_make_buffer_rsrc((void*)F.ws, 0, 0x7fffffff, 0x00020000);
    int koff[NS_][4], voff[NS_][4], nminu[NS_]; const LAS unsigned char* kfp[NS_];
#pragma unroll
    for (int Y = 0; Y < NS_; ++Y) {
        vb[Y] = lds + AT_V + F.wave * AT_VW; trp[Y] = vb[Y] + (4 * g + (fr >> 2)) * AT_VP + (fr & 3) * 8;
        nminu[Y] = k0s[Y] < 0 ? (-k0s[Y] + r - 1) / r : 0;
#pragma unroll
        for (int i = 0; i < 4; ++i) koff[Y][i] = (int)(WS_C + (size_t)M * 1024) + (int)((((long)rowb + k0s[Y] + r * (vrow + 8 * i)) * 512 + h * 64 + vch * 8) * 2);
        kfp[Y] = vb[Y] + fr * AT_VP + g * 16;
#pragma unroll
        for (int i = 0; i < 4; ++i) voff[Y][i] = (int)(WS_C + (size_t)M * 2048) + (int)((((long)rowb + k0s[Y] + r * (vrow + 8 * i)) * 512 + h * 64 + vch * 8) * 2);
    }
    const int kstepb = fake ? 0 : 32768 * r;
#define AT_LOAD(Y, n0) do { const int so_ = ((n0) >> 5) * kstepb; \
        _Pragma("unroll") for (int i = 0; i < 4; ++i) { kr[Y][i] = __builtin_amdgcn_raw_buffer_load_b128(rs, koff[Y][i], so_, 0); vr[Y][i] = __builtin_amdgcn_raw_buffer_load_b128(rs, voff[Y][i], so_, 0); } } while (0)
#pragma unroll
    for (int Y = 0; Y < NS_; ++Y) AT_LOAD(Y, 0);
#pragma unroll 1
    for (int st = 0; st < 5; ++st) {
        const int n0 = st * 32; f32x4 sT[2][2]; bf16x8 pb[2];
        bf16x8 kf[NS_][2][2];
#pragma unroll
        for (int Y = 0; Y < NS_; ++Y) {
#pragma unroll
            for (int i = 0; i < 4; ++i) *(LAS u32x4*)(vb[Y] + (vrow + 8 * i) * AT_VP + vch * 16) = kr[Y][i];
#pragma unroll
            for (int T = 0; T < 2; ++T)
#pragma unroll
                for (int ks = 0; ks < 2; ++ks) kf[Y][T][ks] = *(const LAS bf16x8*)(kfp[Y] + T * 16 * AT_VP + ks * 64);
#pragma unroll
            for (int i = 0; i < 4; ++i) *(LAS u32x4*)(vb[Y] + (vrow + 8 * i) * AT_VP + vch * 16) = vr[Y][i];
        }
#pragma unroll
        for (int X = 0; X < 2; ++X)
#pragma unroll
            for (int T = 0; T < 2; ++T) { const int Y = SHARED ? 0 : X;
                sT[X][T] = __builtin_amdgcn_mfma_f32_16x16x32_bf16(kf[Y][T][0], qf0[X], biasC[X][T], 0, 0, 0); sT[X][T] = __builtin_amdgcn_mfma_f32_16x16x32_bf16(kf[Y][T][1], qf1[X], sT[X][T], 0, 0, 0); }
        if (st < 4) {
#pragma unroll
            for (int Y = 0; Y < NS_; ++Y) AT_LOAD(Y, n0 + 32); }
        const float off = sr * (float)n0;
#pragma unroll
        for (int X = 0; X < 2; ++X) {
            const int Y = SHARED ? 0 : X;
            const bool full = (st >= 1) && (st <= 3) && (n0 >= nminu[Y]);
            if (!full) { const unsigned span = (unsigned)(hi[X] - lo[X]);
#pragma unroll
                for (int T = 0; T < 2; ++T)
#pragma unroll
                    for (int rr = 0; rr < 4; ++rr) { const int n = n0 + 16 * T + 4 * g + rr; if ((unsigned)(n - lo[X]) > span) sT[X][T][rr] = -1e30f; } }
            float pmax = fmaxf(fmaxf(fmaxf(sT[X][0][0], sT[X][0][1]), fmaxf(sT[X][0][2], sT[X][0][3])), fmaxf(fmaxf(sT[X][1][0], sT[X][1][1]), fmaxf(sT[X][1][2], sT[X][1][3])));
            pmax = xmax32(xmax16(pmax)) + off;
            const float mn = fmaxf(m[X], pmax);
            if (__any(mn > m[X])) { const float f = __builtin_amdgcn_exp2f(m[X] - mn); l[X] *= f;
#pragma unroll
                for (int dt = 0; dt < 4; ++dt) o[X][dt] = o[X][dt] * f; }
            m[X] = mn; const float ml = mn - off; float ps = 0.f;
#pragma unroll
            for (int T = 0; T < 2; ++T)
#pragma unroll
                for (int rr = 0; rr < 4; ++rr) { const float p = __builtin_amdgcn_exp2f(sT[X][T][rr] - ml); sT[X][T][rr] = p; ps += p; }
            l[X] += ps;
            const u32x4 pw = (u32x4){cvtpk(sT[X][0][0], sT[X][0][1]), cvtpk(sT[X][0][2], sT[X][0][3]), cvtpk(sT[X][1][0], sT[X][1][1]), cvtpk(sT[X][1][2], sT[X][1][3])};
            pb[X] = __builtin_bit_cast(bf16x8, pw);
        }
#pragma unroll
        for (int dt = 0; dt < 4; ++dt) {
            bf16x8 vf[NS_];
#pragma unroll
            for (int Y = 0; Y < NS_; ++Y) { const s16x4 lo4 = vtr(trp[Y] + dt * 32), hi4 = vtr(trp[Y] + 16 * AT_VP + dt * 32); vf[Y] = (bf16x8){lo4[0], lo4[1], lo4[2], lo4[3], hi4[0], hi4[1], hi4[2], hi4[3]}; }
#pragma unroll
            for (int X = 0; X < 2; ++X) o[X][dt] = __builtin_amdgcn_mfma_f32_16x16x32_bf16(vf[SHARED ? 0 : X], pb[X], o[X][dt], 0, 0, 0);
        }
    }
#undef AT_LOAD
#pragma unroll
    for (int X = 0; X < 2; ++X) {
        float lx = l[X]; lx += __shfl_xor(lx, 16); lx += __shfl_xor(lx, 32); float mx = m[X];
        const int qi = qpos[X] - t0;
        if (br > 0) { const float ms = Mst[qi], ls = Lst[qi]; const float mn = fmaxf(mx, ms), f1 = __builtin_amdgcn_exp2f(mx - mn), f2 = __builtin_amdgcn_exp2f(ms - mn);
#pragma unroll
            for (int dt = 0; dt < 4; ++dt) { const u32x2 ow = *(const LAS u32x2*)(Ost + qi * AT_OP + 16 * dt + 4 * g); const f32x4 os = (f32x4){bflo(ow.x), bfhi(ow.x), bflo(ow.y), bfhi(ow.y)}; o[X][dt] = o[X][dt] * f1 + os * f2; }
            lx = lx * f1 + ls * f2; mx = mn; }
        if (br < 2) {
#pragma unroll
            for (int dt = 0; dt < 4; ++dt) *(LAS u32x2*)(Ost + qi * AT_OP + 16 * dt + 4 * g) = (u32x2){cvtpk(o[X][dt][0], o[X][dt][1]), cvtpk(o[X][dt][2], o[X][dt][3])};
            if (g == 0) { Mst[qi] = mx; Lst[qi] = lx; }
        } else if (!fake) { const float inv = 1.f / lx; bf16_t* op = MIXo + (rowb + qpos[X]) * 1024 + h * 64 + 4 * g;
#pragma unroll
            for (int dt = 0; dt < 4; ++dt) { const f32x4 v = o[X][dt] * inv; *(u32x2*)(op + 16 * dt) = (u32x2){cvtpk(v[0], v[1]), cvtpk(v[2], v[3])}; } }
    }
}
struct CvtPend { int cur; bool has; TrItem it; f32x4 tv[8]; };
__device__ __forceinline__ void cvt_step(Frame& F, const Args& A, CvtPend& P) {
    if (P.has) tr_store(P.it, P.tv, F.lane);
    P.has = P.cur < I_EXP;
    if (P.has) { P.it = tr_decode_exp(F, A, P.cur); tr_load(P.it, P.tv, F.lane); P.cur += F.G * NWAVES; }
}
__device__ __forceinline__ void attn_unit(Frame& F, const Args& A, int b, int h, int t0, int fake, CvtPend& P) {
#pragma unroll 1
    for (int br = 0; br < 3; ++br) { const int r = br == 0 ? 16 : (br == 1 ? 4 : 1);
#pragma unroll 1
        for (int pp = 0; pp < 2; ++pp) { attn_branch<true>(F, b, h, t0, br, r, pp, fake); if (!fake && !P0_EXPERTS) cvt_step(F, A, P); }
        __syncthreads(); }
}
__device__ __forceinline__ void p2_mixers(Frame& F, const Args& A) {
    CvtPend P; P.cur = F.vcu * NWAVES + F.wave; P.has = false;
#ifndef REP_SSM
#define REP_SSM 1
#endif
#ifndef REP_ATT
#define REP_ATT 1
#endif
#ifndef SSM_FAKE
#define SSM_FAKE 0
#endif
#ifndef ATT_FAKE
#define ATT_FAKE 0
#endif
    for (int rp = 0; rp < REP_SSM; ++rp)
    for (int u = F.vcu; u < BATCH * NG; u += F.G) ssm_unit(F, A, u / NG, u % NG, rp > 0 ? SSM_FAKE : 0);
    __syncthreads();
    for (int rp = 0; rp < REP_ATT; ++rp)
    for (int u = F.vcu; u < BATCH * NH * (SEQ / AT_QU); u += F.G) { const int qb = u & 7, bh = u >> 3; attn_unit(F, A, bh >> 3, bh & 7, qb * AT_QU, rp > 0 ? ATT_FAKE : 0, P); }
    if (P.has) tr_store(P.it, P.tv, F.lane);
    if (!P0_EXPERTS) (void)cvt_expert_burst(F, A, P.cur, 1 << 20);
}

constexpr int N_PHASES = 12;
__global__ void __launch_bounds__(NWAVES * 64, 2) mk_fwd(Args args) {
    extern __shared__ __attribute__((aligned(16))) unsigned char lds_raw[];
    Frame F;
    F.lds = (LAS unsigned char*)lds_raw;
    F.MISC = (volatile LAS unsigned*)(F.lds + MISC_OFF);
    F.tid = threadIdx.x; F.lane = F.tid & 63; F.wave = __builtin_amdgcn_readfirstlane(F.tid >> 6);
    F.G = gridDim.x; { const int bx = blockIdx.x; F.vcu = (F.G % 8 == 0) ? (bx % 8) * (F.G / 8) + bx / 8 : bx; }
    F.ws = args.ws; F.out = args.out; F.ctl = (unsigned*)(args.ws + WS_CTL);
    for (int u = F.tid; u < (LDS_BYTES - LDSCTL_OFF) / 4; u += NWAVES * 64) ((LAS unsigned*)(F.lds + LDSCTL_OFF))[u] = 0u;
    __syncthreads();
    const int lo = args.ph_lo, hi = args.ph_hi;
    XcdBarrier bar; bar.bar = F.ctl + CW_BAR; bar.x = 0; bar.st = nullptr;
    if (hi - lo > 1) bar = xcd_barrier_post(F.ctl + CW_BAR, F.MISC + 8);
#ifndef PH_MASK
#define PH_MASK 0xfff
#endif
#define IN(k) (((PH_MASK >> (k)) & 1) && lo <= (k) && (k) < hi)
#ifndef REPEAT_MASK
#define REPEAT_MASK 0
#endif
#ifndef P5_FAKE
#define P5_FAKE 0
#endif
#ifndef PROBE_EPI_MODE
#define PROBE_EPI_MODE 0
#endif
#define PH(k) if (IN(k)) for (int rep_ = 0; rep_ < 1 + ((REPEAT_MASK >> (k)) & 1); ++rep_)
#define RELAUNDER() do { int t_ = threadIdx.x; asm volatile("" : "+v"(t_)); F.tid = t_; F.lane = t_ & 63; F.wave = __builtin_amdgcn_readfirstlane(t_ >> 6); \
        GAS unsigned char* w_ = (GAS unsigned char*)args.ws; GAS float* o_ = (GAS float*)args.out; asm volatile("" : "+s"(w_), "+s"(o_)); F.ws = (unsigned char*)w_; F.out = (float*)o_; F.ctl = (unsigned*)(w_ + WS_CTL); } while (0)
#define XB ((bf16_t*)(F.ws + WS_B))
#define MIX XB
#define H XB
#define Qb ((bf16_t*)(F.ws + WS_C))
#define Ub ((bf16_t*)(F.ws + WS_D))
#define Yb (Ub + (size_t)M * 512)
#define SEAM(k) do { if (IN(k) && IN((k) + 1)) xcd_barrier(bar); } while (0)
    LAS unsigned char* ring = F.lds + RING_OFF;

    PH(0) { RELAUNDER(); for (int it = F.vcu; it < NG * 8; it += F.G) p0_ssm_tables(F, args, it >> 3, it & 7); p0_prologue(F, args); } SEAM(0);
    PH(1) { RELAUNDER();
        pg8::PlainSched S; S.init(XB, (const bf16_t*)(F.ws + WS_WIN), M, ZC, DM, F.G, (int)blockIdx.x);
        EpiQKVU E{Qb};
        pg8::gemm_phase<EpiQKVU, pg8::PlainSched, true>(ring, DM, S, E);
    } SEAM(1);
    PH(2) { RELAUNDER(); p2_mixers(F, args); } SEAM(2);
    PH(3) { RELAUNDER();
        pg8::PlainSched S; S.init(Yb, (const bf16_t*)(F.ws + WS_WGLU), M, SW, SW, F.G, (int)blockIdx.x);
        EpiGLU E{Yb, args.in[12], MIX};
        pg8::gemm_phase<EpiGLU, pg8::PlainSched, true>(ring, SW, S, E);
    } SEAM(3);
    PH(4) { RELAUNDER();
        pg8::PlainSched S; S.init(MIX, (const bf16_t*)(F.ws + WS_WOUT), M, DM, DM, F.G, (int)blockIdx.x);
        EpiWout E{args.in[0], F.out, (f32x2*)(F.ws + WS_STATS)};
        pg8::gemm_phase<EpiWout, pg8::PlainSched, true>(ring, DM, S, E);
    } SEAM(4);
    PH(5) { RELAUNDER();
#if (REPEAT_MASK >> 5) & 1
        if (rep_ == 1 && !P5_FAKE) { xcd_barrier(bar); if (blockIdx.x == 0 && F.tid < 256) __hip_atomic_store(F.ctl + CW_CNT + F.tid, 0u, RLX_AGENT); xcd_barrier(bar); }
#endif
        p5_ln_router(F, args, rep_ == 1 ? P5_FAKE : 0); } SEAM(5);
#define SLABQ(q) ((unsigned char*)(F.ws + (((q) & 1) ? WS_SLAB1 : WS_SLAB0)))
#define DOWN(q) do { DownSched S{(const unsigned char*)(F.ws + WS_HID), (const unsigned char*)(F.ws + WS_WD), (LAS const int*)(F.lds + TAB_OFF)}; \
        EpiDown E{SLABQ(q), (LAS const int*)(F.lds + IDX_OFF)}; pg8::gemm_phase<EpiDown, DownSched, false, true, 1>(ring, EH / 2, S, E); } while (0)
#define COMB_LIGHT(q) p_combine_ln2(F, args, (q), SLABQ(q), 0, F.G)
    PH(6) { RELAUNDER();
        p_convert_p(F, args);
        { pg8::PlainSched S; S.init((const bf16_t*)(F.ws + WS_H8), (const bf16_t*)(F.ws + WS_WPG), M, DM, DM / 2, F.G, (int)blockIdx.x);
          EpiGS E{(bf16_t*)((char*)F.out + OUT_GS)};
          pg8::gemm_phase<EpiGS, pg8::PlainSched, true, true>(ring, DM / 2, S, E); }
        moe_units<0>(F, 0);
        { GUSched S{(const bf16_t*)(F.ws + WS_H8), (const bf16_t*)(F.ws + WS_WGU), (LAS const int*)(F.lds + TAB_OFF), (LAS const int*)(F.lds + IDX_OFF)}; EpiGU E{(unsigned char*)(F.ws + WS_HID)};
          pg8::gemm_phase<EpiGU, GUSched, true, true>(ring, DM / 2, S, E); }
    } SEAM(6);
    PH(7) { RELAUNDER();
        { pg8::PlainSched S; S.init((const bf16_t*)F.out, (const bf16_t*)(F.ws + WS_WPLE), M, DM, PLE, F.G, (int)blockIdx.x);
          EpiBase E{(const bf16_t*)((const char*)F.out + OUT_GS), H};
          pg8::gemm_phase<EpiBase, pg8::PlainSched, true>(ring, PLE, S, E); }
        moe_units<1>(F, 0); DOWN(0);
    } SEAM(7);
#ifndef REP_COMB
#define REP_COMB 1
#endif
#ifndef REP_DOWN
#define REP_DOWN 1
#endif
    PH(8)  { RELAUNDER(); moe_units<1>(F, 1); for (int rc = 0; rc < REP_COMB; ++rc) COMB_LIGHT(0); for (int rd = 0; rd < REP_DOWN; ++rd) DOWN(1); } SEAM(8);
    PH(9)  { RELAUNDER(); moe_units<1>(F, 2); COMB_LIGHT(1); DOWN(2); } SEAM(9);
    PH(10) { RELAUNDER(); moe_units<1>(F, 3); COMB_LIGHT(2); DOWN(3); } SEAM(10);
    PH(11) { RELAUNDER(); p_combine_ln2(F, args, 3, SLABQ(3), 0, F.G); }
#undef SLABQ
#undef DOWN
#undef COMB_LIGHT
#undef IN
#undef SEAM
#undef XB
#undef MIX
#undef H
#undef Qb
#undef Ub
#undef Yb

}

#ifndef HYBRID
#define HYBRID 0
#endif
#ifndef ONE_LAUNCH
#define ONE_LAUNCH 0
#endif
extern "C" void kernel_launch(void* const* d_in, const int* in_sizes, int n_in, void* d_out, int out_size, void* d_ws, size_t ws_size, hipStream_t stream) {
    static int grid = 0;
    if (grid == 0) {
        if (n_in != 28 || out_size != M * DM || ws_size < WS_END) { fprintf(stderr, "kernel_launch: unexpected shapes (n_in %d out %d ws %zu)\n", n_in, out_size, ws_size); grid = -1; return; }
        int dev = 0, cus = 0;
        if (hipGetDevice(&dev) != hipSuccess || hipDeviceGetAttribute(&cus, hipDeviceAttributeMultiprocessorCount, dev) != hipSuccess) { grid = -1; return; }
        if (hipFuncSetAttribute((const void*)mk_fwd, hipFuncAttributeMaxDynamicSharedMemorySize, LDS_BYTES) != hipSuccess) { fprintf(stderr, "kernel_launch: hipFuncSetAttribute failed\n"); grid = -1; return; }
        grid = cus;
    }
    if (grid < 0) return;
    (void)hipMemsetAsync((char*)d_ws + WS_CTL, 0, CTL_ZERO_BYTES, stream);
    Args a{};
    for (int i = 0; i < 28; ++i) a.in[i] = (const float*)d_in[i];
    a.out = (float*)d_out; a.ws = (unsigned char*)d_ws;
    const int last_phase = (HYBRID == 2) ? 5 : N_PHASES;
    if (ONE_LAUNCH) { a.ph_lo = 0; a.ph_hi = last_phase; hipLaunchKernelGGL(mk_fwd, dim3(grid), dim3(NWAVES * 64), LDS_BYTES, stream, a); }
    else for (int p = 0; p < last_phase; ++p) { a.ph_lo = p; a.ph_hi = p + 1; hipLaunchKernelGGL(mk_fwd, dim3(grid), dim3(NWAVES * 64), LDS_BYTES, stream, a); }
#if HYBRID == 2
    {
        using nv::GP;
        const float* pin = (const float*)d_in[1];
        const float* ln1_g = (const float*)d_in[14]; const float* ln1_b = (const float*)d_in[15]; const float* w_router = (const float*)d_in[16]; const float* router_bias = (const float*)d_in[17];
        const float* w_gate = (const float*)d_in[18]; const float* w_up = (const float*)d_in[19]; const float* w_down = (const float*)d_in[20];
        const float* ws_gate = (const float*)d_in[21]; const float* ws_up = (const float*)d_in[22]; const float* ws_down = (const float*)d_in[23];
        const float* w_ple = (const float*)d_in[24]; const float* w_pg = (const float*)d_in[25]; const float* ln2_g = (const float*)d_in[26]; const float* ln2_b = (const float*)d_in[27];
        float* out = (float*)d_out; char* ws = (char*)d_ws;
        float* HID = (float*)(ws); float* H = (float*)(ws + 256 * MiB); float* HIDS = (float*)(ws + 384 * MiB); float* SC = (float*)(ws + 448 * MiB);
        int* LIST = (int*)(ws + 456 * MiB); float* LISTW = (float*)(ws + 464 * MiB); int* CNT = (int*)(ws + 472 * MiB); int* OFF = CNT + 64;
        GP g{};
        nv::k_ln<<<M / 4, 256, 0, stream>>>(out, H, ln1_g, ln1_b);
        g = GP{}; g.A = H; g.lda = DM; g.B = w_router; g.ldb = NE; g.K = DM; g.nrows = M; g.C = SC; g.ldc = NE;
        nv::k_gemm<3><<<dim3(1, M / 64), 256, 0, stream>>>(g);
        (void)hipMemsetAsync(CNT, 0, 128 * sizeof(int), stream);
        nv::k_topk<<<M / 256, 256, 0, stream>>>(SC, router_bias, CNT, LIST, LISTW);
        nv::k_prefix<<<1, 64, 0, stream>>>(CNT, OFF);
        (void)hipMemsetAsync(out, 0, (size_t)M * DM * sizeof(float), stream);
        g = GP{}; g.A = H; g.lda = DM; g.B = w_gate; g.B2 = w_up; g.ldb = EH; g.K = DM; g.C = HID; g.ldc = EH; g.cnt = CNT; g.off = OFF; g.list = LIST; g.listw = LISTW;
        nv::k_gemm<4><<<dim3(EH / 64, M / 64, NE), 256, 0, stream>>>(g);
        g = GP{}; g.A = HID; g.lda = EH; g.B = w_down; g.ldb = DM; g.K = EH; g.C = out; g.ldc = DM; g.cnt = CNT; g.off = OFF; g.list = LIST; g.listw = LISTW;
        nv::k_gemm<5><<<dim3(DM / 64, M / 64, NE), 256, 0, stream>>>(g);
        g = GP{}; g.A = H; g.lda = DM; g.B = ws_gate; g.B2 = ws_up; g.ldb = EH; g.K = DM; g.nrows = M; g.C = HIDS; g.ldc = EH;
        nv::k_gemm<6><<<dim3(EH / 64, M / 64), 256, 0, stream>>>(g);
        g = GP{}; g.A = HIDS; g.lda = EH; g.B = ws_down; g.ldb = DM; g.K = EH; g.nrows = M; g.C = out; g.ldc = DM;
        nv::k_gemm<7><<<dim3(DM / 64, M / 64), 256, 0, stream>>>(g);
        g = GP{}; g.A = pin; g.lda = PLE; g.B = w_ple; g.ldb = DM; g.K = PLE; g.nrows = M; g.C = out; g.ldc = DM; g.A2 = H; g.lda2 = DM; g.B2 = w_pg; g.ldb2 = DM; g.K2 = DM;
        nv::k_gemm<8><<<dim3(DM / 64, M / 64), 256, 0, stream>>>(g);
        nv::k_ln<<<M / 4, 256, 0, stream>>>(out, out, ln2_g, ln2_b);
    }
#endif
}
```

```cpp
#include <hip/hip_runtime.h>
#include <cstdint>
#include <cstdio>
#include <cmath>

#define LAS __attribute__((address_space(3)))
#define GAS __attribute__((address_space(1)))
typedef unsigned short bf16_t;
typedef short bf16x8 __attribute__((ext_vector_type(8)));
typedef float f32x4 __attribute__((ext_vector_type(4)));
typedef float f32x2 __attribute__((ext_vector_type(2)));
typedef unsigned u32x4 __attribute__((ext_vector_type(4)));
typedef unsigned u32x2 __attribute__((ext_vector_type(2)));

constexpr int BATCH = 8, SEQ = 4096, DM = 1024, M = BATCH * SEQ;
constexpr int NH = 8, HD = 64, AW = 512, SW = 512, NG = 32, GC = 16, NS = 64;
constexpr int NE = 64, TOPK = 8, EH = 256, PLE = 256, ZC = 2048;
constexpr float ALPHA = 1.189207115002721f;
constexpr float LN_EPS = 1e-5f;
constexpr float ROUTED_SCALE = 2.5f;
constexpr float LOG2E = 1.4426950408889634f;
constexpr float QSCALE = 0.125f * LOG2E;

__device__ __forceinline__ unsigned f2bf(float f) { unsigned u = __builtin_bit_cast(unsigned, f); return (u + 0x7fffu + ((u >> 16) & 1u)) >> 16; }
__device__ __forceinline__ unsigned pk2(float lo, float hi) { return f2bf(lo) | (f2bf(hi) << 16); }
__device__ __forceinline__ float bf2f(unsigned short b) { return __builtin_bit_cast(float, (unsigned)b << 16); }
__device__ __forceinline__ float bflo(unsigned w) { return __builtin_bit_cast(float, w << 16); }
__device__ __forceinline__ float bfhi(unsigned w) { return __builtin_bit_cast(float, w & 0xffff0000u); }
__device__ __forceinline__ float wave_sum(float v) {
#pragma unroll
    for (int o = 1; o < 64; o <<= 1) v += __shfl_xor(v, o);
    return v;
}
__device__ __forceinline__ float sigmoidf_(float x) { return __builtin_amdgcn_rcpf(1.f + __expf(-x)); }
#ifndef G1_F8
#define G1_F8 1
#endif
__device__ __forceinline__ int hw_lane() { unsigned z = 0u; asm volatile("" : "+v"(z)); return (int)__builtin_amdgcn_mbcnt_hi(~0u, __builtin_amdgcn_mbcnt_lo(~0u, z)); }
#ifndef WOUT_F8
#define WOUT_F8 1
#endif
#ifndef PLE_F8
#define PLE_F8 1
#endif
#define HYBRID 0
#define ONE_LAUNCH 1

namespace pg8 {
constexpr int BM = 256, BK = 64, HALF = 128, HTB = HALF * BK * 2  , STAGE_BYTES = 8 * HTB, NXCD = 8, WGM = 8;

__host__ __device__ __forceinline__ int lds_byte(int r, int c) { const int st = (r >> 4) * 2 + (c >> 5), rr = r & 15, cc = c & 31, ob = rr * 64 + cc * 2; return st * 1024 + (ob ^ (((ob >> 9) & 1) << 5)); }
__host__ __device__ __forceinline__ void stage_rc(int b, int& R, int& C) { const int st = b / 1024, sb = b % 1024, swz = sb ^ (((sb >> 9) & 1) << 5); R = (st >> 1) * 16 + swz / 64; C = (st & 1) * 32 + (swz % 64) / 2; }
__host__ __device__ __forceinline__ int perm32(int rho) { const int n = rho >> 4, i = rho & 15; return 8 * (i >> 2) + 4 * n + (i & 3); }

struct Unit { int arow, brow, crow, ccol, e, aux; };

typedef int i32x8 __attribute__((ext_vector_type(8)));
typedef int i32x4 __attribute__((ext_vector_type(4)));
__device__ __forceinline__ i32x8 cat8(bf16x8 a, bf16x8 b) { return __builtin_shufflevector(__builtin_bit_cast(i32x4, a), __builtin_bit_cast(i32x4, b), 0, 1, 2, 3, 4, 5, 6, 7); }
struct NoHook { __device__ __forceinline__ void operator()(int, bool) const {} __device__ __forceinline__ void none() const {} };
template <class Epi, class Sched, bool ALIGN_EPI, bool F8 = false, int BMODE = 0, int KREP = 1, class Hook = NoHook>
__device__ __forceinline__ void gemm_phase(LAS unsigned char* lds, const int K, const Sched& S, const Epi& E, const int wv0, const Hook& H = Hook()) {
    int tid_l = (wv0 << 6) | hw_lane(); asm volatile("" : "+v"(tid_l));
    const int tid = tid_l, wid = __builtin_amdgcn_readfirstlane(tid >> 6), lane = tid & 63, wr = wid >> 2, wc = wid & 3, fr = lane & 15, fq = lane >> 4;
    const int nt = K / BK;
    unsigned voffB[2];
#pragma unroll
    for (int i = 0; i < 2; ++i) { int R, C; stage_rc(tid * 16 + i * 8192, R, C); const int Rb = (R & ~31) + perm32(R & 31); voffB[i] = BMODE == 0 ? (unsigned)(Rb * K + C) * 2u : BMODE == 1 ? (unsigned)((64 * (Rb >> 5) + (Rb & 31)) * K + C) * 2u : (unsigned)((64 * (Rb >> 5) + 16 * ((Rb & 31) >> 3) + (Rb & 7)) * K + C) * 2u; }
#define PG8_AVOFF(u_, v_) do { int Ra[2], Ca[2]; int t_ = tid; asm volatile("" : "+v"(t_)); _Pragma("unroll") for (int i = 0; i < 2; ++i) stage_rc(t_ * 16 + i * 8192, Ra[i], Ca[i]); S.avoff(u_, Ra, Ca, v_); } while (0)
    const size_t kstep = (size_t)(BK * 2);
    const size_t hstep = (size_t)(BMODE == 0 ? HALF : BMODE == 1 ? 32 : 8) * K * 2;
    const unsigned ldsw = (unsigned)wid * 1024u;
    const int aoff = lds_byte(wr * 64 + fr, fq * 8), boff = lds_byte(wc * 32 + fr, fq * 8);
#define PG8_SA(b, h) (((b) * 2 + (h)) * HTB)
#define PG8_SB(b, h) ((4 + (b) * 2 + (h)) * HTB)
#define PG8_STAGE(bufoff, gbase, v0, v1) do { \
        __builtin_amdgcn_global_load_lds((const unsigned*)((const char*)(gbase) + (v0)), (LAS unsigned*)(lds + (bufoff) + ldsw), 16, 0, 0); \
        __builtin_amdgcn_global_load_lds((const unsigned*)((const char*)(gbase) + (v1)), (LAS unsigned*)(lds + (bufoff) + ldsw + 8192), 16, 0, 0); } while (0)
#define PG8_LDA(dst, b, h) do { if constexpr (F8) { _Pragma("unroll") for (int m = 0; m < 4; ++m) dst##8[m] = cat8(*(const LAS bf16x8*)(lds + PG8_SA(b, h) + aoff + m * 2048), *(const LAS bf16x8*)(lds + PG8_SA(b, h) + aoff + m * 2048 + 1024)); } \
        else { _Pragma("unroll") for (int m = 0; m < 4; ++m) _Pragma("unroll") for (int k = 0; k < 2; ++k) dst[m][k] = *(const LAS bf16x8*)(lds + PG8_SA(b, h) + aoff + m * 2048 + k * 1024); } } while (0)
#define PG8_LDB(dst, b, h) do { if constexpr (F8) { _Pragma("unroll") for (int n = 0; n < 2; ++n) dst##8[n] = cat8(*(const LAS bf16x8*)(lds + PG8_SB(b, h) + boff + n * 2048), *(const LAS bf16x8*)(lds + PG8_SB(b, h) + boff + n * 2048 + 1024)); } \
        else { _Pragma("unroll") for (int n = 0; n < 2; ++n) _Pragma("unroll") for (int k = 0; k < 2; ++k) dst[n][k] = *(const LAS bf16x8*)(lds + PG8_SB(b, h) + boff + n * 2048 + k * 1024); } } while (0)
#define PG8_MMA(ai, bj, At, Bt) do { __builtin_amdgcn_s_setprio(1); if constexpr (F8) { _Pragma("unroll") for (int m = 0; m < 4; ++m) _Pragma("unroll") for (int n = 0; n < 2; ++n) \
            acc[ai][bj][m][n] = __builtin_amdgcn_mfma_scale_f32_16x16x128_f8f6f4(Bt##8[n], At##8[m], acc[ai][bj][m][n], 0, 0, 0, 0x7f7f7f7f, 0, 0x7f7f7f7f); } \
        else { _Pragma("unroll") for (int m = 0; m < 4; ++m) _Pragma("unroll") for (int n = 0; n < 2; ++n) _Pragma("unroll") for (int k = 0; k < 2; ++k) \
            acc[ai][bj][m][n] = __builtin_amdgcn_mfma_f32_16x16x32_bf16(Bt[n][k], At[m][k], acc[ai][bj][m][n], 0, 0, 0); } __builtin_amdgcn_s_setprio(0); } while (0)
#define PG8_WAIT_V(n) asm volatile("s_waitcnt vmcnt(" #n ")" ::: "memory")
#define PG8_WAIT_L(n) asm volatile("s_waitcnt lgkmcnt(" #n ")" ::: "memory")
#define PG8_BAR __builtin_amdgcn_s_barrier()
#define PG8_SCHED __builtin_amdgcn_sched_barrier(0)
    Unit cur, nxt; int ui = 0;
    if (!S.next(0, cur)) { H.none(); return; }
    f32x4 acc[2][2][4][2];
#pragma unroll
    for (int a = 0; a < 2; ++a)
#pragma unroll
        for (int b = 0; b < 2; ++b)
#pragma unroll
            for (int m = 0; m < 4; ++m)
#pragma unroll
                for (int n = 0; n < 2; ++n) acc[a][b][m][n] = (f32x4){0.f, 0.f, 0.f, 0.f};
    bf16x8 At[4][2], B0[2][2], B1[2][2]; i32x8 At8[4], B08[2], B18[2];
    unsigned cv[2][2];
    PG8_AVOFF(cur, cv);
    const char* cA = S.abase(cur); const char* cB = S.bbase(cur);
    PG8_STAGE(PG8_SB(0, 0), cB, voffB[0], voffB[1]); PG8_STAGE(PG8_SB(0, 1), cB + hstep, voffB[0], voffB[1]); PG8_STAGE(PG8_SA(0, 0), cA, cv[0][0], cv[0][1]); PG8_STAGE(PG8_SA(0, 1), cA, cv[1][0], cv[1][1]);
    if (wr == 1) PG8_BAR;
    PG8_WAIT_V(2); PG8_BAR;
    PG8_STAGE(PG8_SB(1, 0), cB + kstep, voffB[0], voffB[1]); PG8_STAGE(PG8_SA(1, 0), cA + kstep, cv[0][0], cv[0][1]); PG8_STAGE(PG8_SB(1, 1), cB + hstep + kstep, voffB[0], voffB[1]);
    PG8_WAIT_V(6); PG8_BAR;
    for (;;) {
        const bool has_next = S.next(ui + 1, nxt);
        const char* nA = cA; const char* nB = cB;
        if (has_next) { nA = S.abase(nxt); nB = S.bbase(nxt); }
#pragma unroll 1
        for (int t = 0; t < nt; t += 2) {
            const bool last = (t == nt - 2);
            const char* a1 = cA + (size_t)(t + 1) * kstep;
            const char* a2 = last ? nA : cA + (size_t)(t + 2) * kstep; const char* b2 = last ? nB : cB + (size_t)(t + 2) * kstep;
            const char* a3 = a2 + kstep; const char* b3 = b2 + kstep;
            PG8_LDB(B0, 0, 0); PG8_LDB(B1, 0, 1); PG8_SCHED; PG8_LDA(At, 0, 0); PG8_STAGE(PG8_SA(1, 1), a1, cv[1][0], cv[1][1]);
            if (last && has_next) PG8_AVOFF(nxt, cv);
            PG8_WAIT_V(8); PG8_WAIT_L(0); PG8_BAR; PG8_MMA(0, 0, At, B0); PG8_MMA(0, 1, At, B1); PG8_BAR; PG8_SCHED;
            PG8_LDA(At, 0, 1); PG8_STAGE(PG8_SB(0, 0), b2, voffB[0], voffB[1]); PG8_STAGE(PG8_SB(0, 1), b2 + hstep, voffB[0], voffB[1]); PG8_STAGE(PG8_SA(0, 0), a2, cv[0][0], cv[0][1]);
            PG8_WAIT_V(8); PG8_WAIT_L(0); PG8_BAR; PG8_MMA(1, 0, At, B0); PG8_MMA(1, 1, At, B1); PG8_BAR; PG8_SCHED;
            PG8_LDB(B0, 1, 0); PG8_LDB(B1, 1, 1); PG8_SCHED; PG8_LDA(At, 1, 0); PG8_STAGE(PG8_SA(0, 1), a2, cv[1][0], cv[1][1]);
            PG8_WAIT_V(8); PG8_WAIT_L(0); PG8_BAR; PG8_MMA(0, 0, At, B0); PG8_MMA(0, 1, At, B1); PG8_BAR; PG8_SCHED;
            PG8_LDA(At, 1, 1); PG8_STAGE(PG8_SB(1, 0), b3, voffB[0], voffB[1]); PG8_STAGE(PG8_SB(1, 1), b3 + hstep, voffB[0], voffB[1]); PG8_STAGE(PG8_SA(1, 0), a3, cv[0][0], cv[0][1]);
            PG8_WAIT_V(8); PG8_WAIT_L(0); PG8_BAR; PG8_MMA(1, 0, At, B0); PG8_MMA(1, 1, At, B1); PG8_BAR; PG8_SCHED;
        }
        if (KREP == 2 && !(ui & 1)) { cur = nxt; cA = nA; cB = nB; ++ui; continue; }
        if constexpr (ALIGN_EPI) { if (wr == 0) PG8_BAR; }
        E(acc, cur, wr, wc, fr, fq);
        H(ui, has_next);
        if (!has_next) break;
#pragma unroll
        for (int a = 0; a < 2; ++a)
#pragma unroll
            for (int b = 0; b < 2; ++b)
#pragma unroll
                for (int m = 0; m < 4; ++m)
#pragma unroll
                    for (int n = 0; n < 2; ++n) acc[a][b][m][n] = (f32x4){0.f, 0.f, 0.f, 0.f};
        cur = nxt; cA = nA; cB = nB; ++ui;
        if constexpr (ALIGN_EPI) { if (wr == 1) PG8_BAR; }
    }
    PG8_WAIT_V(0);
    if constexpr (!ALIGN_EPI) { if (wr == 0) PG8_BAR; }
    PG8_BAR;
#undef PG8_AVOFF
#undef PG8_SA
#undef PG8_SB
#undef PG8_STAGE
#undef PG8_LDA
#undef PG8_LDB
#undef PG8_MMA
#undef PG8_WAIT_V
#undef PG8_WAIT_L
#undef PG8_BAR
#undef PG8_SCHED
}

struct PlainSched {
    const bf16_t* A; const bf16_t* Bt; int K; int nM, nN, nwg, G, c;
    __device__ void init(const bf16_t* A_, const bf16_t* Bt_, int Mr, int N, int K_, int G_, int c_) { A = A_; Bt = Bt_; K = K_; nM = Mr / BM; nN = N / BM; nwg = nM * nN; G = G_; c = c_; }
    __device__ __forceinline__ bool next(int i, Unit& u) const {
        const long L = (long)i * G + c; if (L >= nwg) return false;
        int wgid = (int)L; { const int q = nwg / NXCD, r = nwg % NXCD, xcd = wgid % NXCD, off = wgid / NXCD; wgid = (xcd < r ? xcd * (q + 1) : r * (q + 1) + (xcd - r) * q) + off; }
        const int nig = WGM * nN, gid = wgid / nig, fm = gid * WGM, gsz = (nM - fm) < WGM ? (nM - fm) : WGM;
        const int pm = fm + ((wgid % nig) % gsz), pn = (wgid % nig) / gsz;
        u.arow = pm * BM; u.brow = pn * BM; u.crow = pm * BM; u.ccol = pn * BM; u.e = 0; u.aux = 0; return true;
    }
    __device__ __forceinline__ const char* abase(const Unit& u) const { return (const char*)A + (size_t)u.arow * K * 2; }
    __device__ __forceinline__ const char* bbase(const Unit& u) const { return (const char*)Bt + (size_t)u.brow * K * 2; }
    __device__ __forceinline__ void avoff(const Unit&, const int (&R)[2], const int (&C)[2], unsigned (&v)[2][2]) const {
#pragma unroll
        for (int h = 0; h < 2; ++h)
#pragma unroll
            for (int i = 0; i < 2; ++i) v[h][i] = (unsigned)((h * HALF + R[i]) * K + C[i]) * 2u;
    }
};
template <class Sd> struct RepSched { Sd S;
    __device__ __forceinline__ bool next(int i, Unit& u) const { return S.next(i >> 1, u); }
    __device__ __forceinline__ const char* abase(const Unit& u) const { return S.abase(u); }
    __device__ __forceinline__ const char* bbase(const Unit& u) const { return S.bbase(u); }
    __device__ __forceinline__ void avoff(const Unit& u, const int (&R)[2], const int (&C)[2], unsigned (&v)[2][2]) const { S.avoff(u, R, C, v); }
};
}

constexpr size_t MiB = 1u << 20;
constexpr size_t WS_CTL = 0, CTL_ZERO_BYTES = 64 * 1024;
constexpr size_t WS_LDEST = 1 * MiB;
constexpr size_t WS_LIST = 9 * MiB;
constexpr size_t WS_LISTW = 17 * MiB;
constexpr size_t WS_STATS = 25 * MiB;
constexpr size_t WS_WR = 29 * MiB;
constexpr size_t WS_WIN = 30 * MiB;
constexpr size_t WS_WGLU = 34 * MiB;
constexpr size_t WS_WOUT = 35 * MiB;
constexpr size_t WS_WPG = 37 * MiB;
constexpr size_t WS_WGU = 39 * MiB;
constexpr size_t WS_WD = 104 * MiB;
constexpr size_t WS_WPLE = 136 * MiB + 512 * 1024;
constexpr size_t WS_B = 137 * MiB;
constexpr size_t WS_C = 201 * MiB;
constexpr size_t WS_D = 297 * MiB;
constexpr size_t WS_E = 361 * MiB;
constexpr size_t WS_BASE = WS_B;
constexpr size_t WS_HID = 201 * MiB;
constexpr size_t WS_SLAB0 = 30 * MiB, WS_SLAB1 = 377 * MiB;
constexpr size_t OUT_PB = 64 * MiB;
constexpr size_t OUT_GS = 16 * MiB;
constexpr size_t WS_H8 = 449 * MiB;
constexpr size_t WS_END = 512 * MiB;
constexpr int TQ_TOK = 8192, LCAP = 8192;
static_assert(WS_WD + (size_t)65 * 1024 * 256 * 2 <= WS_WPLE && WS_HID + (size_t)360448 * 512 <= WS_SLAB1 && WS_SLAB1 + (size_t)TQ_TOK * 9 * 1024 <= WS_END && WS_SLAB0 + (size_t)TQ_TOK * 9 * 1024 <= WS_WD, "ws map");
constexpr int CW_CNT = 64;
constexpr int CW_BAR = 1024;

constexpr int RING_OFF = 0, RING_BYTES = 131072;
constexpr int LDSCTL_OFF = RING_BYTES;
constexpr int MISC_OFF = LDSCTL_OFF;
constexpr int TAB_OFF = LDSCTL_OFF + 128;
constexpr int TST_OFF = LDSCTL_OFF + 512;
constexpr int IDX_OFF = LDSCTL_OFF + 2048;
constexpr int CNTL_OFF = LDSCTL_OFF + 2048 + 12 * 1024;
constexpr int LDS_BYTES = 147456;
static_assert(IDX_OFF + 12 * 1024 <= CNTL_OFF && CNTL_OFF + 1024 <= LDS_BYTES, "LDS map");

constexpr int NWAVES = 8;
#define RLX_AGENT __ATOMIC_RELAXED, __HIP_MEMORY_SCOPE_AGENT
#define LDS_WAIT() asm volatile("s_waitcnt lgkmcnt(0)" ::: "memory")
#define VM_WAIT() asm volatile("s_waitcnt vmcnt(0)" ::: "memory")
#define LDS_BARRIER() do { asm volatile("s_waitcnt lgkmcnt(0)" ::: "memory"); __builtin_amdgcn_s_barrier(); asm volatile("" ::: "memory"); } while (0)

#define XB_TMO      128
#define XB_XCNT(j)  (256  + 64 * (j))
#define XB_XSUB(j)  (1280 + 64 * (j))
#define XB_XGEN(j)  (2304 + 64 * (j))
#define XB_TOP      3328
#define XB_TOPGEN   3392
#define XCD_BAR_WORDS 3456
#define XB_SPIN_CAP (1u << 18)
__device__ __forceinline__ unsigned xb_ld(unsigned* p)              { return __hip_atomic_load(p, __ATOMIC_RELAXED, __HIP_MEMORY_SCOPE_AGENT); }
__device__ __forceinline__ unsigned xb_add(unsigned* p, unsigned v) { return __hip_atomic_fetch_add(p, v, __ATOMIC_RELAXED, __HIP_MEMORY_SCOPE_AGENT); }
__device__ __forceinline__ unsigned xb_xcc_id() { return (unsigned)__builtin_amdgcn_s_getreg((3 << 11) | 20) & 0xFu; }
#define XB_SPIN(cond, bar) do { unsigned _sp = 0; while (cond) { __builtin_amdgcn_s_sleep(1); \
    if ((++_sp & 255u) == 0u) { if (xb_ld(&(bar)[XB_TMO])) break; if (_sp > XB_SPIN_CAP) { atomicAdd(&(bar)[XB_TMO], 1u); break; } } } } while (0)
struct XcdBarrier { unsigned* bar; unsigned x; volatile LAS unsigned* st; };
__device__ __forceinline__ XcdBarrier xcd_barrier_post(unsigned* bar, volatile LAS unsigned* st) {
    XcdBarrier b; b.bar = bar; b.x = xb_xcc_id(); b.st = st;
    if (threadIdx.x == 0) (void)xb_add(&bar[XB_XCNT(b.x)], 1u);
    return b;
}
__device__ __forceinline__ void xcd_barrier_complete(unsigned* bar, unsigned x, unsigned& nloc, unsigned& nx) {
    const unsigned G = gridDim.x * gridDim.y * gridDim.z;
    unsigned sum, cnt, mine, sp = 0u;
    for (;;) {
        sum = 0u; cnt = 0u; mine = 0u;
#pragma unroll
        for (unsigned j = 0; j < 16; ++j) { const unsigned c = xb_ld(&bar[XB_XCNT(j)]); sum += c; cnt += (c > 0u) ? 1u : 0u; mine = (j == x) ? c : mine; }
        if (sum == G) break;
        __builtin_amdgcn_s_sleep(1);
        if ((++sp & 255u) == 0u) { if (xb_ld(&bar[XB_TMO])) break; if (sp > XB_SPIN_CAP) { atomicAdd(&bar[XB_TMO], 1u); break; } }
    }
    nloc = mine > 0u ? mine : 1u; nx = cnt > 0u ? cnt : 1u;
}
__device__ __forceinline__ void xcd_barrier(const XcdBarrier& b, const int wave) {
    asm volatile("s_waitcnt vmcnt(0)" ::: "memory");
    __syncthreads();
    if (wave == 0 && hw_lane() == 0) {
        unsigned* bar = b.bar;
        __builtin_amdgcn_s_waitcnt(0);
        unsigned nloc = b.st[0], nx = b.st[1];
        if (nloc == 0u) { xcd_barrier_complete(bar, b.x, nloc, nx); b.st[0] = nloc; b.st[1] = nx; }
        const unsigned old = xb_add(&bar[XB_XSUB(b.x)], 1u);
        const unsigned gen = old / nloc;
        if (old + 1u == (gen + 1u) * nloc) {
            __builtin_amdgcn_fence(__ATOMIC_RELEASE, "agent");
            asm volatile("s_waitcnt vmcnt(0)" ::: "memory");
            (void)xb_add(&bar[XB_TOP], 1u);
        }
        XB_SPIN(xb_ld(&bar[XB_TOP]) < (gen + 1u) * nx, bar);
        __builtin_amdgcn_fence(__ATOMIC_ACQUIRE, "agent");
        asm volatile("s_waitcnt vmcnt(0)" ::: "memory");
    }
    __syncthreads();
}

template <class Fn> __device__ __forceinline__ void xcd_barrier_with(const XcdBarrier& b, const int wave, Fn&& fn) {
    asm volatile("s_waitcnt vmcnt(0)" ::: "memory");
    __syncthreads();
    if (wave == 0 && hw_lane() == 0) {
        unsigned* bar = b.bar;
        __builtin_amdgcn_s_waitcnt(0);
        unsigned nloc = b.st[0], nx = b.st[1];
        if (nloc == 0u) { xcd_barrier_complete(bar, b.x, nloc, nx); b.st[0] = nloc; b.st[1] = nx; }
        const unsigned old = xb_add(&bar[XB_XSUB(b.x)], 1u);
        const unsigned gen = old / nloc;
        if (old + 1u == (gen + 1u) * nloc) {
            __builtin_amdgcn_fence(__ATOMIC_RELEASE, "agent");
            asm volatile("s_waitcnt vmcnt(0)" ::: "memory");
            (void)xb_add(&bar[XB_TOP], 1u);
        }
        b.st[2] = (gen + 1u) * nx;
    }
    fn();
    if (wave == 0 && hw_lane() == 0) {
        unsigned* bar = b.bar; const unsigned target = b.st[2];
        XB_SPIN(xb_ld(&bar[XB_TOP]) < target, bar);
        __builtin_amdgcn_fence(__ATOMIC_ACQUIRE, "agent");
        asm volatile("s_waitcnt vmcnt(0)" ::: "memory");
    }
    __syncthreads();
}

struct Frame {
    LAS unsigned char* lds;
    volatile LAS unsigned* MISC;
    unsigned* ctl;
    int tid, lane, wave, vcu, G, wv0;
    float* out; unsigned char* ws;
};
struct Args { const float* in[28]; float* out; unsigned char* ws; int ph_lo, ph_hi; };
typedef __bf16 bf16x2_t __attribute__((ext_vector_type(2)));
__device__ __forceinline__ unsigned cvtpk(float lo, float hi) { f32x2 v = {lo, hi}; bf16x2_t b = __builtin_convertvector(v, bf16x2_t); return __builtin_bit_cast(unsigned, b); }
__device__ __forceinline__ u32x4 pack8(const f32x4 a, const f32x4 b) { u32x4 w; w.x = cvtpk(a[0], a[1]); w.y = cvtpk(a[2], a[3]); w.z = cvtpk(b[0], b[1]); w.w = cvtpk(b[2], b[3]); return w; }
__device__ __forceinline__ void unpack8(const u32x4 w, f32x4& a, f32x4& b) { a = (f32x4){bflo(w.x), bfhi(w.x), bflo(w.y), bfhi(w.y)}; b = (f32x4){bflo(w.z), bfhi(w.z), bflo(w.w), bfhi(w.w)}; }

using pg8::Unit;
typedef const f32x4 (&AccRef)[2][2][4][2];
#define EPI_ROWS_BEGIN _Pragma("unroll") for (int ai = 0; ai < 2; ++ai) _Pragma("unroll") for (int m = 0; m < 4; ++m) { const int rr = ai * 128 + wr * 64 + m * 16 + fr;
#define EPI_ROWS_END }
#define UF_PIECE(b_, g_, ks_, ch_, par_, hf_) ((size_t)((((((b_) * 32 + (g_)) * 32 + (ks_)) * 4 + ((ch_) >> 4)) * 64) + (((par_) * 2 + (hf_)) * 16 + ((ch_) & 15))))
__device__ __forceinline__ int g1_tok0(int pm) { return (pm >> 4) * SEQ + ((pm >> 2) & 3) * 1024 + (pm & 3) * 16; }
struct EpiQKVU {
    bf16_t* O;
    __device__ __forceinline__ void operator()(AccRef acc, const Unit& u, int wr, int wc, int fr, int fq) const {
        const int t = u.ccol >> 9, colt = u.ccol & 511; bf16_t* base = O + (size_t)t * M * 512; const float sc = ((t == 0) ? QSCALE : 1.f) * (G1_F8 ? 1.f / 32.f : 1.f);
        const int col0 = colt + wc * 32 + 8 * fq, pm = u.crow >> 8, tok0 = g1_tok0(pm);
        if (t == 3) {
            EPI_ROWS_BEGIN
                const int tt = (pm & 3) * 16 + (rr >> 4);
#pragma unroll
                for (int bj = 0; bj < 2; ++bj) { const int c = col0 + bj * 128;
                    *(u32x4*)(base + UF_PIECE(pm >> 4, c >> 4, tt >> 1, ((pm >> 2) & 3) * 16 + fr, tt & 1, (c >> 3) & 1) * 8) = pack8(acc[ai][bj][m][0] * sc, acc[ai][bj][m][1] * sc); }
            EPI_ROWS_END
            return; }
        EPI_ROWS_BEGIN
            bf16_t* rowp = base + (size_t)(tok0 + fr * 64 + (rr >> 4)) * 512 + col0;
#pragma unroll
            for (int bj = 0; bj < 2; ++bj) *(u32x4*)(rowp + bj * 128) = pack8(acc[ai][bj][m][0] * sc, acc[ai][bj][m][1] * sc);
        EPI_ROWS_END
    }
};
struct G1Sched { pg8::PlainSched P;
    __device__ __forceinline__ bool next(int i, Unit& u) const { return P.next(i, u); }
    __device__ __forceinline__ const char* abase(const Unit& u) const { return (const char*)P.A + (size_t)g1_tok0(u.arow >> 8) * P.K * 2; }
    __device__ __forceinline__ const char* bbase(const Unit& u) const { return P.bbase(u); }
    __device__ __forceinline__ void avoff(const Unit&, const int (&R)[2], const int (&C)[2], unsigned (&v)[2][2]) const {
#pragma unroll
        for (int h = 0; h < 2; ++h)
#pragma unroll
            for (int i = 0; i < 2; ++i) { const int r = h * pg8::HALF + R[i]; v[h][i] = (unsigned)(((r & 15) * 64 + (r >> 4)) * P.K + C[i]) * 2u; }
    }
};
__device__ __forceinline__ f32x4 vexp2(const f32x4 a) { return (f32x4){__builtin_amdgcn_exp2f(a[0]), __builtin_amdgcn_exp2f(a[1]), __builtin_amdgcn_exp2f(a[2]), __builtin_amdgcn_exp2f(a[3])}; }
__device__ __forceinline__ f32x4 vrcp(const f32x4 a) { return (f32x4){__builtin_amdgcn_rcpf(a[0]), __builtin_amdgcn_rcpf(a[1]), __builtin_amdgcn_rcpf(a[2]), __builtin_amdgcn_rcpf(a[3])}; }
__device__ __forceinline__ f32x4 vsigmoid_scaled(const f32x4 a, const float c) { return vrcp(vexp2(a * (-c * LOG2E)) + 1.f); }
struct EpiGLU {
    const bf16_t* Y; const float* bias; bf16_t* MIX;
    __device__ __forceinline__ void operator()(AccRef acc, const Unit& u, int wr, int wc, int fr, int fq) const {
        const int col0 = u.ccol + wc * 64 + 16 * fq;
        f32x4 bv[2][2];
#pragma unroll
        for (int bj = 0; bj < 2; ++bj) { bv[bj][0] = *(const f32x4*)(bias + col0 + bj * 8); bv[bj][1] = *(const f32x4*)(bias + col0 + bj * 8 + 4); }
        u32x4 yw[2][4][2];
#pragma unroll
        for (int ai = 0; ai < 2; ++ai)
#pragma unroll
            for (int m = 0; m < 4; ++m)
#pragma unroll
                for (int bj = 0; bj < 2; ++bj) yw[ai][m][bj] = __builtin_nontemporal_load((const u32x4*)(Y + (size_t)(u.crow + ai * 128 + wr * 64 + m * 16 + fr) * 512 + col0 + bj * 8));
        __builtin_amdgcn_sched_barrier(0);
        EPI_ROWS_BEGIN
            const size_t row = (size_t)(u.crow + rr); u32x4 o; f32x4 keep[2][2];
#pragma unroll
            for (int bj = 0; bj < 2; ++bj) {
                f32x4 y0, y1; unpack8(yw[ai][m][bj], y0, y1);
                f32x4 a0 = acc[ai][bj][m][0] + bv[bj][0], a1 = acc[ai][bj][m][1] + bv[bj][1];
                a0 = y0 * vsigmoid_scaled(a0, 1.f); a1 = y1 * vsigmoid_scaled(a1, 1.f); keep[bj][0] = a0; keep[bj][1] = a1;
                int p0 = __builtin_amdgcn_cvt_pk_fp8_f32(a0[0], a0[1], 0, false); p0 = __builtin_amdgcn_cvt_pk_fp8_f32(a0[2], a0[3], p0, true); int p1 = __builtin_amdgcn_cvt_pk_fp8_f32(a1[0], a1[1], 0, false); p1 = __builtin_amdgcn_cvt_pk_fp8_f32(a1[2], a1[3], p1, true);
                if (bj == 0) { o.x = (unsigned)p0; o.y = (unsigned)p1; } else { o.z = (unsigned)p0; o.w = (unsigned)p1; }
            }
            if (WOUT_F8) *(u32x4*)((unsigned char*)MIX + row * 1024 + 512 + col0) = o;
            else { *(u32x4*)(MIX + row * 1024 + 512 + col0) = pack8(keep[0][0], keep[0][1]); *(u32x4*)(MIX + row * 1024 + 512 + col0 + 8) = pack8(keep[1][0], keep[1][1]); }
        EPI_ROWS_END
    }
};
struct EpiWout {
    const float* X; bf16_t* PRE; f32x2* STATS;
    __device__ __forceinline__ void operator()(AccRef acc, const Unit& u, int wr, int wc, int fr, int fq) const {
        const int col0 = u.ccol + wc * 32 + 8 * fq; const float asc = WOUT_F8 ? 1.f / 32.f : 1.f;
#pragma unroll
        for (int ai = 0; ai < 2; ++ai) {
            f32x4 xv[4][2][2];
#pragma unroll
            for (int m = 0; m < 4; ++m)
#pragma unroll
                for (int bj = 0; bj < 2; ++bj) { const float* xp = X + (size_t)(u.crow + ai * 128 + wr * 64 + m * 16 + fr) * 1024 + col0 + bj * 128; xv[m][bj][0] = __builtin_nontemporal_load((const f32x4*)xp); xv[m][bj][1] = __builtin_nontemporal_load((const f32x4*)(xp + 4)); }
            __builtin_amdgcn_sched_barrier(0);
#pragma unroll
            for (int m = 0; m < 4; ++m) { const size_t row = (size_t)(u.crow + ai * 128 + wr * 64 + m * 16 + fr); float s = 0.f, q = 0.f;
#pragma unroll
                for (int bj = 0; bj < 2; ++bj) {
                    const f32x4 v0 = xv[m][bj][0] * ALPHA + acc[ai][bj][m][0] * asc, v1 = xv[m][bj][1] * ALPHA + acc[ai][bj][m][1] * asc;
                    *(u32x4*)(PRE + row * 1024 + col0 + bj * 128) = pack8(v0, v1);
                    s += (v0[0] + v0[1]) + (v0[2] + v0[3]) + (v1[0] + v1[1]) + (v1[2] + v1[3]);
                    q += (v0[0] * v0[0] + v0[1] * v0[1]) + (v0[2] * v0[2] + v0[3] * v0[3]) + (v1[0] * v1[0] + v1[1] * v1[1]) + (v1[2] * v1[2] + v1[3] * v1[3]);
                }
                s += __shfl_xor(s, 16); s += __shfl_xor(s, 32); q += __shfl_xor(q, 16); q += __shfl_xor(q, 32);
                if (fq == 0) STATS[row * 16 + (u.ccol >> 8) * 4 + wc] = (f32x2){s, q}; }
        }
    }
};
constexpr float WSC = 1.f / 32.f;
struct EpiGU {
    unsigned char* HID;
    __device__ __forceinline__ void operator()(AccRef acc, const Unit& u, int wr, int wc, int fr, int fq) const {
        const int col0 = u.ccol + wc * 32 + 8 * fq;
        EPI_ROWS_BEGIN
            const f32x4 h0 = (acc[ai][0][m][0] * acc[ai][1][m][0]) * (vsigmoid_scaled(acc[ai][0][m][0], WSC) * (WSC * WSC));
            const f32x4 h1 = (acc[ai][0][m][1] * acc[ai][1][m][1]) * (vsigmoid_scaled(acc[ai][0][m][1], WSC) * (WSC * WSC));
            int p0 = __builtin_amdgcn_cvt_pk_fp8_f32(h0[0], h0[1], 0, false); p0 = __builtin_amdgcn_cvt_pk_fp8_f32(h0[2], h0[3], p0, true);
            int p1 = __builtin_amdgcn_cvt_pk_fp8_f32(h1[0], h1[1], 0, false); p1 = __builtin_amdgcn_cvt_pk_fp8_f32(h1[2], h1[3], p1, true);
            *(u32x2*)(HID + (size_t)(u.crow + rr) * 256 + col0) = (u32x2){(unsigned)p0, (unsigned)p1};
        EPI_ROWS_END
    }
};
struct EpiDown {
    unsigned char* SLAB; LAS const int* dw;
    __device__ __forceinline__ void operator()(AccRef acc, const Unit& u, int wr, int wc, int fr, int fq) const {
        const int col0 = u.ccol + wc * 64 + 16 * fq;
        EPI_ROWS_BEGIN
            const int dest = dw[(u.crow * 256 + rr) * 2]; const float w = __int_as_float(dw[(u.crow * 256 + rr) * 2 + 1]) * (16.f * WSC);
            if (dest >= 0) { u32x4 o;
#pragma unroll
                for (int bj = 0; bj < 2; ++bj) { const f32x4 a = acc[ai][bj][m][0] * w, c = acc[ai][bj][m][1] * w;
                    int p0 = __builtin_amdgcn_cvt_pk_fp8_f32(a[0], a[1], 0, false); p0 = __builtin_amdgcn_cvt_pk_fp8_f32(a[2], a[3], p0, true);
                    int p1 = __builtin_amdgcn_cvt_pk_fp8_f32(c[0], c[1], 0, false); p1 = __builtin_amdgcn_cvt_pk_fp8_f32(c[2], c[3], p1, true);
                    if (bj == 0) { o.x = (unsigned)p0; o.y = (unsigned)p1; } else { o.z = (unsigned)p0; o.w = (unsigned)p1; } }
                *(u32x4*)(SLAB + (size_t)dest * 1024 + col0) = o; }
        EPI_ROWS_END
    }
};
struct EpiGS {
    unsigned char* GS;
    __device__ __forceinline__ void operator()(AccRef acc, const Unit& u, int wr, int wc, int fr, int fq) const {
        const int col0 = u.ccol + wc * 64 + 16 * fq;
        EPI_ROWS_BEGIN
            u32x4 o;
#pragma unroll
            for (int bj = 0; bj < 2; ++bj) { const f32x4 a0 = vsigmoid_scaled(acc[ai][bj][m][0], WSC), a1 = vsigmoid_scaled(acc[ai][bj][m][1], WSC);
                int p0 = __builtin_amdgcn_cvt_pk_fp8_f32(a0[0], a0[1], 0, false); p0 = __builtin_amdgcn_cvt_pk_fp8_f32(a0[2], a0[3], p0, true); int p1 = __builtin_amdgcn_cvt_pk_fp8_f32(a1[0], a1[1], 0, false); p1 = __builtin_amdgcn_cvt_pk_fp8_f32(a1[2], a1[3], p1, true);
                if (bj == 0) { o.x = (unsigned)p0; o.y = (unsigned)p1; } else { o.z = (unsigned)p0; o.w = (unsigned)p1; } }
            *(u32x4*)(GS + (size_t)(u.crow + rr) * 1024 + col0) = o;
        EPI_ROWS_END
    }
};
struct EpiBase {
    const unsigned char* GSB; unsigned char* T;
    __device__ __forceinline__ void operator()(AccRef acc, const Unit& u, int wr, int wc, int fr, int fq) const {
        const int col0 = u.ccol + wc * 64 + 16 * fq; const float tsc = PLE_F8 ? 16.f / 32.f : 16.f;
#pragma unroll
        for (int ai = 0; ai < 2; ++ai) {
            u32x4 gw[4];
#pragma unroll
            for (int m = 0; m < 4; ++m) gw[m] = __builtin_nontemporal_load((const u32x4*)(GSB + (size_t)(u.crow + ai * 128 + wr * 64 + m * 16 + fr) * 1024 + col0));
            __builtin_amdgcn_sched_barrier(0);
#pragma unroll
            for (int m = 0; m < 4; ++m) { u32x4 o;
#pragma unroll
                for (int bj = 0; bj < 2; ++bj) { const unsigned gx = bj == 0 ? gw[m].x : gw[m].z, gy = bj == 0 ? gw[m].y : gw[m].w;
                    const f32x2 a = __builtin_amdgcn_cvt_pk_f32_fp8((int)gx, false), b = __builtin_amdgcn_cvt_pk_f32_fp8((int)gx, true), c = __builtin_amdgcn_cvt_pk_f32_fp8((int)gy, false), d = __builtin_amdgcn_cvt_pk_f32_fp8((int)gy, true);
                    const f32x4 o0 = acc[ai][bj][m][0] * ((f32x4){a[0], a[1], b[0], b[1]} * tsc), o1 = acc[ai][bj][m][1] * ((f32x4){c[0], c[1], d[0], d[1]} * tsc);
                    int p0 = __builtin_amdgcn_cvt_pk_fp8_f32(o0[0], o0[1], 0, false); p0 = __builtin_amdgcn_cvt_pk_fp8_f32(o0[2], o0[3], p0, true); int p1 = __builtin_amdgcn_cvt_pk_fp8_f32(o1[0], o1[1], 0, false); p1 = __builtin_amdgcn_cvt_pk_fp8_f32(o1[2], o1[3], p1, true);
                    if (bj == 0) { o.x = (unsigned)p0; o.y = (unsigned)p1; } else { o.z = (unsigned)p0; o.w = (unsigned)p1; } }
                *(u32x4*)(T + (size_t)(u.crow + ai * 128 + wr * 64 + m * 16 + fr) * 1024 + col0) = o; }
        }
    }
};

__device__ __forceinline__ void moe_prefix(Frame& F) {
    LAS int* tst = (LAS int*)(F.lds + TST_OFF);
    __syncthreads();
    if (F.wave == 0) {
        int c[5], tot = 0;
#pragma unroll
        for (int j = 0; j < 5; ++j) { const int i = 5 * F.lane + j, q = i / 65, e = i % 65; int cn = 0; if (i < 260 && e < 64) { cn = (int)__hip_atomic_load(F.ctl + CW_CNT + q * 64 + e, RLX_AGENT); ((LAS int*)(F.lds + CNTL_OFF))[q * 64 + e] = cn; }
            c[j] = i < 260 ? (e < 64 ? (cn + 255) >> 8 : 32) : 0; tot += c[j]; }
        int inc = tot;
#pragma unroll
        for (int o = 1; o < 64; o <<= 1) { const int v = __shfl_up(inc, o); if (F.lane >= o) inc += v; }
        int run = inc - tot;
#pragma unroll
        for (int j = 0; j < 5; ++j) { const int i = 5 * F.lane + j; if (i < 260) tst[i] = run; run += c[j]; }
        if (F.lane == 63) tst[260] = inc;
    }
    __syncthreads();
}
template <int MODE> __device__ __forceinline__ void moe_units(Frame& F, int tq) {
    LAS int* tst = (LAS int*)(F.lds + TST_OFF); LAS int* tab = (LAS int*)(F.lds + TAB_OFF); LAS int* idx = (LAS int*)(F.lds + IDX_OFF);
    const int* LIST = (const int*)(F.ws + WS_LIST); const int* LDEST = (const int*)(F.ws + WS_LDEST); const float* LISTW = (const float*)(F.ws + WS_LISTW);
    if (MODE == 0 || !ONE_LAUNCH) moe_prefix(F); else __syncthreads();
    const int tile0 = MODE == 0 ? 0 : tst[tq * 65], ntile = MODE == 0 ? tst[260] : tst[tq * 65 + 65] - tile0, nunit = MODE == 0 ? 2 * ntile : 4 * ntile;
    constexpr int CAP = MODE == 0 ? 12 : 6;
    int n = (nunit - F.vcu + F.G - 1) / F.G; n = n < 0 ? 0 : (n > CAP ? CAP : n);
    if (F.tid < 260) { const int lo = tst[F.tid], hi = tst[F.tid + 1];
#pragma unroll
        for (int s = 0; s < CAP; ++s) { const int L = s * F.G + F.vcu, tile = tile0 + (MODE == 0 ? (L >> 1) : (L >> 2));
            if (s < n && lo <= tile && tile < hi) { LAS int* t = tab + 4 + 6 * s; t[0] = F.tid % 65; t[1] = tile - lo; t[2] = tile; t[3] = MODE == 0 ? (L & 1) : (L & 3); t[4] = F.tid / 65; } } }
    if (F.tid == 0) { tab[0] = n; tab[1] = nunit; }
    __syncthreads();
    for (int it = F.tid; it < n * 256; it += 512) { const int s = it >> 8, r = it & 255; const int e = tab[4 + 6 * s], ti = tab[5 + 6 * s], q = tab[8 + 6 * s]; const int p = ti * 256 + r;
        if (MODE == 0) { int v;
            if (e < 64) { const int cnt = ((LAS const int*)(F.lds + CNTL_OFF))[q * 64 + e]; v = p < cnt ? __builtin_nontemporal_load(LIST + (size_t)(q * 64 + e) * LCAP + p) : q * TQ_TOK; }
            else v = q * TQ_TOK + p;
            idx[it] = v;
        } else { int dest = p * 9 + 8; float w = 1.f;
            if (e < 64) { const int cnt = ((LAS const int*)(F.lds + CNTL_OFF))[q * 64 + e]; const size_t li = (size_t)(q * 64 + e) * LCAP + (p < cnt ? p : 0); dest = p < cnt ? __builtin_nontemporal_load(LDEST + li) : -1; w = __builtin_nontemporal_load(LISTW + li); }
            idx[it * 2] = dest; idx[it * 2 + 1] = __float_as_int(w); } }
    __syncthreads();
}
struct GUSched {
    const bf16_t* H; const bf16_t* W; LAS const int* tab; LAS const int* idx;
    __device__ __forceinline__ bool next(int i, Unit& u) const { if (i >= tab[0]) return false; u.e = tab[4 + 6 * i]; const int tile = tab[6 + 6 * i], pn = tab[7 + 6 * i];
        u.aux = i; u.arow = 0; u.crow = tile * 256; u.ccol = pn * 128; u.brow = u.e * 512 + pn * 256; return true; }
    __device__ __forceinline__ const char* abase(const Unit&) const { return (const char*)H; }
    __device__ __forceinline__ const char* bbase(const Unit& u) const { return (const char*)W + (size_t)u.brow * 512 * 2; }
    __device__ __forceinline__ void avoff(const Unit& u, const int (&R)[2], const int (&C)[2], unsigned (&v)[2][2]) const {
#pragma unroll
        for (int h = 0; h < 2; ++h)
#pragma unroll
            for (int i = 0; i < 2; ++i) v[h][i] = (unsigned)(idx[u.aux * 256 + h * 128 + R[i]] * 512 + C[i]) * 2u;
    }
};
struct DownSched {
    const unsigned char* HID; const unsigned char* W; LAS const int* tab;
    __device__ __forceinline__ bool next(int i, Unit& u) const { if (i >= tab[0]) return false; u.e = tab[4 + 6 * i]; u.aux = tab[5 + 6 * i]; const int tile = tab[6 + 6 * i], pn = tab[7 + 6 * i];
        u.arow = tile * 256; u.ccol = pn * 256; u.brow = u.e * 1024 + pn * 256; u.crow = i; return true; }
    __device__ __forceinline__ const char* abase(const Unit& u) const { return (const char*)HID + (size_t)u.arow * 256; }
    __device__ __forceinline__ const char* bbase(const Unit& u) const { return (const char*)W + (size_t)u.brow * 256; }
    __device__ __forceinline__ void avoff(const Unit&, const int (&R)[2], const int (&C)[2], unsigned (&v)[2][2]) const {
#pragma unroll
        for (int h = 0; h < 2; ++h)
#pragma unroll
            for (int i = 0; i < 2; ++i) v[h][i] = (unsigned)((h * 128 + R[i]) * 128 + C[i]) * 2u;
    }
};

#ifndef G1_F8
#define G1_F8 1
#endif
struct TrItem { const float* W; bf16_t* WT; int K, N, destrow0, k0, n0, f8; };
__device__ __forceinline__ void tr_load(const TrItem& it, f32x4 (&tv)[8], int lane) {
#pragma unroll
    for (int j = 0; j < 8; ++j) tv[j] = __builtin_nontemporal_load((const f32x4*)(it.W + (size_t)(it.k0 + 8 * (lane >> 3) + j) * it.N + it.n0 + 4 * (lane & 7)));
}
__device__ __forceinline__ void tr_store(const TrItem& it, const f32x4 (&tv)[8], int lane) {
    if (it.f8) {
#pragma unroll
        for (int c = 0; c < 4; ++c) { int p0 = __builtin_amdgcn_cvt_pk_fp8_f32(tv[0][c] * 32.f, tv[1][c] * 32.f, 0, false); p0 = __builtin_amdgcn_cvt_pk_fp8_f32(tv[2][c] * 32.f, tv[3][c] * 32.f, p0, true);
            int p1 = __builtin_amdgcn_cvt_pk_fp8_f32(tv[4][c] * 32.f, tv[5][c] * 32.f, 0, false); p1 = __builtin_amdgcn_cvt_pk_fp8_f32(tv[6][c] * 32.f, tv[7][c] * 32.f, p1, true);
            *(u32x2*)((unsigned char*)it.WT + (size_t)(it.destrow0 + 4 * (lane & 7) + c) * it.K + it.k0 + 8 * (lane >> 3)) = (u32x2){(unsigned)p0, (unsigned)p1}; }
        return; }
#pragma unroll
    for (int c = 0; c < 4; ++c) { u32x4 o; o.x = pk2(tv[0][c], tv[1][c]); o.y = pk2(tv[2][c], tv[3][c]); o.z = pk2(tv[4][c], tv[5][c]); o.w = pk2(tv[6][c], tv[7][c]);
        *(u32x4*)(it.WT + (size_t)(it.destrow0 + 4 * (lane & 7) + c) * it.K + it.k0 + 8 * (lane >> 3)) = o; }
}
constexpr int I_IN = 16 * 64, I_GLU = 8 * 16, I_OUT = 16 * 32, I_PG = 16 * 32, I_PLE = 4 * 32, I_SMALL = I_IN + I_GLU + I_OUT + I_PG + I_PLE, I_G = 65 * 128, I_U = 65 * 128, I_D = 65 * 128, I_EXP = I_G + I_U + I_D;
__device__ __forceinline__ TrItem tr_decode_small(Frame& F, const Args& A, int r) {
    if (r < I_IN) return TrItem{A.in[2], (bf16_t*)(F.ws + WS_WIN), 1024, 2048, (r % 64) * 32, (r / 64) * 64, (r % 64) * 32, G1_F8}; r -= I_IN;
    if (r < I_GLU) return TrItem{A.in[11], (bf16_t*)(F.ws + WS_WGLU), 512, 512, (r % 16) * 32, (r / 16) * 64, (r % 16) * 32, 0}; r -= I_GLU;
    if (r < I_OUT) return TrItem{A.in[13], (bf16_t*)(F.ws + WS_WOUT), 1024, 1024, (r % 32) * 32, (r / 32) * 64, (r % 32) * 32, WOUT_F8}; r -= I_OUT;
    if (r < I_PG) return TrItem{A.in[25], (bf16_t*)(F.ws + WS_WPG), 1024, 1024, (r % 32) * 32, (r / 32) * 64, (r % 32) * 32, 1}; r -= I_PG;
    return TrItem{A.in[24], (bf16_t*)(F.ws + WS_WPLE), 256, 1024, (r % 32) * 32, (r / 32) * 64, (r % 32) * 32, PLE_F8};
}
__device__ __forceinline__ TrItem tr_decode_exp(Frame& F, const Args& A, int r) {
    bf16_t* WGU = (bf16_t*)(F.ws + WS_WGU); bf16_t* WD = (bf16_t*)(F.ws + WS_WD);
    if (r < I_G + I_U) { const bool up = r >= I_G; if (up) r -= I_G; const int e = r / 128, rr = r % 128, n0 = (rr % 8) * 32, k0 = (rr / 8) * 64;
        const float* src = e < 64 ? (up ? A.in[19] : A.in[18]) + (size_t)e * 1024 * 256 : (up ? A.in[22] : A.in[21]);
        return TrItem{src, (bf16_t*)((unsigned char*)WGU + (size_t)e * 512 * 1024), 1024, 256, (n0 >> 7) * 256 + (n0 & 127) + (up ? 128 : 0), k0, n0, 1}; }
    r -= I_G + I_U;
    { const int e = r / 128, rr = r % 128, n0 = (rr % 32) * 32, k0 = (rr / 32) * 64; const float* src = e < 64 ? A.in[20] + (size_t)e * 256 * 1024 : A.in[23];
        return TrItem{src, (bf16_t*)((unsigned char*)WD + (size_t)e * 1024 * 256), 256, 1024, n0, k0, n0, 1}; }
}
__device__ __forceinline__ int cvt_expert_burst(Frame& F, const Args& A, int cur, int nmax, int iend = I_EXP) {
    const int NGW = F.G * NWAVES;
    for (int k = 0; k < nmax && cur < iend; k += 2) {
        const bool two = (k + 1 < nmax) && (cur + NGW < iend);
        const TrItem a = tr_decode_exp(F, A, cur); f32x4 ta[8], tb[8]; tr_load(a, ta, F.lane);
        TrItem bI = a; if (two) { bI = tr_decode_exp(F, A, cur + NGW); tr_load(bI, tb, F.lane); }
        tr_store(a, ta, F.lane); if (two) tr_store(bI, tb, F.lane);
        cur += two ? 2 * NGW : NGW;
    }
    return cur;
}
#ifndef CVT_IN_GEMM
#define CVT_IN_GEMM 2
#endif
__device__ __forceinline__ int cvt_p2_end(const Frame& F) { if (CVT_IN_GEMM == 1) return 0; if (CVT_IN_GEMM == 0) return I_EXP; const int ngw = F.G * NWAVES, e = ((I_G + I_U + ngw - 1) / ngw) * ngw; return e < I_EXP ? e : I_EXP; }
struct CvtHook { Frame* F; const Args* A; int at, j_lo, j_hi;
    __device__ __forceinline__ void run() const { const int NGW = F->G * NWAVES; (void)cvt_expert_burst(*F, *A, F->vcu * NWAVES + F->wave + j_lo * NGW, j_hi - j_lo); }
    __device__ __forceinline__ void operator()(int ui, bool has_next) const { if (ui == at || (!has_next && ui < at)) run(); }
    __device__ __forceinline__ void none() const { run(); }
};
static_assert(9 * 256 * 8 >= I_G + I_U, "slices 9.. must be down-projection items (for the 256-block grid; other grids take the mixer-phase path)");
#ifndef P0_EXPERTS
#define P0_EXPERTS 0
#endif
__device__ __forceinline__ void p0_prologue(Frame& F, const Args& A) {
    const int gw = F.vcu * NWAVES + F.wave, NGW = F.G * NWAVES;
    if (gw < I_SMALL) {
        TrItem cur = tr_decode_small(F, A, gw); f32x4 tv[8], tn[8]; tr_load(cur, tv, F.lane);
        for (int it = gw; it < I_SMALL; it += NGW) {
            const bool has = it + NGW < I_SMALL; TrItem nxt = cur;
            if (has) { nxt = tr_decode_small(F, A, it + NGW); tr_load(nxt, tn, F.lane); }
            tr_store(cur, tv, F.lane);
            cur = nxt;
#pragma unroll
            for (int i = 0; i < 8; ++i) tv[i] = tn[i];
        }
    }
    if (P0_EXPERTS && gw < I_EXP) {
        TrItem cur = tr_decode_exp(F, A, gw); f32x4 tv[8], tn[8]; tr_load(cur, tv, F.lane);
        for (int it = gw; it < I_EXP; it += NGW) {
            const bool has = it + NGW < I_EXP; TrItem nxt = cur;
            if (has) { nxt = tr_decode_exp(F, A, it + NGW); tr_load(nxt, tn, F.lane); }
            tr_store(cur, tv, F.lane);
            cur = nxt;
#pragma unroll
            for (int i = 0; i < 8; ++i) tv[i] = tn[i];
        }
    }
    { const float* x = A.in[0]; bf16_t* XB = (bf16_t*)(F.ws + WS_B);
      for (int m = gw * 4; m < M; m += NGW * 4) { f32x4 v[4][4];
#pragma unroll
          for (int r = 0; r < 4; ++r)
#pragma unroll
              for (int j = 0; j < 4; ++j) v[r][j] = __builtin_nontemporal_load((const f32x4*)(x + (size_t)(m + r) * DM) + F.lane + 64 * j);
#pragma unroll
          for (int r = 0; r < 4; ++r)
#pragma unroll
              for (int j = 0; j < 4; ++j) { if (G1_F8) { int p0 = __builtin_amdgcn_cvt_pk_fp8_f32(v[r][j][0], v[r][j][1], 0, false); p0 = __builtin_amdgcn_cvt_pk_fp8_f32(v[r][j][2], v[r][j][3], p0, true); ((unsigned*)((unsigned char*)XB + (size_t)(m + r) * DM))[F.lane + 64 * j] = (unsigned)p0; }
                  else ((u32x2*)(XB + (size_t)(m + r) * DM))[F.lane + 64 * j] = (u32x2){pk2(v[r][j][0], v[r][j][1]), pk2(v[r][j][2], v[r][j][3])}; } } }
    { const float* wr = A.in[16]; bf16_t* WR = (bf16_t*)(F.ws + WS_WR);
      for (int i = (F.vcu * NWAVES + F.wave) * 64 + F.lane; i < 64 * 1024; i += NGW * 64) { const int e = i >> 10, k = i & 1023; const float v = wr[(size_t)k * 64 + e];
          const unsigned hb = f2bf(v); const float hf = __builtin_bit_cast(float, hb << 16); WR[i] = (bf16_t)hb; WR[65536 + i] = (bf16_t)f2bf(v - hf); } }
}

__device__ __forceinline__ void p2_attn_naive(Frame& F) {
    const bf16_t* Q = (const bf16_t*)(F.ws + WS_C); const bf16_t* Kb = Q + (size_t)M * 512; const bf16_t* Vb = Kb + (size_t)M * 512; bf16_t* MIX = (bf16_t*)(F.ws + WS_B);
    const int gw = F.vcu * NWAVES + F.wave, NGW = F.G * NWAVES, lane = F.lane;
    for (int item = gw; item < M * NH; item += NGW) {
        const int h = item & 7, bt = item >> 3, t = bt & (SEQ - 1), b = bt >> 12;
        const float q = bf2f(Q[(size_t)bt * 512 + h * 64 + lane]);
        const float slope2 = exp2f(-(float)(h + 1)) * LOG2E;
        float m = -INFINITY, l = 0.f, o = 0.f;
        for (int br = 0; br < 3; ++br) { const int dil = (br == 0) ? 1 : (br == 1 ? 4 : 16);
            for (int j = 0; j <= 128; ++j) { const int pos = t - j * dil; if (pos < 0) break;
                const size_t ro = (size_t)(b * SEQ + pos) * 512 + h * 64 + lane;
                const float kk = bf2f(Kb[ro]), vv = bf2f(Vb[ro]);
                const float s = wave_sum(q * kk) - slope2 * (float)(j * dil);
                const float mn = fmaxf(m, s); const float corr = exp2f(m - mn); const float pe = exp2f(s - mn);
                l = l * corr + pe; o = o * corr + pe * vv; m = mn; } }
        MIX[(size_t)bt * 1024 + h * 64 + lane] = (bf16_t)f2bf(o / l);
    }
}
__device__ __forceinline__ float gelu_tanh(float v) { return 0.5f * v * (1.f + tanhf(0.7978845608028654f * (v + 0.044715f * v * v * v))); }
__device__ __forceinline__ void p2_ssm_naive(Frame& F, const Args& A) {
    if (F.wave != 0) return;
    const bf16_t* U = (const bf16_t*)(F.ws + WS_D); bf16_t* Y = (bf16_t*)(F.ws + WS_D) + (size_t)M * 512;
    const float* lam_re = A.in[3]; const float* lam_im = A.in[4]; const float* log_dt = A.in[5]; const float* b_re = A.in[6]; const float* b_im = A.in[7];
    const float* c_re = A.in[8]; const float* c_im = A.in[9]; const float* d_skip = A.in[10];
    const int n = F.lane;
    for (int item = F.vcu; item < BATCH * NG; item += F.G) {
        const int b = item / NG, g = item % NG;
        const float lr = lam_re[g * NS + n], li = lam_im[g * NS + n], dt = expf(log_dt[g]);
        const float er = expf(lr * dt); const float ar = er * cosf(li * dt), ai = er * sinf(li * dt);
        const float den = lr * lr + li * li;
        const float gr = ((ar - 1.f) * lr + ai * li) / den, gi = (ai * lr - (ar - 1.f) * li) / den;
        float bbr[16], bbi[16], cr[16], ci[16];
#pragma unroll
        for (int c = 0; c < 16; ++c) { const float br = b_re[(g * NS + n) * GC + c], bi = b_im[(g * NS + n) * GC + c];
            bbr[c] = gr * br - gi * bi; bbi[c] = gr * bi + gi * br; cr[c] = c_re[(g * GC + c) * NS + n]; ci[c] = c_im[(g * GC + c) * NS + n]; }
        const float dsk = (n < 16) ? d_skip[g * GC + n] : 0.f;
        float sr = 0.f, si = 0.f;
        for (int t = 0; t < SEQ; ++t) {
            const u32x4* up = (const u32x4*)(U + (size_t)(b * SEQ + t) * 512 + g * GC);
            float u[16]; { f32x4 a0, a1, a2, a3; unpack8(up[0], a0, a1); unpack8(up[1], a2, a3);
#pragma unroll
                for (int c = 0; c < 4; ++c) { u[c] = a0[c]; u[4 + c] = a1[c]; u[8 + c] = a2[c]; u[12 + c] = a3[c]; } }
            float bur = 0.f, bui = 0.f;
#pragma unroll
            for (int c = 0; c < 16; ++c) { bur += bbr[c] * u[c]; bui += bbi[c] * u[c]; }
            const float nr = ar * sr - ai * si + bur, ni = ar * si + ai * sr + bui; sr = nr; si = ni;
            float my = 0.f, uc = 0.f;
#pragma unroll
            for (int c = 0; c < 16; ++c) { const float v = wave_sum(cr[c] * sr - ci[c] * si); if (n == c) { my = v; uc = u[c]; } }
            if (n < 16) Y[(size_t)(b * SEQ + t) * 512 + g * GC + n] = (bf16_t)f2bf(gelu_tanh(my + dsk * uc));
        }
    }
}

constexpr int P5_WB = 0, P5_BUF = 34816, P5_PART = 17408, P5_PITCH = 272, P5_SCR = 69632, P5_HIST = 104448, P5_BASEL = P5_HIST + 256, P5_RB = P5_HIST + 512, P5_GB = P5_HIST + 1024;
__device__ __forceinline__ void p5_ln_router(Frame& F, const Args& A, int fake) {
    const bf16_t* PRE = (const bf16_t*)F.out; const f32x4* STATS = (const f32x4*)(F.ws + WS_STATS); const float* gam = A.in[14]; const float* bet = A.in[15]; const float* rbias = A.in[17];
    bf16_t* H = (bf16_t*)(F.ws + WS_B); unsigned char* H8 = F.ws + WS_H8; const bf16_t* WR = (const bf16_t*)(F.ws + WS_WR);
    int* LIST = (int*)(F.ws + WS_LIST); float* LISTW = (float*)(F.ws + WS_LISTW); int* LDEST = (int*)(F.ws + WS_LDEST); int* CNT = (int*)(F.ctl + CW_CNT);
    LAS unsigned char* lds = F.lds; LAS float* scr = (LAS float*)(lds + P5_SCR) + F.wave * (16 * 68); LAS int* hist = (LAS int*)(lds + P5_HIST); LAS int* basel = (LAS int*)(lds + P5_BASEL); LAS float* rb = (LAS float*)(lds + P5_RB);
    const int tid = F.tid, lane = F.lane, fr = lane & 15, g = lane >> 4;
    for (int rg = F.vcu; rg < M / 128; rg += F.G) {
        const int row = rg * 128 + F.wave * 16 + fr;
        if (tid < 64) { hist[tid] = 0; rb[tid] = rbias[tid]; }
        { LAS float* gbl = (LAS float*)(lds + P5_GB); for (int i = tid; i < 256; i += 512) { *(LAS f32x4*)(gbl + 4 * i) = *(const f32x4*)(gam + 4 * i); *(LAS f32x4*)(gbl + 1024 + 4 * i) = *(const f32x4*)(bet + 4 * i); } }
        float mean, rstd;
        { const f32x4 p0 = __builtin_nontemporal_load(STATS + (size_t)row * 8 + 2 * g), p1 = __builtin_nontemporal_load(STATS + (size_t)row * 8 + 2 * g + 1); float s = (p0[0] + p0[2]) + (p1[0] + p1[2]), q = (p0[1] + p0[3]) + (p1[1] + p1[3]);
          s += __shfl_xor(s, 16); s += __shfl_xor(s, 32); q += __shfl_xor(q, 16); q += __shfl_xor(q, 32);
          mean = s * (1.f / DM); const float var = fmaxf(q * (1.f / DM) - mean * mean, 0.f); rstd = rsqrtf(var + LN_EPS); }
        u32x4 st[4];
#pragma unroll
        for (int i = 0; i < 4; ++i) { const int q = tid + 512 * i, part = q >> 10, rem = q & 1023, e = rem >> 4, pc = rem & 15; st[i] = *(const u32x4*)(WR + (size_t)part * 65536 + e * 1024 + pc * 8); }
        const bf16_t* prow = PRE + (size_t)row * DM + 8 * g;
        u32x4 pv[4], pn[4];
#pragma unroll
        for (int ks = 0; ks < 4; ++ks) pv[ks] = __builtin_nontemporal_load((const u32x4*)(prow + ks * 32));
#pragma unroll
        for (int i = 0; i < 4; ++i) { const int q = tid + 512 * i, part = q >> 10, rem = q & 1023, e = rem >> 4, pc = rem & 15; *(LAS u32x4*)(lds + P5_WB + part * P5_PART + e * P5_PITCH + pc * 16) = st[i]; }
        LDS_BARRIER();
        f32x4 acc[4];
#pragma unroll
        for (int nt = 0; nt < 4; ++nt) acc[nt] = (f32x4){0.f, 0.f, 0.f, 0.f};
        const LAS float* gbl = (const LAS float*)(lds + P5_GB) + 8 * g;
#pragma unroll 1
        for (int kc = 0; kc < 8; ++kc) {
            if (kc < 7) {
#pragma unroll
                for (int i = 0; i < 4; ++i) { const int q = tid + 512 * i, part = q >> 10, rem = q & 1023, e = rem >> 4, pc = rem & 15; st[i] = *(const u32x4*)(WR + (size_t)part * 65536 + e * 1024 + (kc + 1) * 128 + pc * 8); }
#pragma unroll
                for (int ks = 0; ks < 4; ++ks) pn[ks] = __builtin_nontemporal_load((const u32x4*)(prow + (kc + 1) * 128 + ks * 32));
            }
            LAS unsigned char* wb = lds + P5_WB + (kc & 1) * P5_BUF;
#pragma unroll
            for (int ks = 0; ks < 4; ++ks) {
                const int kk = kc * 128 + ks * 32 + 8 * g;
                f32x4 v0, v1; unpack8(pv[ks], v0, v1);
                const f32x4 g0 = *(const LAS f32x4*)(gbl + kc * 128 + ks * 32), g1 = *(const LAS f32x4*)(gbl + kc * 128 + ks * 32 + 4), b0 = *(const LAS f32x4*)(gbl + 1024 + kc * 128 + ks * 32), b1 = *(const LAS f32x4*)(gbl + 1024 + kc * 128 + ks * 32 + 4);
                v0 = (v0 - mean) * rstd * g0 + b0; v1 = (v1 - mean) * rstd * g1 + b1;
                const u32x4 hw = pack8(v0, v1);
                *(u32x4*)(H + (size_t)row * DM + kk) = hw;
                { int p0 = __builtin_amdgcn_cvt_pk_fp8_f32(v0[0], v0[1], 0, false); p0 = __builtin_amdgcn_cvt_pk_fp8_f32(v0[2], v0[3], p0, true); int p1 = __builtin_amdgcn_cvt_pk_fp8_f32(v1[0], v1[1], 0, false); p1 = __builtin_amdgcn_cvt_pk_fp8_f32(v1[2], v1[3], p1, true);
                  *(u32x2*)(H8 + (size_t)row * DM + kk) = (u32x2){(unsigned)p0, (unsigned)p1}; }
                f32x4 h0, h1; unpack8(hw, h0, h1);
                const u32x4 lw = pack8(v0 - h0, v1 - h1);
                const bf16x8 ahi = __builtin_bit_cast(bf16x8, hw), alo = __builtin_bit_cast(bf16x8, lw);
#pragma unroll
                for (int nt = 0; nt < 4; ++nt) {
                    const bf16x8 bhi = *(const LAS bf16x8*)(wb + (16 * nt + fr) * P5_PITCH + (ks * 32 + 8 * g) * 2);
                    const bf16x8 blo = *(const LAS bf16x8*)(wb + P5_PART + (16 * nt + fr) * P5_PITCH + (ks * 32 + 8 * g) * 2);
                    acc[nt] = __builtin_amdgcn_mfma_f32_16x16x32_bf16(ahi, bhi, acc[nt], 0, 0, 0);
                    acc[nt] = __builtin_amdgcn_mfma_f32_16x16x32_bf16(alo, bhi, acc[nt], 0, 0, 0);
                    acc[nt] = __builtin_amdgcn_mfma_f32_16x16x32_bf16(ahi, blo, acc[nt], 0, 0, 0);
                }
            }
            if (kc < 7) {
                LAS unsigned char* wn = lds + P5_WB + ((kc + 1) & 1) * P5_BUF;
#pragma unroll
                for (int i = 0; i < 4; ++i) { const int q = tid + 512 * i, part = q >> 10, rem = q & 1023, e = rem >> 4, pc = rem & 15; *(LAS u32x4*)(wn + part * P5_PART + e * P5_PITCH + pc * 16) = st[i]; }
#pragma unroll
                for (int i = 0; i < 4; ++i) pv[i] = pn[i];
            }
            LDS_BARRIER();
        }
        if (fake) continue;
#pragma unroll
        for (int nt = 0; nt < 4; ++nt)
#pragma unroll
            for (int r = 0; r < 4; ++r) scr[(4 * g + r) * 68 + 16 * nt + fr] = sigmoidf_(acc[nt][r]);
        __syncthreads();
        const int trow = lane >> 2, q4 = lane & 3;
        float sc[16], cand[16];
        { const LAS f32x4* sp = (const LAS f32x4*)(scr + trow * 68 + 16 * q4); const LAS f32x4* bp = (const LAS f32x4*)(rb + 16 * q4);
#pragma unroll
          for (int j = 0; j < 4; ++j) { const f32x4 s4 = sp[j], b4 = bp[j];
#pragma unroll
              for (int e = 0; e < 4; ++e) { sc[4 * j + e] = s4[e]; cand[4 * j + e] = s4[e] + b4[e]; } } }
        float gsc[2];
#pragma unroll
        for (int h = 0; h < 2; ++h) { float m1 = -INFINITY, m2 = -INFINITY;
#pragma unroll
            for (int j = 0; j < 8; ++j) { const float v = cand[8 * h + j]; const float lo_ = fminf(m1, v); m1 = fmaxf(m1, v); m2 = fmaxf(m2, lo_); }
            gsc[h] = m1 + m2; }
        float gs[8];
#pragma unroll
        for (int k = 0; k < 4; ++k) { gs[2 * k] = __shfl(gsc[0], (lane & ~3) + k); gs[2 * k + 1] = __shfl(gsc[1], (lane & ~3) + k); }
        unsigned gm = 0;
#pragma unroll
        for (int it = 0; it < 4; ++it) { float best = -INFINITY; int bi = 0;
#pragma unroll
            for (int gg = 0; gg < 8; ++gg) { const bool ok = !((gm >> gg) & 1u) && gs[gg] > best; best = ok ? gs[gg] : best; bi = ok ? gg : bi; }
            gm |= 1u << bi; }
#pragma unroll
        for (int j = 0; j < 16; ++j) if (!((gm >> (2 * q4 + (j >> 3))) & 1u)) cand[j] = -INFINITY;
        int idx[8]; float wv[8]; float wsum = 0.f;
#pragma unroll
        for (int it = 0; it < 8; ++it) {
            float bv = -INFINITY; int be = 0;
#pragma unroll
            for (int j = 0; j < 16; ++j) { const bool ok = cand[j] > bv; bv = ok ? cand[j] : bv; be = ok ? j : be; }
            be += 16 * q4;
#pragma unroll
            for (int o = 1; o < 4; o <<= 1) { const float ov = __shfl_xor(bv, o); const int oe = __shfl_xor(be, o); const bool take = (ov > bv) || (ov == bv && oe < be); bv = take ? ov : bv; be = take ? oe : be; }
            float mysc = 0.f;
#pragma unroll
            for (int j = 0; j < 16; ++j) { const bool hit = (be == 16 * q4 + j); cand[j] = hit ? -INFINITY : cand[j]; mysc = hit ? sc[j] : mysc; }
            const float w = __shfl(mysc, (lane & ~3) + (be >> 4));
            idx[it] = be; wv[it] = w; wsum += w;
        }
        int myrk[2];
#pragma unroll
        for (int h = 0; h < 2; ++h) { int e = 0;
#pragma unroll
            for (int it = 0; it < 8; ++it) if (it == 2 * q4 + h) e = idx[it];
            myrk[h] = __hip_atomic_fetch_add(hist + e, 1, __ATOMIC_RELAXED, __HIP_MEMORY_SCOPE_WORKGROUP); }
        __syncthreads();
        const int tq = rg >> 6;
        if (tid < 64) { const int c = hist[tid]; int t2 = tid; asm volatile("" : "+v"(t2)); basel[tid] = c ? atomicAdd(CNT + tq * 64 + t2, c) : 0; }
        __syncthreads();
        { const int tok = rg * 128 + F.wave * 16 + trow; const float inv = ROUTED_SCALE / wsum;
#pragma unroll
          for (int h = 0; h < 2; ++h) { int e = 0; float w = 0.f;
#pragma unroll
              for (int it = 0; it < 8; ++it) if (it == 2 * q4 + h) { e = idx[it]; w = wv[it]; }
              const int pos = basel[e] + myrk[h]; const size_t li = (size_t)(tq * 64 + e) * LCAP + pos;
              LIST[li] = tok; LISTW[li] = w * inv; LDEST[li] = (tok - tq * TQ_TOK) * 9 + 2 * q4 + h; } }
        __syncthreads();
    }
}

__device__ __forceinline__ void p_combine_ln2(Frame& F, const Args& A, int tq, const unsigned char* SLAB, int b0, int nb) {
    const bf16_t* BASE = (const bf16_t*)(F.ws + WS_BASE); const unsigned char* TPLE = F.ws + WS_H8; const float* gam = A.in[26]; const float* bet = A.in[27];
    if (F.vcu < b0 || F.vcu >= b0 + nb) return;
    const int gw = (F.vcu - b0) * NWAVES + F.wave, NGW = nb * NWAVES, lane = F.lane;
    f32x4 gg[4], bb[4];
#pragma unroll
    for (int j = 0; j < 4; ++j) { gg[j] = *(const f32x4*)(gam + 4 * lane + 256 * j); bb[j] = *(const f32x4*)(bet + 4 * lane + 256 * j); }
    for (int tl = gw; tl < TQ_TOK; tl += NGW) {
        const int t = tq * TQ_TOK + tl;
        unsigned w[10][4]; u32x2 bw[4];
#pragma unroll
        for (int j = 0; j < 4; ++j) bw[j] = __builtin_nontemporal_load((const u32x2*)(BASE + (size_t)t * 1024 + 4 * lane + 256 * j));
#pragma unroll
        for (int k = 0; k < 9; ++k)
#pragma unroll
            for (int j = 0; j < 4; ++j) w[k][j] = __builtin_nontemporal_load((const unsigned*)(SLAB + ((size_t)tl * 9 + k) * 1024 + 4 * lane + 256 * j));
#pragma unroll
        for (int j = 0; j < 4; ++j) w[9][j] = __builtin_nontemporal_load((const unsigned*)(TPLE + (size_t)t * 1024 + 4 * lane + 256 * j));
        f32x4 s4[4];
#pragma unroll
        for (int j = 0; j < 4; ++j) s4[j] = (f32x4){0.f, 0.f, 0.f, 0.f};
#pragma unroll
        for (int k = 0; k < 10; ++k)
#pragma unroll
            for (int j = 0; j < 4; ++j) { const f32x2 d0 = __builtin_amdgcn_cvt_pk_f32_fp8((int)w[k][j], false), d1 = __builtin_amdgcn_cvt_pk_f32_fp8((int)w[k][j], true); s4[j] += (f32x4){d0[0], d0[1], d1[0], d1[1]}; }
        f32x4 v[4];
#pragma unroll
        for (int j = 0; j < 4; ++j) v[j] = (f32x4){bflo(bw[j].x), bfhi(bw[j].x), bflo(bw[j].y), bfhi(bw[j].y)} * ALPHA + s4[j] * 0.0625f;
        float s = 0.f;
#pragma unroll
        for (int j = 0; j < 4; ++j) s += (v[j][0] + v[j][1]) + (v[j][2] + v[j][3]);
        const float mean = wave_sum(s) * (1.f / DM); float s2 = 0.f;
#pragma unroll
        for (int j = 0; j < 4; ++j) { v[j] = v[j] - mean; s2 += (v[j][0] * v[j][0] + v[j][1] * v[j][1]) + (v[j][2] * v[j][2] + v[j][3] * v[j][3]); }
        const float rstd = rsqrtf(wave_sum(s2) * (1.f / DM) + LN_EPS);
        float* op = F.out + (size_t)t * DM + 4 * lane;
#pragma unroll
        for (int j = 0; j < 4; ++j) *(f32x4*)(op + 256 * j) = v[j] * rstd * gg[j] + bb[j];
    }
}
__device__ __forceinline__ void p_convert_p(Frame& F, const Args& A) {
    const float* P = A.in[1]; bf16_t* PB = (bf16_t*)((char*)F.out + OUT_PB);
    const int gw = F.vcu * NWAVES + F.wave, NGW = F.G * NWAVES;
    for (int m = gw * 8; m < M; m += NGW * 8) { f32x4 v[8];
#pragma unroll
        for (int r = 0; r < 8; ++r) v[r] = __builtin_nontemporal_load((const f32x4*)(P + (size_t)(m + r) * PLE) + F.lane);
#pragma unroll
        for (int r = 0; r < 8; ++r) { if (PLE_F8) { int p0 = __builtin_amdgcn_cvt_pk_fp8_f32(v[r][0], v[r][1], 0, false); p0 = __builtin_amdgcn_cvt_pk_fp8_f32(v[r][2], v[r][3], p0, true); ((unsigned*)((unsigned char*)PB + (size_t)(m + r) * PLE))[F.lane] = (unsigned)p0; }
            else ((u32x2*)(PB + (size_t)(m + r) * PLE))[F.lane] = (u32x2){pk2(v[r][0], v[r][1]), pk2(v[r][2], v[r][3])}; } }
}

constexpr size_t WS_KT = WS_E, WS_EM = WS_E + 2 * MiB, WS_MY = WS_E + 12 * MiB, WS_A64 = WS_E + 22 * MiB;
constexpr int KT_ELEMS = 65 * 256;
__device__ __forceinline__ void p0_ssm_tables(Frame& F, const Args& A, int gi, int sl) {
    const float* lam_re = A.in[3]; const float* lam_im = A.in[4]; const float* log_dt = A.in[5]; const float* b_re = A.in[6]; const float* b_im = A.in[7];
    const float* c_re = A.in[8]; const float* c_im = A.in[9];
    LAS f32x2* POW = (LAS f32x2*)(F.lds);
    LAS f32x2* BB = (LAS f32x2*)(F.lds + 33280);
    LAS f32x2* CC = (LAS f32x2*)(F.lds + 33280 + 8192);
    const int tid = F.tid; const float dt = expf(log_dt[gi]);
    __syncthreads();
    for (int idx = tid; idx < 65 * 64; idx += 512) { const int d = idx >> 6, n = idx & 63; const float lr = lam_re[gi * NS + n], li = lam_im[gi * NS + n];
        const float mag = expf(lr * dt * (float)d); float sn, cs; sincosf(li * dt * (float)d, &sn, &cs); POW[idx] = (f32x2){mag * cs, mag * sn}; }
    for (int idx = tid; idx < 64 * 16; idx += 512) { const int n = idx >> 4, c = idx & 15; const float lr = lam_re[gi * NS + n], li = lam_im[gi * NS + n];
        const float er = expf(lr * dt); float sn, cs; sincosf(li * dt, &sn, &cs); const float ar = er * cs, ai = er * sn, den = lr * lr + li * li;
        const float gr = ((ar - 1.f) * lr + ai * li) / den, gim = (ai * lr - (ar - 1.f) * li) / den;
        const float br = b_re[(gi * NS + n) * GC + c], bi = b_im[(gi * NS + n) * GC + c];
        BB[idx] = (f32x2){gr * br - gim * bi, gr * bi + gim * br}; }
    for (int idx = tid; idx < 16 * 64; idx += 512) CC[idx] = (f32x2){c_re[gi * 1024 + idx], c_im[gi * 1024 + idx]};
    __syncthreads();
    bf16_t* KT = (bf16_t*)(F.ws + WS_KT) + (size_t)gi * KT_ELEMS; bf16_t* EM = (bf16_t*)(F.ws + WS_EM) + (size_t)gi * 128 * 1024; bf16_t* MY = (bf16_t*)(F.ws + WS_MY) + (size_t)gi * 1024 * 128;
    for (int idx = sl * (KT_ELEMS / 8) + tid; idx < (sl + 1) * (KT_ELEMS / 8); idx += 512) { const int dd = idx >> 8, c = (idx >> 4) & 15, cp = idx & 15; float acc = 0.f;
        if (dd > 0) { const int d = dd - 1;
            for (int n = 0; n < 64; ++n) { const f32x2 p = POW[d * 64 + n], bb = BB[n * 16 + cp], cc = CC[c * 64 + n];
                const float wr = p[0] * bb[0] - p[1] * bb[1], wi = p[0] * bb[1] + p[1] * bb[0]; acc += cc[0] * wr - cc[1] * wi; } }
        KT[idx] = (bf16_t)f2bf(acc); }
    for (int idx = sl * 16384 + tid; idx < (sl + 1) * 16384; idx += 512) { const int ri = idx >> 10, k = idx & 1023, n = ri & 63, part = ri >> 6, j = k >> 4, cp = k & 15;
        const f32x2 p = POW[(63 - j) * 64 + n], bb = BB[n * 16 + cp]; const float v = part == 0 ? p[0] * bb[0] - p[1] * bb[1] : p[0] * bb[1] + p[1] * bb[0];
        EM[idx] = (bf16_t)f2bf(v); }
    for (int idx = sl * 16384 + tid; idx < (sl + 1) * 16384; idx += 512) { const int row = idx >> 7, ki = idx & 127, t = row >> 4, c = row & 15, n = ki & 63, part = ki >> 6;
        const f32x2 p = POW[(t + 1) * 64 + n], cc = CC[c * 64 + n]; const float v = part == 0 ? cc[0] * p[0] - cc[1] * p[1] : -(cc[0] * p[1] + cc[1] * p[0]);
        MY[idx] = (bf16_t)f2bf(v); }
    if (sl == 0 && tid < 64) ((f32x2*)(F.ws + WS_A64))[gi * 64 + tid] = POW[64 * 64 + tid];
    __syncthreads();
}

__device__ __forceinline__ float gelu_tanh_f(float v) { const float u = 0.7978845608028654f * (v + 0.044715f * v * v * v); const float e = __expf(2.f * u); return v * (1.f - __builtin_amdgcn_rcpf(e + 1.f)); }
constexpr int SS_KT = 0, SS_ES = 33280, SS_MYB = 33280, SS_MYP = 272, SS_EMB = 66560, SS_EMP = 144, SS_EMBUF = 128 * SS_EMP, SS_SP = 103424, SS_SPP = 136;
static_assert(SS_EMB + 2 * SS_EMBUF <= SS_SP && SS_MYB + 256 * SS_MYP <= SS_SP && SS_SP + 64 * SS_SPP * 2 <= RING_BYTES, "SSM LDS map");
__device__ __forceinline__ void ssm_unit(Frame& F, const Args& A, int b, int gi, int fake) {
    const bf16_t* U = (const bf16_t*)(F.ws + WS_D); bf16_t* Y = (bf16_t*)(F.ws + WS_D) + (size_t)M * 512; const float* d_skip = A.in[10];
    const bf16_t* KTg = (const bf16_t*)(F.ws + WS_KT) + (size_t)gi * KT_ELEMS; const bf16_t* EM = (const bf16_t*)(F.ws + WS_EM) + (size_t)gi * 128 * 1024; const bf16_t* MY = (const bf16_t*)(F.ws + WS_MY) + (size_t)gi * 1024 * 128;
    LAS unsigned char* lds = F.lds; LAS bf16_t* KT = (LAS bf16_t*)(lds + SS_KT); LAS float* ES = (LAS float*)(lds + SS_ES); LAS bf16_t* SP = (LAS bf16_t*)(lds + SS_SP);
    const int tid = F.tid, lane = F.lane, fr = lane & 15, g = lane >> 4, w = F.wave, nt = w & 3, wh = w >> 2;
    __syncthreads();
    for (int i = tid; i < KT_ELEMS / 8; i += 512) ((LAS u32x4*)KT)[i] = ((const u32x4*)KTg)[i];
    const size_t tokb = (size_t)b * SEQ + (size_t)(16 * nt + fr) * 64;
    const bf16_t* ub = U + (UF_PIECE(b, gi, 0, 16 * nt, 0, 0) + lane) * 8;
    constexpr size_t UKS = 4 * 64 * 8;
    if (!(fake & 2)) { f32x4 acc[4];
#pragma unroll
      for (int i = 0; i < 4; ++i) acc[i] = (f32x4){0.f, 0.f, 0.f, 0.f};
      const int er0 = tid >> 3, es = tid & 7;
      const bf16_t* eg = EM + (size_t)er0 * 1024 + es * 8;
      u32x4 re[4][2]; bf16x8 rb[4][2];
#define SS_LD(j, kc) do { re[j][0] = *(const u32x4*)(eg + (kc) * 64); re[j][1] = *(const u32x4*)(eg + (size_t)64 * 1024 + (kc) * 64); \
          rb[j][0] = *(const bf16x8*)(ub + (size_t)(2 * (kc)) * UKS); rb[j][1] = *(const bf16x8*)(ub + (size_t)(2 * (kc) + 1) * UKS); } while (0)
#pragma unroll
      for (int j = 0; j < 4; ++j) SS_LD(j, j);
#pragma unroll
      for (int kq = 0; kq < 16; kq += 4) {
#pragma unroll
          for (int j = 0; j < 4; ++j) { const int kc = kq + j; LAS unsigned char* eb = lds + SS_EMB + (kc & 1) * SS_EMBUF;
              *(LAS u32x4*)(eb + er0 * SS_EMP + es * 16) = re[j][0]; *(LAS u32x4*)(eb + (er0 + 64) * SS_EMP + es * 16) = re[j][1];
              const bf16x8 b0 = rb[j][0], b1 = rb[j][1];
              if (kc + 4 < 16) SS_LD(j, kc + 4);
              LDS_BARRIER();
              bf16x8 af[2][4];
#pragma unroll
              for (int q = 0; q < 2; ++q)
#pragma unroll
                  for (int i = 0; i < 4; ++i) af[q][i] = *(const LAS bf16x8*)(eb + (wh * 64 + i * 16 + fr) * SS_EMP + q * 64 + g * 16);
#pragma unroll
              for (int i = 0; i < 4; ++i) { acc[i] = __builtin_amdgcn_mfma_f32_16x16x32_bf16(af[0][i], b0, acc[i], 0, 0, 0); acc[i] = __builtin_amdgcn_mfma_f32_16x16x32_bf16(af[1][i], b1, acc[i], 0, 0, 0); } } }
#undef SS_LD
#pragma unroll
      for (int i = 0; i < 4; ++i)
#pragma unroll
          for (int r = 0; r < 4; ++r) ES[(wh * 64 + i * 16 + 4 * g + r) * 65 + 16 * nt + fr] = acc[i][r]; }
    __syncthreads();
    if (tid < 64 && !(fake & 4)) { const f32x2 a = ((const f32x2*)(F.ws + WS_A64))[gi * 64 + tid]; float sr = 0.f, si = 0.f;
        for (int c = 0; c < 64; ++c) { SP[c * SS_SPP + tid] = (bf16_t)f2bf(sr); SP[c * SS_SPP + 64 + tid] = (bf16_t)f2bf(si);
            const float er = ES[tid * 65 + c], ei = ES[(64 + tid) * 65 + c]; const float nr = a[0] * sr - a[1] * si + er, ni = a[0] * si + a[1] * sr + ei; sr = nr; si = ni; } }
    const int mr0 = tid >> 4, ms = tid & 15; const bf16_t* mg = MY + (size_t)mr0 * 128 + ms * 8;
    u32x4 rm[8];
#pragma unroll
    for (int i = 0; i < 8; ++i) rm[i] = *(const u32x4*)(mg + (size_t)(32 * i) * 128);
    LDS_BARRIER();
    if (!(fake & 8)) { const f32x4 dsk = *(const f32x4*)(d_skip + gi * 16 + 4 * g);
      const LAS bf16_t* ka = KT + fr * 16 + 8 * (g & 1) + (1 - (g >> 1) + wh) * 256;
#pragma unroll 1
      for (int B = 0; B < 4; ++B) {
          f32x4 acc[8];
#pragma unroll
          for (int i = 0; i < 8; ++i) acc[i] = (f32x4){0.f, 0.f, 0.f, 0.f};
          bf16x8 ring[4];
#pragma unroll
          for (int j = 0; j < 4; ++j) ring[j] = *(const bf16x8*)(ub + (size_t)j * UKS);
#pragma unroll
          for (int i = 0; i < 8; ++i) *(LAS u32x4*)(lds + SS_MYB + (mr0 + 32 * i) * SS_MYP + ms * 16) = rm[i];
          if (B < 3) {
#pragma unroll
              for (int i = 0; i < 8; ++i) rm[i] = *(const u32x4*)(mg + (size_t)(256 * (B + 1) + 32 * i) * 128); }
          LDS_BARRIER();
#pragma unroll
          for (int ks = 0; ks < 4; ++ks) { const bf16x8 bs = *(const LAS bf16x8*)(SP + (16 * nt + fr) * SS_SPP + ks * 32 + 8 * g);
              bf16x8 af[8];
#pragma unroll
              for (int i = 0; i < 8; ++i) af[i] = *(const LAS bf16x8*)(lds + SS_MYB + ((2 * i + wh) * 16 + fr) * SS_MYP + ks * 64 + g * 16);
#pragma unroll
              for (int i = 0; i < 8; ++i) acc[i] = __builtin_amdgcn_mfma_f32_16x16x32_bf16(af[i], bs, acc[i], 0, 0, 0); }
#pragma unroll 1
          for (int kb = 0; kb < 8 * B; kb += 4) {
#pragma unroll
              for (int j = 0; j < 4; ++j) { const int ks = kb + j;
                  const bf16x8 bf = ring[j]; ring[j] = *(const bf16x8*)(ub + (size_t)(ks + 4) * UKS);
                  const LAS bf16_t* kk = ka + (8 * B - ks) * 512;
                  bf16x8 af[8];
#pragma unroll
                  for (int i = 0; i < 8; ++i) af[i] = *(const LAS bf16x8*)(kk + i * 512);
                  __builtin_amdgcn_sched_barrier(0);
#pragma unroll
                  for (int i = 0; i < 8; ++i) acc[i] = __builtin_amdgcn_mfma_f32_16x16x32_bf16(af[i], bf, acc[i], 0, 0, 0);
                  __builtin_amdgcn_sched_barrier(0); } }
#pragma unroll
          for (int d = 0; d < 8; ++d) {
              const bf16x8 bf = ring[d & 3]; if (d < 4) ring[d & 3] = *(const bf16x8*)(ub + (size_t)(8 * B + d + 4) * UKS);
#pragma unroll
              for (int i = d; i < 8; ++i) { const bf16x8 af = *(const LAS bf16x8*)(ka + (i - d) * 512); acc[i] = __builtin_amdgcn_mfma_f32_16x16x32_bf16(af, bf, acc[i], 0, 0, 0); } }
#pragma unroll
          for (int i = 0; i < 8; ++i) { const int t = 2 * (8 * B + i) + wh; const size_t off = (tokb + t) * 512 + gi * 16 + 4 * g;
              const u32x2 uw = *(const u32x2*)(U + UF_PIECE(b, gi, 8 * B + i, 16 * nt + fr, wh, g >> 1) * 8 + 4 * (g & 1)); const f32x4 uv = (f32x4){bflo(uw.x), bfhi(uw.x), bflo(uw.y), bfhi(uw.y)};
              f32x4 y = acc[i] + dsk * uv;
#pragma unroll
              for (int r = 0; r < 4; ++r) y[r] = gelu_tanh_f(y[r]);
              if (!(fake & 1)) *(u32x2*)(Y + off) = (u32x2){cvtpk(y[0], y[1]), cvtpk(y[2], y[3])}; }
          LDS_BARRIER();
      } }
}

constexpr int AT_QU = 512  , AT_OST = 0, AT_OP = 72  , AT_M = 73728, AT_L = 75776, AT_V = 77824, AT_VW = 4608, AT_VP = 144;
typedef short s16x4 __attribute__((ext_vector_type(4)));
__device__ __forceinline__ s16x4 vtr(const LAS unsigned char* p) { return __builtin_bit_cast(s16x4, __builtin_amdgcn_ds_read_tr16_b64_v4i16((LAS s16x4*)p)); }
__device__ __forceinline__ float xmax16(float x) { auto r = __builtin_amdgcn_permlane16_swap(__float_as_uint(x), __float_as_uint(x), false, false); return fmaxf(__uint_as_float(r[0]), __uint_as_float(r[1])); }
__device__ __forceinline__ float xmax32(float x) { auto r = __builtin_amdgcn_permlane32_swap(__float_as_uint(x), __float_as_uint(x), false, false); return fmaxf(__uint_as_float(r[0]), __uint_as_float(r[1])); }
template <bool SHARED>
__device__ __forceinline__ void attn_branch(Frame& F, int b, int h, int t0, int br, int r, int pp, int fake) {
    const bf16_t* Qg = (const bf16_t*)(F.ws + WS_C); bf16_t* MIXo = (bf16_t*)(F.ws + WS_B);
    LAS unsigned char* lds = F.lds; LAS bf16_t* Ost = (LAS bf16_t*)(lds + AT_OST); LAS float* Mst = (LAS float*)(lds + AT_M); LAS float* Lst = (LAS float*)(lds + AT_L);
    const int lane = F.lane, fr = lane & 15, g = lane >> 4;
    const float slope2 = exp2f(-(float)(h + 1)) * LOG2E, sr = slope2 * (float)r;
    const size_t rowb = (size_t)b * SEQ;
    const int vrow = lane >> 3, vch = lane & 7;
    constexpr int NS_ = SHARED ? 1 : 2;
    int qpos[2], lo[2], hi[2], k0s[NS_]; bf16x8 qf0[2], qf1[2]; float m[2], l[2]; f32x4 o[2][4]; u32x4 kr[NS_][4]; u32x4 vr[NS_][4]; f32x4 biasC[2][2];
    LAS unsigned char* vb[NS_]; const LAS unsigned char* trp[NS_];
#pragma unroll
    for (int X = 0; X < 2; ++X) {
        int base;
        if (SHARED) { const int p = F.wave + 8 * pp, cls = p % r, pi = p / r; base = t0 + cls + (2 * pi + X) * 16 * r; }
        else { const int s = F.wave + 8 * X; base = t0 + s; }
        qpos[X] = base + r * fr;
        const int k0 = (SHARED ? base - 16 * r * X : base) - 128 * r;
        if (X < NS_) k0s[X < NS_ ? X : 0] = k0;
        const int nmin = k0 < 0 ? (-k0 + r - 1) / r : 0, sh = SHARED ? 16 * X : 0;
        lo[X] = (fr + sh) > nmin ? (fr + sh) : nmin; hi[X] = fr + sh + 128;
        const bf16_t* qp = Qg + (rowb + qpos[X]) * 512 + h * 64 + 8 * g; qf0[X] = *(const bf16x8*)qp; qf1[X] = *(const bf16x8*)(qp + 32);
        m[X] = -1e30f; l[X] = 0.f;
#pragma unroll
        for (int dt = 0; dt < 4; ++dt) o[X][dt] = (f32x4){0.f, 0.f, 0.f, 0.f};
#pragma unroll
        for (int T = 0; T < 2; ++T)
#pragma unroll
            for (int rr = 0; rr < 4; ++rr) biasC[X][T][rr] = sr * (float)(16 * T + 4 * g + rr - sh - 128 - fr);
    }
    const __amdgpu_buffer_rsrc_t rs = __builtin_amdgcn_make_buffer_rsrc((void*)F.ws, 0, 0x7fffffff, 0x00020000);
    int koff[NS_][4], voff[NS_][4], nminu[NS_]; const LAS unsigned char* kfp[NS_];
#pragma unroll
    for (int Y = 0; Y < NS_; ++Y) {
        vb[Y] = lds + AT_V + F.wave * AT_VW; trp[Y] = vb[Y] + (4 * g + (fr >> 2)) * AT_VP + (fr & 3) * 8;
        nminu[Y] = k0s[Y] < 0 ? (-k0s[Y] + r - 1) / r : 0;
#pragma unroll
        for (int i = 0; i < 4; ++i) koff[Y][i] = (int)(WS_C + (size_t)M * 1024) + (int)((((long)rowb + k0s[Y] + r * (vrow + 8 * i)) * 512 + h * 64 + vch * 8) * 2);
        kfp[Y] = vb[Y] + fr * AT_VP + g * 16;
#pragma unroll
        for (int i = 0; i < 4; ++i) voff[Y][i] = (int)(WS_C + (size_t)M * 2048) + (int)((((long)rowb + k0s[Y] + r * (vrow + 8 * i)) * 512 + h * 64 + vch * 8) * 2);
    }
    const int kstepb = fake ? 0 : 32768 * r;
#define AT_LOAD(Y, n0) do { const int so_ = ((n0) >> 5) * kstepb; \
        _Pragma("unroll") for (int i = 0; i < 4; ++i) { kr[Y][i] = __builtin_amdgcn_raw_buffer_load_b128(rs, koff[Y][i], so_, 0); vr[Y][i] = __builtin_amdgcn_raw_buffer_load_b128(rs, voff[Y][i], so_, 0); } } while (0)
#pragma unroll
    for (int Y = 0; Y < NS_; ++Y) AT_LOAD(Y, 0);
#pragma unroll 1
    for (int st = 0; st < 5; ++st) {
        const int n0 = st * 32; f32x4 sT[2][2]; bf16x8 pb[2];
        bf16x8 kf[NS_][2][2];
#pragma unroll
        for (int Y = 0; Y < NS_; ++Y) {
#pragma unroll
            for (int i = 0; i < 4; ++i) *(LAS u32x4*)(vb[Y] + (vrow + 8 * i) * AT_VP + vch * 16) = kr[Y][i];
#pragma unroll
            for (int T = 0; T < 2; ++T)
#pragma unroll
                for (int ks = 0; ks < 2; ++ks) kf[Y][T][ks] = *(const LAS bf16x8*)(kfp[Y] + T * 16 * AT_VP + ks * 64);
#pragma unroll
            for (int i = 0; i < 4; ++i) *(LAS u32x4*)(vb[Y] + (vrow + 8 * i) * AT_VP + vch * 16) = vr[Y][i];
        }
#pragma unroll
        for (int X = 0; X < 2; ++X)
#pragma unroll
            for (int T = 0; T < 2; ++T) { const int Y = SHARED ? 0 : X;
                sT[X][T] = __builtin_amdgcn_mfma_f32_16x16x32_bf16(kf[Y][T][0], qf0[X], biasC[X][T], 0, 0, 0); sT[X][T] = __builtin_amdgcn_mfma_f32_16x16x32_bf16(kf[Y][T][1], qf1[X], sT[X][T], 0, 0, 0); }
        if (st < 4) {
#pragma unroll
            for (int Y = 0; Y < NS_; ++Y) AT_LOAD(Y, n0 + 32); }
        const float off = sr * (float)n0;
#pragma unroll
        for (int X = 0; X < 2; ++X) {
            const int Y = SHARED ? 0 : X;
            const bool full = (st >= 1) && (st <= 3) && (n0 >= nminu[Y]);
            if (!full) { const unsigned span = (unsigned)(hi[X] - lo[X]);
#pragma unroll
                for (int T = 0; T < 2; ++T)
#pragma unroll
                    for (int rr = 0; rr < 4; ++rr) { const int n = n0 + 16 * T + 4 * g + rr; if ((unsigned)(n - lo[X]) > span) sT[X][T][rr] = -1e30f; } }
            float pmax = fmaxf(fmaxf(fmaxf(sT[X][0][0], sT[X][0][1]), fmaxf(sT[X][0][2], sT[X][0][3])), fmaxf(fmaxf(sT[X][1][0], sT[X][1][1]), fmaxf(sT[X][1][2], sT[X][1][3])));
            pmax = xmax32(xmax16(pmax)) + off;
            const float mn = fmaxf(m[X], pmax);
            if (__any(mn > m[X])) { const float f = __builtin_amdgcn_exp2f(m[X] - mn); l[X] *= f;
#pragma unroll
                for (int dt = 0; dt < 4; ++dt) o[X][dt] = o[X][dt] * f; }
            m[X] = mn; const float ml = mn - off;
            sT[X][0] = vexp2(sT[X][0] - ml); sT[X][1] = vexp2(sT[X][1] - ml);
            { const f32x4 p4 = sT[X][0] + sT[X][1]; l[X] += (p4[0] + p4[1]) + (p4[2] + p4[3]); }
            const u32x4 pw = (u32x4){cvtpk(sT[X][0][0], sT[X][0][1]), cvtpk(sT[X][0][2], sT[X][0][3]), cvtpk(sT[X][1][0], sT[X][1][1]), cvtpk(sT[X][1][2], sT[X][1][3])};
            pb[X] = __builtin_bit_cast(bf16x8, pw);
        }
#pragma unroll
        for (int dt = 0; dt < 4; ++dt) {
            bf16x8 vf[NS_];
#pragma unroll
            for (int Y = 0; Y < NS_; ++Y) { const s16x4 lo4 = vtr(trp[Y] + dt * 32), hi4 = vtr(trp[Y] + 16 * AT_VP + dt * 32); vf[Y] = (bf16x8){lo4[0], lo4[1], lo4[2], lo4[3], hi4[0], hi4[1], hi4[2], hi4[3]}; }
#pragma unroll
            for (int X = 0; X < 2; ++X) o[X][dt] = __builtin_amdgcn_mfma_f32_16x16x32_bf16(vf[SHARED ? 0 : X], pb[X], o[X][dt], 0, 0, 0);
        }
    }
#undef AT_LOAD
#pragma unroll
    for (int X = 0; X < 2; ++X) {
        float lx = l[X]; lx += __shfl_xor(lx, 16); lx += __shfl_xor(lx, 32); float mx = m[X];
        const int qi = qpos[X] - t0;
        if (br > 0) { const float ms = Mst[qi], ls = Lst[qi]; const float mn = fmaxf(mx, ms), f1 = __builtin_amdgcn_exp2f(mx - mn), f2 = __builtin_amdgcn_exp2f(ms - mn);
#pragma unroll
            for (int dt = 0; dt < 4; ++dt) { const u32x2 ow = *(const LAS u32x2*)(Ost + qi * AT_OP + 16 * dt + 4 * g); const f32x4 os = (f32x4){bflo(ow.x), bfhi(ow.x), bflo(ow.y), bfhi(ow.y)}; o[X][dt] = o[X][dt] * f1 + os * f2; }
            lx = lx * f1 + ls * f2; mx = mn; }
        if (br < 2) {
#pragma unroll
            for (int dt = 0; dt < 4; ++dt) *(LAS u32x2*)(Ost + qi * AT_OP + 16 * dt + 4 * g) = (u32x2){cvtpk(o[X][dt][0], o[X][dt][1]), cvtpk(o[X][dt][2], o[X][dt][3])};
            if (g == 0) { Mst[qi] = mx; Lst[qi] = lx; }
        } else if (!fake) { const float inv = __builtin_amdgcn_rcpf(lx);
            if (WOUT_F8) { unsigned char* op8 = (unsigned char*)MIXo + (rowb + qpos[X]) * 1024 + h * 64 + 4 * g;
#pragma unroll
                for (int dt = 0; dt < 4; ++dt) { const f32x4 v = o[X][dt] * inv; int p0 = __builtin_amdgcn_cvt_pk_fp8_f32(v[0], v[1], 0, false); p0 = __builtin_amdgcn_cvt_pk_fp8_f32(v[2], v[3], p0, true); *(unsigned*)(op8 + 16 * dt) = (unsigned)p0; } }
            else { bf16_t* op = MIXo + (rowb + qpos[X]) * 1024 + h * 64 + 4 * g;
#pragma unroll
                for (int dt = 0; dt < 4; ++dt) { const f32x4 v = o[X][dt] * inv; *(u32x2*)(op + 16 * dt) = (u32x2){cvtpk(v[0], v[1]), cvtpk(v[2], v[3])}; } } }
    }
}
struct CvtPend { int cur; bool has; TrItem it; f32x4 tv[8]; };
__device__ __forceinline__ void cvt_step(Frame& F, const Args& A, CvtPend& P) {
    if (P.has) tr_store(P.it, P.tv, F.lane);
    P.has = P.cur < cvt_p2_end(F);
    if (P.has) { P.it = tr_decode_exp(F, A, P.cur); tr_load(P.it, P.tv, F.lane); P.cur += F.G * NWAVES; }
}
__device__ __forceinline__ void attn_unit(Frame& F, const Args& A, int b, int h, int t0, int fake, CvtPend& P) {
#pragma unroll 1
    for (int br = 0; br < 3; ++br) { const int r = br == 0 ? 16 : (br == 1 ? 4 : 1);
#pragma unroll 1
        for (int pp = 0; pp < 2; ++pp) { attn_branch<true>(F, b, h, t0, br, r, pp, fake); if (!fake && !P0_EXPERTS && CVT_IN_GEMM != 1) cvt_step(F, A, P); }
        __syncthreads(); }
}
__device__ __forceinline__ void p2_mixers(Frame& F, const Args& A) {
    CvtPend P; P.cur = F.vcu * NWAVES + F.wave; P.has = false;
#ifndef REP_SSM
#define REP_SSM 1
#endif
#ifndef REP_ATT
#define REP_ATT 1
#endif
#ifndef SSM_FAKE
#define SSM_FAKE 0
#endif
#ifndef ATT_FAKE
#define ATT_FAKE 0
#endif
    for (int rp = 0; rp < REP_SSM; ++rp)
    for (int u = F.vcu; u < BATCH * NG; u += F.G) ssm_unit(F, A, u / NG, u % NG, rp > 0 ? SSM_FAKE : 0);
    __syncthreads();
    for (int rp = 0; rp < REP_ATT; ++rp)
    for (int u = F.vcu; u < BATCH * NH * (SEQ / AT_QU); u += F.G) { const int qb = u & 7, bh = u >> 3; attn_unit(F, A, bh >> 3, bh & 7, qb * AT_QU, rp > 0 ? ATT_FAKE : 0, P); }
    if (P.has) tr_store(P.it, P.tv, F.lane);
    if (!P0_EXPERTS && CVT_IN_GEMM != 1) (void)cvt_expert_burst(F, A, P.cur, 1 << 20, cvt_p2_end(F));
}

constexpr int N_PHASES = 12;
__global__ void __launch_bounds__(NWAVES * 64, 2) mk_fwd(Args args) {
    extern __shared__ __attribute__((aligned(16))) unsigned char lds_raw[];
    Frame F;
    F.lds = (LAS unsigned char*)lds_raw;
    F.MISC = (volatile LAS unsigned*)(F.lds + MISC_OFF);
    F.wv0 = __builtin_amdgcn_readfirstlane((int)threadIdx.x >> 6); F.tid = (F.wv0 << 6) | hw_lane(); F.lane = F.tid & 63; F.wave = F.wv0;
    F.G = gridDim.x; { const int bx = blockIdx.x; F.vcu = (F.G % 8 == 0) ? (bx % 8) * (F.G / 8) + bx / 8 : bx; }
    F.ws = args.ws; F.out = args.out; F.ctl = (unsigned*)(args.ws + WS_CTL);
    for (int u = F.tid; u < (LDS_BYTES - LDSCTL_OFF) / 4; u += NWAVES * 64) ((LAS unsigned*)(F.lds + LDSCTL_OFF))[u] = 0u;
    __syncthreads();
    const int lo = args.ph_lo, hi = args.ph_hi;
    XcdBarrier bar; bar.bar = F.ctl + CW_BAR; bar.x = 0; bar.st = nullptr;
    if (hi - lo > 1) bar = xcd_barrier_post(F.ctl + CW_BAR, F.MISC + 8);
#ifndef PH_MASK
#define PH_MASK 0xfff
#endif
#define IN(k) (((PH_MASK >> (k)) & 1) && lo <= (k) && (k) < hi)
#ifndef REPEAT_MASK
#define REPEAT_MASK 0
#endif
#ifndef P5_FAKE
#define P5_FAKE 0
#endif
#ifndef PROBE_EPI_MODE
#define PROBE_EPI_MODE 0
#endif
#define PH(k) if (IN(k)) for (int rep_ = 0; rep_ < 1 + ((REPEAT_MASK >> (k)) & 1); ++rep_)
#define RELAUNDER() do { int t_ = (F.wv0 << 6) | hw_lane(); asm volatile("" : "+v"(t_)); F.tid = t_; F.lane = t_ & 63; F.wave = __builtin_amdgcn_readfirstlane(t_ >> 6); \
        GAS unsigned char* w_ = (GAS unsigned char*)args.ws; GAS float* o_ = (GAS float*)args.out; asm volatile("" : "+s"(w_), "+s"(o_)); F.ws = (unsigned char*)w_; F.out = (float*)o_; F.ctl = (unsigned*)(w_ + WS_CTL); } while (0)
#define XB ((bf16_t*)(F.ws + WS_B))
#define MIX XB
#define H XB
#define Qb ((bf16_t*)(F.ws + WS_C))
#define Ub ((bf16_t*)(F.ws + WS_D))
#define Yb (Ub + (size_t)M * 512)
#define SEAM(k) do { if (IN(k) && IN((k) + 1)) xcd_barrier(bar, F.wv0); } while (0)
#define SEAMF(k, body) do { if (IN(k) && IN((k) + 1)) xcd_barrier_with(bar, F.wv0, [&]() { RELAUNDER(); body; }); else if (IN((k) + 1)) { RELAUNDER(); body; } } while (0)
#define SEAMT(k, tq) do { if (IN(k) && IN((k) + 1)) xcd_barrier_with(bar, F.wv0, [&]() { RELAUNDER(); moe_units<1>(F, (tq)); }); else if (IN((k) + 1)) { RELAUNDER(); moe_units<1>(F, (tq)); } } while (0)
    LAS unsigned char* ring = F.lds + RING_OFF;

    PH(0) { RELAUNDER();
        const int first = (F.vcu & 1) ? 1 : 0;
#pragma unroll 1
        for (int st = 0; st < 2; ++st) {
            if (st == first) { for (int it = F.vcu; it < NG * 8; it += F.G) p0_ssm_tables(F, args, it >> 3, it & 7); }
            else p0_prologue(F, args);
        }
    } SEAM(0);
    PH(1) { RELAUNDER();
        pg8::PlainSched S; S.init(XB, (const bf16_t*)(F.ws + WS_WIN), M, ZC, G1_F8 ? DM / 2 : DM, F.G, (int)blockIdx.x);
        EpiQKVU E{Qb};
#if CVT_IN_GEMM == 1
        { const int ngw = F.G * NWAVES, jgu = (I_G + I_U + ngw - 1) / ngw, s1 = (jgu * 5 + 8) / 9 < jgu ? (jgu * 5 + 8) / 9 : jgu, nloc = S.nwg > (int)blockIdx.x ? (S.nwg - 1 - (int)blockIdx.x) / F.G + 1 : 1;
          CvtHook Hk{&F, &args, (F.vcu >> 3) % nloc, 0, s1};
          pg8::gemm_phase<EpiQKVU, pg8::PlainSched, true, G1_F8 != 0, 0, 1, CvtHook>(ring, G1_F8 ? DM / 2 : DM, S, E, F.wv0, Hk); }
#else
        { G1Sched GS_{S}; pg8::gemm_phase<EpiQKVU, G1Sched, true, G1_F8 != 0>(ring, G1_F8 ? DM / 2 : DM, GS_, E, F.wv0); }
#endif
    } SEAM(1);
    PH(2) { RELAUNDER(); p2_mixers(F, args); } SEAMF(2, p_convert_p(F, args));
    PH(3) { RELAUNDER();
        pg8::PlainSched S; S.init(Yb, (const bf16_t*)(F.ws + WS_WGLU), M, SW, SW, F.G, (int)blockIdx.x);
        EpiGLU E{Yb, args.in[12], MIX};
        pg8::gemm_phase<EpiGLU, pg8::PlainSched, true, false, 2>(ring, SW, S, E, F.wv0);
    } SEAM(3);
    PH(4) { RELAUNDER();
        pg8::PlainSched S; S.init(MIX, (const bf16_t*)(F.ws + WS_WOUT), M, DM, WOUT_F8 ? DM / 2 : DM, F.G, (int)blockIdx.x);
        EpiWout E{args.in[0], (bf16_t*)F.out, (f32x2*)(F.ws + WS_STATS)};
#if CVT_IN_GEMM == 1
        { const int ngw = F.G * NWAVES, jgu = (I_G + I_U + ngw - 1) / ngw, s1 = (jgu * 5 + 8) / 9 < jgu ? (jgu * 5 + 8) / 9 : jgu, nloc = S.nwg > (int)blockIdx.x ? (S.nwg - 1 - (int)blockIdx.x) / F.G + 1 : 1;
          CvtHook Hk{&F, &args, (F.vcu >> 3) % nloc, s1, jgu};
          pg8::gemm_phase<EpiWout, pg8::PlainSched, true, false, 0, 1, CvtHook>(ring, DM, S, E, F.wv0, Hk); }
#else
        pg8::gemm_phase<EpiWout, pg8::PlainSched, true, WOUT_F8 != 0>(ring, WOUT_F8 ? DM / 2 : DM, S, E, F.wv0);
#endif
    } SEAM(4);
    PH(5) { RELAUNDER();
#if (REPEAT_MASK >> 5) & 1
        if (rep_ == 1 && !P5_FAKE) { xcd_barrier(bar, F.wv0); if (blockIdx.x == 0 && F.tid < 256) __hip_atomic_store(F.ctl + CW_CNT + F.tid, 0u, RLX_AGENT); xcd_barrier(bar, F.wv0); }
#endif
        p5_ln_router(F, args, rep_ == 1 ? P5_FAKE : 0); } SEAM(5);
#define SLABQ(q) ((unsigned char*)(F.ws + (((q) & 1) ? WS_SLAB1 : WS_SLAB0)))
#define DOWN(q) do { DownSched S{(const unsigned char*)(F.ws + WS_HID), (const unsigned char*)(F.ws + WS_WD), (LAS const int*)(F.lds + TAB_OFF)}; \
        EpiDown E{SLABQ(q), (LAS const int*)(F.lds + IDX_OFF)}; pg8::gemm_phase<EpiDown, DownSched, true, true, 2>(ring, EH / 2, S, E, F.wv0); } while (0)
#define COMB_LIGHT(q) p_combine_ln2(F, args, (q), SLABQ(q), 0, F.G)
    PH(6) { RELAUNDER();
        { pg8::PlainSched S; S.init((const bf16_t*)(F.ws + WS_H8), (const bf16_t*)(F.ws + WS_WPG), M, DM, DM / 2, F.G, (int)blockIdx.x);
          EpiGS E{(unsigned char*)((char*)F.out + OUT_GS)};
          pg8::gemm_phase<EpiGS, pg8::PlainSched, true, true, 2>(ring, DM / 2, S, E, F.wv0); }
        moe_units<0>(F, 0);
        { GUSched S{(const bf16_t*)(F.ws + WS_H8), (const bf16_t*)(F.ws + WS_WGU), (LAS const int*)(F.lds + TAB_OFF), (LAS const int*)(F.lds + IDX_OFF)}; EpiGU E{(unsigned char*)(F.ws + WS_HID)};
#if CVT_IN_GEMM
          const int ngw = F.G * NWAVES, jgu = (I_G + I_U + ngw - 1) / ngw, jall = (I_EXP + ngw - 1) / ngw;
          CvtHook Hk{&F, &args, (F.vcu >> 3) & 7, jgu, jall};
          pg8::gemm_phase<EpiGU, GUSched, true, true, 0, 1, CvtHook>(ring, DM / 2, S, E, F.wv0, Hk); }
#else
          pg8::gemm_phase<EpiGU, GUSched, true, true>(ring, DM / 2, S, E, F.wv0); }
#endif
    } SEAMT(6, 0);
    PH(7) { RELAUNDER();
        { pg8::PlainSched S; S.init((const bf16_t*)((const char*)F.out + OUT_PB), (const bf16_t*)(F.ws + WS_WPLE), M, DM, PLE_F8 ? PLE / 2 : PLE, F.G, (int)blockIdx.x);
          EpiBase E{(const unsigned char*)((const char*)F.out + OUT_GS), F.ws + WS_H8};
          int kple = PLE_F8 ? PLE / 2 : PLE; asm volatile("" : "+s"(kple));
          pg8::gemm_phase<EpiBase, pg8::PlainSched, true, PLE_F8 != 0, 2>(ring, kple, S, E, F.wv0); }
        DOWN(0);
    } SEAMT(7, 1);
#ifndef REP_COMB
#define REP_COMB 1
#endif
#ifndef REP_DOWN
#define REP_DOWN 1
#endif
    PH(8)  { RELAUNDER(); for (int rc = 0; rc < REP_COMB; ++rc) COMB_LIGHT(0); for (int rd = 0; rd < REP_DOWN; ++rd) DOWN(1); } SEAMT(8, 2);
    PH(9)  { RELAUNDER(); COMB_LIGHT(1); DOWN(2); } SEAMT(9, 3);
    PH(10) { RELAUNDER(); COMB_LIGHT(2); DOWN(3); } SEAM(10);
    PH(11) { RELAUNDER(); p_combine_ln2(F, args, 3, SLABQ(3), 0, F.G); }
#undef SLABQ
#undef DOWN
#undef COMB_LIGHT
#undef IN
#undef SEAM
#undef SEAMT
#undef SEAMF
#undef XB
#undef MIX
#undef H
#undef Qb
#undef Ub
#undef Yb

}

#ifndef HYBRID
#define HYBRID 0
#endif
#ifndef ONE_LAUNCH
#define ONE_LAUNCH 0
#endif
extern "C" void kernel_launch(void* const* d_in, const int* in_sizes, int n_in, void* d_out, int out_size, void* d_ws, size_t ws_size, hipStream_t stream) {
    static int grid = 0;
    if (grid == 0) {
        if (n_in != 28 || out_size != M * DM || ws_size < WS_END) { fprintf(stderr, "kernel_launch: unexpected shapes (n_in %d out %d ws %zu)\n", n_in, out_size, ws_size); grid = -1; return; }
        int dev = 0, cus = 0;
        if (hipGetDevice(&dev) != hipSuccess || hipDeviceGetAttribute(&cus, hipDeviceAttributeMultiprocessorCount, dev) != hipSuccess) { grid = -1; return; }
        if (hipFuncSetAttribute((const void*)mk_fwd, hipFuncAttributeMaxDynamicSharedMemorySize, LDS_BYTES) != hipSuccess) { fprintf(stderr, "kernel_launch: hipFuncSetAttribute failed\n"); grid = -1; return; }
        grid = cus;
    }
    if (grid < 0) return;
    (void)hipMemsetAsync((char*)d_ws + WS_CTL, 0, CTL_ZERO_BYTES, stream);
    Args a{};
    for (int i = 0; i < 28; ++i) a.in[i] = (const float*)d_in[i];
    a.out = (float*)d_out; a.ws = (unsigned char*)d_ws;
    const int last_phase = (HYBRID == 2) ? 5 : N_PHASES;
    if (ONE_LAUNCH) { a.ph_lo = 0; a.ph_hi = last_phase; hipLaunchKernelGGL(mk_fwd, dim3(grid), dim3(NWAVES * 64), LDS_BYTES, stream, a); }
    else for (int p = 0; p < last_phase; ++p) { a.ph_lo = p; a.ph_hi = p + 1; hipLaunchKernelGGL(mk_fwd, dim3(grid), dim3(NWAVES * 64), LDS_BYTES, stream, a); }
#if HYBRID == 2
    {
        using nv::GP;
        const float* pin = (const float*)d_in[1];
        const float* ln1_g = (const float*)d_in[14]; const float* ln1_b = (const float*)d_in[15]; const float* w_router = (const float*)d_in[16]; const float* router_bias = (const float*)d_in[17];
        const float* w_gate = (const float*)d_in[18]; const float* w_up = (const float*)d_in[19]; const float* w_down = (const float*)d_in[20];
        const float* ws_gate = (const float*)d_in[21]; const float* ws_up = (const float*)d_in[22]; const float* ws_down = (const float*)d_in[23];
        const float* w_ple = (const float*)d_in[24]; const float* w_pg = (const float*)d_in[25]; const float* ln2_g = (const float*)d_in[26]; const float* ln2_b = (const float*)d_in[27];
        float* out = (float*)d_out; char* ws = (char*)d_ws;
        float* HID = (float*)(ws); float* H = (float*)(ws + 256 * MiB); float* HIDS = (float*)(ws + 384 * MiB); float* SC = (float*)(ws + 448 * MiB);
        int* LIST = (int*)(ws + 456 * MiB); float* LISTW = (float*)(ws + 464 * MiB); int* CNT = (int*)(ws + 472 * MiB); int* OFF = CNT + 64;
        GP g{};
        nv::k_ln<<<M / 4, 256, 0, stream>>>(out, H, ln1_g, ln1_b);
        g = GP{}; g.A = H; g.lda = DM; g.B = w_router; g.ldb = NE; g.K = DM; g.nrows = M; g.C = SC; g.ldc = NE;
        nv::k_gemm<3><<<dim3(1, M / 64), 256, 0, stream>>>(g);
        (void)hipMemsetAsync(CNT, 0, 128 * sizeof(int), stream);
        nv::k_topk<<<M / 256, 256, 0, stream>>>(SC, router_bias, CNT, LIST, LISTW);
        nv::k_prefix<<<1, 64, 0, stream>>>(CNT, OFF);
        (void)hipMemsetAsync(out, 0, (size_t)M * DM * sizeof(float), stream);
        g = GP{}; g.A = H; g.lda = DM; g.B = w_gate; g.B2 = w_up; g.ldb = EH; g.K = DM; g.C = HID; g.ldc = EH; g.cnt = CNT; g.off = OFF; g.list = LIST; g.listw = LISTW;
        nv::k_gemm<4><<<dim3(EH / 64, M / 64, NE), 256, 0, stream>>>(g);
        g = GP{}; g.A = HID; g.lda = EH; g.B = w_down; g.ldb = DM; g.K = EH; g.C = out; g.ldc = DM; g.cnt = CNT; g.off = OFF; g.list = LIST; g.listw = LISTW;
        nv::k_gemm<5><<<dim3(DM / 64, M / 64, NE), 256, 0, stream>>>(g);
        g = GP{}; g.A = H; g.lda = DM; g.B = ws_gate; g.B2 = ws_up; g.ldb = EH; g.K = DM; g.nrows = M; g.C = HIDS; g.ldc = EH;
        nv::k_gemm<6><<<dim3(EH / 64, M / 64), 256, 0, stream>>>(g);
        g = GP{}; g.A = HIDS; g.lda = EH; g.B = ws_down; g.ldb = DM; g.K = EH; g.nrows = M; g.C = out; g.ldc = DM;
        nv::k_gemm<7><<<dim3(DM / 64, M / 64), 256, 0, stream>>>(g);
        g = GP{}; g.A = pin; g.lda = PLE; g.B = w_ple; g.ldb = DM; g.K = PLE; g.nrows = M; g.C = out; g.ldc = DM; g.A2 = H; g.lda2 = DM; g.B2 = w_pg; g.ldb2 = DM; g.K2 = DM;
        nv::k_gemm<8><<<dim3(DM / 64, M / 64), 256, 0, stream>>>(g);
        nv::k_ln<<<M / 4, 256, 0, stream>>>(out, out, ln2_g, ln2_b);
    }
#endif
}
```
